# Optimizing an MI355X kernel written in HIP

```python
import math
import jax, jax.numpy as jnp
from jax import lax
import numpy as np

D_MODEL = 1024
BATCH = 8
SEQ = 4096
DEPTH = 4

N_META = 16
GRID_W = 64
ROPE_THETA = 10000.0
EPS = 1e-6
EXP_CLIP = 30.0

ATT_HEADS = 8
ATT_KV_HEADS = 2
HEAD_DIM = 64
Q_BLOCK = 128
ATT_WIDTH = ATT_HEADS * HEAD_DIM
KV_WIDTH = ATT_KV_HEADS * HEAD_DIM

HGRN_HEADS = 4
HGRN_EXPAND = 128
HGRN_HEAD_V = 128
HGRN_KEY_WIDTH = HGRN_HEADS * HGRN_EXPAND
HGRN_WIDTH = HGRN_HEADS * HGRN_HEAD_V

SSM_HEADS = 8
SSM_HEAD_DIM = 64
SSM_GROUPS = 2
SSM_STATE = 64
SSM_CONV = 7
SSM_WIDTH = SSM_HEADS * SSM_HEAD_DIM
SSM_CONV_DIM = SSM_WIDTH + 2 * SSM_GROUPS * SSM_STATE

CHUNK = 64
MIX_WIDTH = ATT_WIDTH + HGRN_WIDTH + SSM_WIDTH

IN_SIZES = (ATT_WIDTH, KV_WIDTH, KV_WIDTH,
            HGRN_KEY_WIDTH, HGRN_KEY_WIDTH, HGRN_KEY_WIDTH,
            HGRN_WIDTH, HGRN_WIDTH,
            SSM_WIDTH, SSM_CONV_DIM, 2 * SSM_HEADS)
IN_WIDTH = sum(IN_SIZES)

N_EXPERTS = 16
EXPERT_FF = 2048
CAPACITY_FACTOR = 2

kernel_name = 'hybrid_parallel_heads_ec_moe_encoder'


def _rmsnorm(x, w):
    xf = x.astype(jnp.float32)
    y = xf * lax.rsqrt(jnp.mean(xf * xf, axis=-1, keepdims=True) + EPS)
    return (y * w.astype(jnp.float32)).astype(x.dtype)


def _axial_rope_tables(n_tok):
    rows = n_tok // GRID_W
    row = jnp.repeat(jnp.arange(rows), GRID_W).astype(jnp.float32)
    col = (jnp.arange(rows * GRID_W) % GRID_W).astype(jnp.float32)
    n_pair = HEAD_DIM // 4
    inv = ROPE_THETA ** (-jnp.arange(n_pair, dtype=jnp.float32) / n_pair)
    ang = jnp.concatenate([row[:, None] * inv, col[:, None] * inv], axis=-1)
    ang = jnp.concatenate([jnp.zeros((N_META, HEAD_DIM // 2), jnp.float32), ang], axis=0)
    return jnp.cos(ang), jnp.sin(ang)


def _apply_rope(x, cos, sin):
    half = HEAD_DIM // 2
    x1, x2 = x[..., :half], x[..., half:]
    c, s = cos[None, :, None, :], sin[None, :, None, :]
    return jnp.concatenate([x1 * c - x2 * s, x1 * s + x2 * c], axis=-1).astype(x.dtype)


def _attention_group(q, k, v, q_norm_w, k_norm_w, cos, sin):
    bsz, L, _ = q.shape
    rep = ATT_HEADS // ATT_KV_HEADS
    q = _apply_rope(_rmsnorm(q.reshape(bsz, L, ATT_HEADS, HEAD_DIM), q_norm_w), cos, sin)
    k = _apply_rope(_rmsnorm(k.reshape(bsz, L, ATT_KV_HEADS, HEAD_DIM), k_norm_w), cos, sin)
    q = q.reshape(bsz, L, ATT_KV_HEADS, rep, HEAD_DIM).transpose(0, 2, 3, 1, 4)
    k = k.transpose(0, 2, 1, 3)
    v = v.reshape(bsz, L, ATT_KV_HEADS, HEAD_DIM).transpose(0, 2, 1, 3)
    scale = HEAD_DIM ** -0.5

    def attend(qb):
        s = jnp.einsum('bgrqd,bgkd->bgrqk', qb, k).astype(jnp.float32) * scale
        p = jax.nn.softmax(s, axis=-1).astype(v.dtype)
        return jnp.einsum('bgrqk,bgkd->bgrqd', p, v)

    o_meta = attend(q[:, :, :, :N_META])
    n_real = L - N_META
    n_blk = n_real // Q_BLOCK
    qr = q[:, :, :, N_META:].reshape(bsz, ATT_KV_HEADS, rep, n_blk, Q_BLOCK, HEAD_DIM)
    o_real = lax.map(attend, jnp.moveaxis(qr, 3, 0))
    o_real = jnp.moveaxis(o_real, 0, 3).reshape(bsz, ATT_KV_HEADS, rep, n_real, HEAD_DIM)
    o = jnp.concatenate([o_meta, o_real], axis=3)
    return o.transpose(0, 3, 1, 2, 4).reshape(bsz, L, ATT_WIDTH)


def _to_chunks(a):
    bsz, h, t = a.shape[:3]
    return jnp.moveaxis(a.reshape((bsz, h, t // CHUNK, CHUNK) + a.shape[3:]), 2, 0)


def _from_chunks(o):
    o = jnp.moveaxis(o, 0, 2)
    return o.reshape(o.shape[0], o.shape[1], -1, o.shape[-1])


def _masked_exp(mask, diff):
    return jnp.where(mask, jnp.exp(jnp.where(mask, diff, 0.0)), 0.0)


def _gla_chunk_scan(q, k, v, g):
    bsz, h, _, dk = q.shape
    dv = v.shape[-1]
    mask = jnp.tril(jnp.ones((CHUNK, CHUNK), bool))

    def step(S, inp):
        qi, ki, vi, gi = inp
        cum = jnp.cumsum(gi, axis=2)
        rel = _masked_exp(mask[:, :, None], cum[:, :, :, None, :] - cum[:, :, None, :, :])
        att = jnp.einsum('bhid,bhjd,bhijd->bhij', qi, ki, rel)
        o = jnp.einsum('bhij,bhjv->bhiv', att, vi) + jnp.einsum('bhid,bhdv->bhiv', qi * jnp.exp(cum), S)
        last = cum[:, :, -1:, :]
        S = jnp.exp(last[:, :, 0, :])[..., None] * S + jnp.einsum('bhjd,bhjv->bhdv', ki * jnp.exp(last - cum), vi)
        return S, o

    S0 = jnp.zeros((bsz, h, dk, dv), jnp.float32)
    _, o = lax.scan(step, S0, (_to_chunks(q), _to_chunks(k), _to_chunks(v), _to_chunks(g)))
    return _from_chunks(o)


def _ssd_chunk_scan(q, k, v, g):
    bsz, h, _, n = q.shape
    p = v.shape[-1]
    mask = jnp.tril(jnp.ones((CHUNK, CHUNK), bool))

    def step(S, inp):
        qi, ki, vi, gi = inp
        cum = jnp.cumsum(gi, axis=-1)
        decay = _masked_exp(mask, cum[..., :, None] - cum[..., None, :])
        att = jnp.einsum('bhin,bhjn->bhij', qi, ki) * decay
        o = jnp.einsum('bhij,bhjp->bhip', att, vi) + jnp.einsum('bhin,bhnp->bhip', qi, S) * jnp.exp(cum)[..., None]
        S = jnp.exp(cum[..., -1])[..., None, None] * S + jnp.einsum(
            'bhjn,bhjp->bhnp', ki * jnp.exp(cum[..., -1:] - cum)[..., None], vi)
        return S, o

    gc = jnp.moveaxis(g.reshape(bsz, h, -1, CHUNK), 2, 0)
    S0 = jnp.zeros((bsz, h, n, p), jnp.float32)
    _, o = lax.scan(step, S0, (_to_chunks(q), _to_chunks(k), _to_chunks(v), gc))
    return _from_chunks(o)


def _bidirectional(scan_fn, q, v, k_f, g_f, k_b, g_b):
    pad = (-N_META) % CHUNK

    def prep(a):
        return jnp.pad(a.astype(jnp.float32), [(0, 0), (0, 0), (pad, 0)] + [(0, 0)] * (a.ndim - 3))

    q, v, k_f, g_f, k_b, g_b = (prep(a) for a in (q, v, k_f, g_f, k_b, g_b))
    rev = lambda a: jnp.flip(a, axis=2)
    o = scan_fn(q, k_f, v, g_f) + rev(scan_fn(rev(q), rev(k_b), rev(v), rev(g_b)))
    return o[:, :, pad:]


def _hgrn2_group(q, f_fwd, f_bwd, i, gate, lb_fwd, lb_bwd, norm_w):
    bsz, L, _ = q.shape
    heads = lambda a, d: a.reshape(bsz, L, HGRN_HEADS, d).transpose(0, 2, 1, 3)

    def log_forget(f_pre, lb):
        xf = f_pre.astype(jnp.float32)
        return jax.nn.log_sigmoid(xf) + jnp.log1p(lb * jnp.exp(jnp.minimum(-xf, EXP_CLIP)))

    g_f = heads(jnp.minimum(log_forget(f_fwd, lb_fwd), 0.0), HGRN_EXPAND)
    g_b = heads(jnp.minimum(log_forget(f_bwd, lb_bwd), 0.0), HGRN_EXPAND)
    k_f, k_b = -jnp.expm1(g_f), -jnp.expm1(g_b)
    qh = heads(jax.nn.silu(q), HGRN_EXPAND)
    vh = heads(i, HGRN_HEAD_V)
    o = _bidirectional(_gla_chunk_scan, qh, vh, k_f, g_f, k_b, g_b)
    o = o.transpose(0, 2, 1, 3).astype(q.dtype)
    o = _rmsnorm(o, norm_w.reshape(HGRN_HEADS, HGRN_HEAD_V)).reshape(bsz, L, HGRN_WIDTH)
    return o * jax.nn.silu(gate)


def _mamba2_group(z, xbc, dt_pre, conv_w, conv_b, dt_bias, a_log, d_skip, norm_w):
    bsz, L, _ = z.shape
    half = SSM_CONV // 2
    xbc = lax.conv_general_dilated(xbc, conv_w.T[:, None, :], window_strides=(1,),
                                   padding=[(half, half)], dimension_numbers=('NWC', 'WIO', 'NWC'),
                                   feature_group_count=SSM_CONV_DIM) + conv_b
    xbc = jax.nn.silu(xbc)
    xs, bm, cm = jnp.split(xbc, [SSM_WIDTH, SSM_WIDTH + SSM_GROUPS * SSM_STATE], axis=-1)
    xh = xs.reshape(bsz, L, SSM_HEADS, SSM_HEAD_DIM).transpose(0, 2, 1, 3)
    rep = SSM_HEADS // SSM_GROUPS
    expand = lambda a: jnp.repeat(a.reshape(bsz, L, SSM_GROUPS, SSM_STATE), rep, axis=2).transpose(0, 2, 1, 3)
    bh, ch = expand(bm), expand(cm)
    dt = jax.nn.softplus(dt_pre.astype(jnp.float32).reshape(bsz, L, 2, SSM_HEADS) + dt_bias)
    dt = dt.transpose(2, 0, 3, 1)
    A = -jnp.exp(a_log.astype(jnp.float32))
    g = dt * A[:, None, :, None]
    y = _bidirectional(_ssd_chunk_scan, ch, xh, bh * dt[0][..., None], g[0], bh * dt[1][..., None], g[1])
    y = y + d_skip[:, None, None] * xh
    y = y.transpose(0, 2, 1, 3).reshape(bsz, L, SSM_WIDTH).astype(z.dtype)
    return _rmsnorm(y * jax.nn.silu(z), norm_w)


def _expert_choice_ffn(h, router_w, w_gate, w_up, w_down):
    bsz, L, d = h.shape
    cap = CAPACITY_FACTOR * L // N_EXPERTS
    aff = jax.nn.softmax(jnp.einsum('bld,de->ble', h, router_w).astype(jnp.float32), axis=-1)
    gate, idx = lax.top_k(jnp.swapaxes(aff, 1, 2), cap)
    xs = jax.vmap(lambda hb, ib: hb[ib])(h, idx)
    a = jnp.einsum('becd,edf->becf', xs, w_gate)
    u = jnp.einsum('becd,edf->becf', xs, w_up)
    out = jnp.einsum('becf,efd->becd', jax.nn.silu(a) * u, w_down)
    out = out * gate[..., None].astype(out.dtype)
    return jax.vmap(lambda ob, ib: jax.ops.segment_sum(ob.reshape(-1, d), ib.reshape(-1), num_segments=L))(out, idx)


def setup_inputs(seed: int = 0) -> dict:
    key = jax.random.key(seed)
    ks = jax.random.split(key, 24)
    f32 = jnp.float32
    nrm = lambda k, shape, scale: scale * jax.random.normal(k, shape, f32)
    gain = lambda k, shape: 1.0 + 0.02 * jax.random.normal(k, shape, f32)
    dt0 = jnp.exp(jax.random.uniform(ks[10], (DEPTH, 2, SSM_HEADS), f32, math.log(1e-3), math.log(1e-1)))
    return {
        'x': jax.random.normal(ks[0], (BATCH, SEQ, D_MODEL), f32),
        'meta_tokens': nrm(ks[1], (N_META, D_MODEL), 1.0),
        'norm1_w': gain(ks[2], (DEPTH, D_MODEL)),
        'w_in': nrm(ks[3], (DEPTH, D_MODEL, IN_WIDTH), D_MODEL ** -0.5),
        'q_norm_w': gain(ks[4], (DEPTH, HEAD_DIM)),
        'k_norm_w': gain(ks[5], (DEPTH, HEAD_DIM)),
        'attn_norm_w': gain(ks[6], (DEPTH, ATT_WIDTH)),
        'hgrn_lb': nrm(ks[7], (2, DEPTH, HGRN_KEY_WIDTH), 0.1),
        'hgrn_norm_w': gain(ks[8], (DEPTH, HGRN_WIDTH)),
        'conv_w': nrm(ks[9], (DEPTH, SSM_CONV_DIM, SSM_CONV), SSM_CONV ** -0.5),
        'conv_b': nrm(ks[11], (DEPTH, SSM_CONV_DIM), 0.01),
        'dt_bias': dt0 + jnp.log(-jnp.expm1(-dt0)),
        'a_log': jnp.log(jax.random.uniform(ks[12], (DEPTH, 2, SSM_HEADS), f32, 1.0, 16.0)),
        'd_skip': gain(ks[13], (DEPTH, SSM_HEADS)),
        'ssm_norm_w': gain(ks[14], (DEPTH, SSM_WIDTH)),
        'w_out': nrm(ks[15], (DEPTH, MIX_WIDTH, D_MODEL), MIX_WIDTH ** -0.5),
        'norm2_w': gain(ks[16], (DEPTH, D_MODEL)),
        'router_w': nrm(ks[17], (DEPTH, D_MODEL, N_EXPERTS), D_MODEL ** -0.5),
        'w_gate': nrm(ks[18], (DEPTH, N_EXPERTS, D_MODEL, EXPERT_FF), D_MODEL ** -0.5),
        'w_up': nrm(ks[19], (DEPTH, N_EXPERTS, D_MODEL, EXPERT_FF), D_MODEL ** -0.5),
        'w_down': nrm(ks[20], (DEPTH, N_EXPERTS, EXPERT_FF, D_MODEL), EXPERT_FF ** -0.5),
    }


def reference(x, meta_tokens, norm1_w, w_in, q_norm_w, k_norm_w, attn_norm_w, hgrn_lb, hgrn_norm_w,
              conv_w, conv_b, dt_bias, a_log, d_skip, ssm_norm_w, w_out, norm2_w, router_w,
              w_gate, w_up, w_down):
    bsz, n_tok, _ = x.shape
    h = jnp.concatenate([jnp.broadcast_to(meta_tokens[None].astype(x.dtype), (bsz, N_META, D_MODEL)), x], axis=1)
    cos, sin = _axial_rope_tables(n_tok)
    p = jax.nn.softmax(hgrn_lb.astype(jnp.float32), axis=1)
    lower_bounds = jnp.clip(jnp.cumsum(p, axis=1) - p[:, :1], 0.0, 1.0)
    split_points = np.cumsum(IN_SIZES)[:-1].tolist()
    for l in range(DEPTH):
        u = _rmsnorm(h, norm1_w[l])
        proj = jnp.einsum('bld,dn->bln', u, w_in[l])
        aq, ak, av, hq, hf, hb, hi, hg, sz, sxbc, sdt = jnp.split(proj, split_points, axis=-1)
        att = _attention_group(aq, ak, av, q_norm_w[l], k_norm_w[l], cos, sin)
        rec = _hgrn2_group(hq, hf, hb, hi, hg, lower_bounds[0, l], lower_bounds[1, l], hgrn_norm_w[l])
        ssm = _mamba2_group(sz, sxbc, sdt, conv_w[l], conv_b[l], dt_bias[l], a_log[l], d_skip[l], ssm_norm_w[l])
        mix = jnp.concatenate([_rmsnorm(att, attn_norm_w[l]), rec, ssm], axis=-1)
        h = h + jnp.einsum('blm,md->bld', mix, w_out[l]).astype(h.dtype)
        h = h + _expert_choice_ffn(_rmsnorm(h, norm2_w[l]), router_w[l], w_gate[l], w_up[l], w_down[l]).astype(h.dtype)
    return h[:, N_META:]
```

```cpp
#include <hip/hip_runtime.h>
#include <cstdio>
#include <cstdint>

#define LAS __attribute__((address_space(3)))
typedef unsigned short bf16_t;
typedef short bf16x8 __attribute__((ext_vector_type(8)));
typedef float f32x4 __attribute__((ext_vector_type(4)));
typedef float f32x2 __attribute__((ext_vector_type(2)));
typedef unsigned u32x4 __attribute__((ext_vector_type(4)));
typedef unsigned u32x2 __attribute__((ext_vector_type(2)));

#ifndef PH_MASK
#define PH_MASK 0xFFFFF
#endif
#ifndef LAUNCH_PER_PHASE
#define LAUNCH_PER_PHASE 0
#endif

constexpr int DM = 1024, NB = 8, SEQ = 4096, DEPTH = 4, NMETA = 16, LTOK = SEQ + NMETA;
constexpr int ROWS_REAL = NB * SEQ, ROWS = NB * LTOK, ROWS_PAD = 33024;
constexpr int INW = 4624, PROJW = 4608;
constexpr int C_AQ = 0, C_AK = 512, C_AV = 640, C_HQ = 768, C_HF = 1280, C_HB = 1792, C_HI = 2304, C_HG = 2816, C_SZ = 3328, C_XBC = 3840, C_DT = 4608;
constexpr int MIXW = 1536, NEXP = 16, FF = 2048, CAP = 514, EROWS = 4352, MOE_ROWS = NEXP * EROWS;
constexpr float EPS = 1e-6f;
constexpr float QSCALE = 0.125f * 1.4426950408889634f;

constexpr size_t MiB = 1u << 20;
constexpr size_t WS_CTL = 0, CTL_BYTES = 1 * MiB;
constexpr size_t WS_ROPE = 1 * MiB;
constexpr size_t WS_LB = WS_ROPE + 2u * 4096 * 32 * 4;
constexpr size_t WS_H = 3 * MiB;
constexpr size_t WS_U = 133 * MiB;
constexpr size_t WS_DT = 198 * MiB;
constexpr size_t WS_AFFT = 201 * MiB;
constexpr size_t WS_SEL = 204 * MiB;
constexpr size_t WS_RIDX = 207 * MiB;
constexpr size_t WS_GATE = 208 * MiB;
constexpr size_t WS_XBC = 209 * MiB;
constexpr size_t WS_ATT = 258 * MiB;
constexpr size_t WS_OF = 291 * MiB, WS_OB = 324 * MiB, WS_YF = 357 * MiB, WS_YB = 390 * MiB;
constexpr size_t WS_MIX = 423 * MiB;
constexpr size_t WS_PROJ = 520 * MiB;
constexpr size_t WS_ACT = WS_PROJ;
constexpr size_t WS_Y = 811 * MiB;
constexpr size_t WS_WIN = 947 * MiB;
constexpr size_t WS_WOUT = 956 * MiB;
constexpr size_t WS_WGU = 959 * MiB;
constexpr size_t WS_WD = 1087 * MiB;
constexpr size_t WS_END = 1151 * MiB;

constexpr int LDS_BYTES = 147456;
constexpr int LDS_MISC = 145408;

__device__ __forceinline__ unsigned cvt_pk_bf16(float lo, float hi) { unsigned r; asm volatile("v_cvt_pk_bf16_f32 %0, %1, %2" : "=v"(r) : "v"(lo), "v"(hi)); return r; }
__device__ __forceinline__ bf16_t f2bf(float f) { return (bf16_t)(cvt_pk_bf16(f, 0.f) & 0xffffu); }
__device__ __forceinline__ float bf2f(bf16_t b) { return __uint_as_float(((unsigned)b) << 16); }
__device__ __forceinline__ float bflo(unsigned w) { return __uint_as_float(w << 16); }
__device__ __forceinline__ float bfhi(unsigned w) { return __uint_as_float(w & 0xffff0000u); }
__device__ __forceinline__ float wave_sum(float v) {
#pragma unroll
    for (int o = 1; o < 64; o <<= 1) v += __shfl_xor(v, o);
    return v;
}
__device__ __forceinline__ float silu_f(float x) { return x * __builtin_amdgcn_rcpf(1.0f + __expf(-x)); }
__device__ __forceinline__ int row_of(int b, int t) { return t < NMETA ? ROWS_REAL + b * NMETA + t : b * SEQ + (t - NMETA); }

#define XB_TMO      128
#define XB_XCNT(j)  (256  + 64 * (j))
#define XB_XSUB(j)  (1280 + 64 * (j))
#define XB_XGEN(j)  (2304 + 64 * (j))
#define XB_TOP      3328
#define XB_TOPGEN   3392
#define XCD_BAR_WORDS 3456
#define XB_SPIN_CAP (1u << 18)
__device__ __forceinline__ unsigned xb_ld(unsigned* p)              { return __hip_atomic_load(p, __ATOMIC_RELAXED, __HIP_MEMORY_SCOPE_AGENT); }
__device__ __forceinline__ unsigned xb_add(unsigned* p, unsigned v) { return __hip_atomic_fetch_add(p, v, __ATOMIC_RELAXED, __HIP_MEMORY_SCOPE_AGENT); }
__device__ __forceinline__ unsigned xb_xcc_id() { return (unsigned)__builtin_amdgcn_s_getreg((3 << 11) | 20) & 0xFu; }
#define XB_SPIN(cond, bar) do { unsigned _sp = 0; while (cond) { __builtin_amdgcn_s_sleep(1); \
    if ((++_sp & 255u) == 0u) { if (xb_ld(&(bar)[XB_TMO])) break; if (_sp > XB_SPIN_CAP) { atomicAdd(&(bar)[XB_TMO], 1u); break; } } } } while (0)
struct XcdBarrier { unsigned* bar; unsigned x; volatile LAS unsigned* st; };
__device__ __forceinline__ XcdBarrier xcd_barrier_post(unsigned* bar, volatile LAS unsigned* st) {
    XcdBarrier b; b.bar = bar; b.x = xb_xcc_id(); b.st = st;
    if (threadIdx.x == 0) (void)xb_add(&bar[XB_XCNT(b.x)], 1u);
    return b;
}
__device__ __forceinline__ void xcd_barrier_complete(unsigned* bar, unsigned x, unsigned& nloc, unsigned& nx) {
    const unsigned G = gridDim.x * gridDim.y * gridDim.z;
    unsigned sum, cnt, mine, sp = 0u;
    for (;;) {
        sum = 0u; cnt = 0u; mine = 0u;
#pragma unroll
        for (unsigned j = 0; j < 16; ++j) { const unsigned c = xb_ld(&bar[XB_XCNT(j)]); sum += c; cnt += (c > 0u) ? 1u : 0u; mine = (j == x) ? c : mine; }
        if (sum == G) break;
        __builtin_amdgcn_s_sleep(1);
        if ((++sp & 255u) == 0u) { if (xb_ld(&bar[XB_TMO])) break; if (sp > XB_SPIN_CAP) { atomicAdd(&bar[XB_TMO], 1u); break; } }
    }
    nloc = mine > 0u ? mine : 1u; nx = cnt > 0u ? cnt : 1u;
}
__device__ __forceinline__ void xcd_barrier(const XcdBarrier& b) {
    asm volatile("s_waitcnt vmcnt(0)" ::: "memory");
    __syncthreads();
    if (threadIdx.x == 0) {
        unsigned* bar = b.bar;
        __builtin_amdgcn_s_waitcnt(0);
        unsigned nloc = b.st[0], nx = b.st[1];
        if (nloc == 0u) { xcd_barrier_complete(bar, b.x, nloc, nx); b.st[0] = nloc; b.st[1] = nx; }
        const unsigned old = xb_add(&bar[XB_XSUB(b.x)], 1u);
        const unsigned gen = old / nloc;
        if (old + 1u == (gen + 1u) * nloc) {
            __builtin_amdgcn_fence(__ATOMIC_RELEASE, "agent");
            asm volatile("s_waitcnt vmcnt(0)" ::: "memory");
            const unsigned og = xb_add(&bar[XB_TOP], 1u);
            const unsigned tg = og / nx;
            if (og + 1u == (tg + 1u) * nx) xb_add(&bar[XB_TOPGEN], 1u);
            else XB_SPIN(xb_ld(&bar[XB_TOPGEN]) == tg, bar);
            __builtin_amdgcn_fence(__ATOMIC_ACQUIRE, "agent");
            xb_add(&bar[XB_XGEN(b.x)], 1u);
            asm volatile("s_waitcnt vmcnt(0)" ::: "memory");
        } else {
            XB_SPIN(xb_ld(&bar[XB_XGEN(b.x)]) == gen, bar);
            __builtin_amdgcn_fence(__ATOMIC_ACQUIRE, "agent");
            asm volatile("s_waitcnt vmcnt(0)" ::: "memory");
        }
    }
    __syncthreads();
}

namespace pg {
constexpr int BM = 256, BK = 64, HALF = 128, HTB = HALF * BK * 2, STAGE_BYTES = 8 * HTB;
__device__ __forceinline__ int lds_byte(int r, int c) { const int st = (r >> 4) * 2 + (c >> 5), rr = r & 15, cc = c & 31, ob = rr * 64 + cc * 2; return st * 1024 + (ob ^ (((ob >> 9) & 1) << 5)); }
__device__ __forceinline__ void stage_rc(int b, int& R, int& C) { const int st = b / 1024, sb = b % 1024, swz = sb ^ (((sb >> 9) & 1) << 5); R = (st >> 1) * 16 + swz / 64; C = (st & 1) * 32 + (swz % 64) / 2; }
__device__ __forceinline__ int perm32(int rho) { const int n = rho >> 4, i = rho & 15; return 8 * (i >> 2) + 4 * n + (i & 3); }
struct Unit { int pm, pn, e; };

template <class Epi, class Sched>
__device__ __forceinline__ void gemm_phase(LAS unsigned char* lds, const int wid_in, const char* Abase, const int K, const Sched& S, const Epi& E) {
    int wid = wid_in; asm volatile("" : "+s"(wid));
    unsigned z_ = 0u; asm volatile("" : "+s"(z_));
    const int lane = (int)__builtin_amdgcn_mbcnt_hi(~0u, __builtin_amdgcn_mbcnt_lo(~0u, z_)), tid = wid * 64 + lane;
    const int wr = wid >> 2, wc = wid & 3, fr = lane & 15, fq = lane >> 4;
    const int nt = K / BK;
    constexpr bool GA = Sched::GATHER;
    unsigned voffA[2], voffB[2];
#pragma unroll
    for (int i = 0; i < 2; ++i) { int R, C; stage_rc(tid * 16 + i * 8192, R, C); const int Rb = Epi::PERM ? ((R & ~31) + perm32(R & 31)) : R; voffA[i] = (unsigned)(R * K + C) * 2u; voffB[i] = (unsigned)(Rb * K + C) * 2u; }
    const size_t kstep = (size_t)(BK * 2);
    const size_t hstep = (size_t)HALF * K * 2;
    const unsigned ldsw = (unsigned)wid * 1024u;
    const int aoff = lds_byte(wr * 64 + fr, fq * 8), boff = lds_byte(wc * 32 + fr, fq * 8);
#define PG_SA(b, h) (((b) * 2 + (h)) * HTB)
#define PG_SB(b, h) ((4 + (b) * 2 + (h)) * HTB)
#define PG_STAGE(bufoff, gbase, voff) do { _Pragma("unroll") for (int _i = 0; _i < 2; ++_i) \
        __builtin_amdgcn_global_load_lds((const unsigned*)((const char*)(gbase) + (voff)[_i]), (LAS unsigned*)(lds + (bufoff) + ldsw + _i * 8192), 16, 0, 0); } while (0)
#define PG_STAGE_A(bufoff, ab, av, h, koff) do { if (GA) { const u32x2 o2_ = *(const LAS u32x2*)(aol + 2 * (h)); unsigned ov_[2] = {o2_.x, o2_.y}; PG_STAGE(bufoff, Abase + (koff), ov_); } else { PG_STAGE(bufoff, (ab) + (h) * hstep + (koff), voffA); } } while (0)
#define PG_LDA(dst, b, h) do { _Pragma("unroll") for (int m = 0; m < 4; ++m) _Pragma("unroll") for (int k = 0; k < 2; ++k) dst[m][k] = *(const LAS bf16x8*)(lds + PG_SA(b, h) + aoff + m * 2048 + k * 1024); } while (0)
#define PG_LDB(dst, b, h) do { _Pragma("unroll") for (int n = 0; n < 2; ++n) _Pragma("unroll") for (int k = 0; k < 2; ++k) dst[n][k] = *(const LAS bf16x8*)(lds + PG_SB(b, h) + boff + n * 2048 + k * 1024); } while (0)
#define PG_MMA(ai, bj, At, Bt) do { __builtin_amdgcn_s_setprio(1); _Pragma("unroll") for (int m = 0; m < 4; ++m) _Pragma("unroll") for (int n = 0; n < 2; ++n) _Pragma("unroll") for (int k = 0; k < 2; ++k) \
        acc[ai][bj][m][n] = __builtin_amdgcn_mfma_f32_16x16x32_bf16(Bt[n][k], At[m][k], acc[ai][bj][m][n], 0, 0, 0); __builtin_amdgcn_s_setprio(0); } while (0)
#define PG_WAIT_V(n) asm volatile("s_waitcnt vmcnt(" #n ")" ::: "memory")
#define PG_WAIT_L(n) asm volatile("s_waitcnt lgkmcnt(" #n ")" ::: "memory")
#define PG_BAR __builtin_amdgcn_s_barrier()
#define PG_SCHED __builtin_amdgcn_sched_barrier(0)
    Unit cur, nxt; int ui = 0;
    if (!S.next(0, cur)) return;
    LAS int* rtab = (LAS int*)(lds + STAGE_BYTES);
    LAS unsigned* aol = (LAS unsigned*)(lds + STAGE_BYTES + 2048) + tid * 4;
#define PG_AO_FROM_TABLE(tb) do { u32x4 o_; { int R_, C_; stage_rc(tid * 16, R_, C_); o_.x = (unsigned)(rtab[(tb) * 256 + R_] * K + C_) * 2u; o_.z = (unsigned)(rtab[(tb) * 256 + 128 + R_] * K + C_) * 2u; } \
        { int R_, C_; stage_rc(tid * 16 + 8192, R_, C_); o_.y = (unsigned)(rtab[(tb) * 256 + R_] * K + C_) * 2u; o_.w = (unsigned)(rtab[(tb) * 256 + 128 + R_] * K + C_) * 2u; } *(LAS u32x4*)aol = o_; } while (0)
    if (GA) { if (tid < 256) rtab[tid] = S.arow(cur, tid); __syncthreads(); PG_AO_FROM_TABLE(0); }
    const char* cA = GA ? Abase : Abase + S.aunit(cur, K);
    const char* cB = S.bptr(cur, K);
    f32x4 acc[2][2][4][2];
#pragma unroll
    for (int a = 0; a < 2; ++a)
#pragma unroll
        for (int b = 0; b < 2; ++b)
#pragma unroll
            for (int m = 0; m < 4; ++m)
#pragma unroll
                for (int n = 0; n < 2; ++n) acc[a][b][m][n] = (f32x4){0.f, 0.f, 0.f, 0.f};
    bf16x8 At[4][2], B0[2][2], B1[2][2];
    PG_STAGE(PG_SB(0, 0), cB, voffB); PG_STAGE_A(PG_SA(0, 0), cA, 0, 0, 0); PG_STAGE(PG_SB(0, 1), cB + hstep, voffB); PG_STAGE_A(PG_SA(0, 1), cA, 0, 1, 0);
    if (wr == 1) PG_BAR;
    PG_WAIT_V(4); PG_BAR;
    PG_STAGE(PG_SB(1, 0), cB + kstep, voffB); PG_STAGE_A(PG_SA(1, 0), cA, 0, 0, kstep); PG_STAGE(PG_SB(1, 1), cB + hstep + kstep, voffB);
    PG_WAIT_V(6); PG_BAR;
    for (;;) {
        const bool has_next = S.next(ui + 1, nxt);
        const char* nA = cA; const char* nB = cB;
        if (has_next) { if (GA) { if (wid < 4) __builtin_amdgcn_global_load_lds((const unsigned*)S.arowp(nxt, tid), (LAS unsigned*)(rtab + ((ui + 1) & 1) * 256 + wid * 64), 4, 0, 0); }
            else nA = Abase + S.aunit(nxt, K); nB = S.bptr(nxt, K); }
        for (int t = 0; t < nt; t += 2) {
            const bool last = (t == nt - 2);
            const size_t k1 = (size_t)(t + 1) * kstep, k2 = last ? 0 : (size_t)(t + 2) * kstep, k3 = k2 + kstep;
            const char* a2 = last ? nA : cA; const char* b2 = last ? nB : cB;
            PG_LDB(B0, 0, 0); PG_SCHED; PG_LDA(At, 0, 0); PG_STAGE_A(PG_SA(1, 1), cA, 0, 1, k1);
            if (GA && last && has_next) { PG_AO_FROM_TABLE((ui + 1) & 1); }
            PG_WAIT_L(8); PG_BAR; PG_WAIT_L(0); PG_MMA(0, 0, At, B0); PG_BAR; PG_SCHED;
            PG_LDB(B1, 0, 1); PG_STAGE(PG_SB(0, 0), b2 + k2, voffB);
            PG_BAR; PG_WAIT_L(0); PG_MMA(0, 1, At, B1); PG_BAR;
            PG_LDA(At, 0, 1); PG_STAGE_A(PG_SA(0, 0), a2, 0, 0, k2);
            PG_BAR; PG_WAIT_L(0); PG_MMA(1, 0, At, B0); PG_BAR; PG_SCHED;
            PG_STAGE(PG_SB(0, 1), b2 + hstep + k2, voffB);
            PG_WAIT_V(6); PG_BAR; PG_MMA(1, 1, At, B1); PG_BAR;
            PG_LDB(B0, 1, 0); PG_SCHED; PG_LDA(At, 1, 0); PG_STAGE_A(PG_SA(0, 1), a2, 0, 1, k2);
            PG_WAIT_L(8); PG_BAR; PG_WAIT_L(0); PG_MMA(0, 0, At, B0); PG_BAR; PG_SCHED;
            PG_LDB(B1, 1, 1); PG_STAGE(PG_SB(1, 0), b2 + k3, voffB);
            PG_BAR; PG_WAIT_L(0); PG_MMA(0, 1, At, B1); PG_BAR;
            PG_LDA(At, 1, 1); PG_STAGE_A(PG_SA(1, 0), a2, 0, 0, k3);
            PG_BAR; PG_WAIT_L(0); PG_MMA(1, 0, At, B0); PG_BAR; PG_SCHED;
            PG_STAGE(PG_SB(1, 1), b2 + hstep + k3, voffB);
            PG_WAIT_V(6); PG_BAR; PG_MMA(1, 1, At, B1); PG_BAR;
        }
        E(acc, cur, wr, wc, fr, fq);
        if (!has_next) break;
#pragma unroll
        for (int a = 0; a < 2; ++a)
#pragma unroll
            for (int b = 0; b < 2; ++b)
#pragma unroll
                for (int m = 0; m < 4; ++m)
#pragma unroll
                    for (int n = 0; n < 2; ++n) acc[a][b][m][n] = (f32x4){0.f, 0.f, 0.f, 0.f};
        cur = nxt; cA = nA; cB = nB; ++ui;
    }
    PG_WAIT_V(0);
    if (wr == 0) PG_BAR;
    PG_BAR;
#undef PG_SA
#undef PG_SB
#undef PG_STAGE
#undef PG_STAGE_A
#undef PG_AO_FROM_TABLE
#undef PG_LDA
#undef PG_LDB
#undef PG_MMA
#undef PG_WAIT_V
#undef PG_WAIT_L
#undef PG_BAR
#undef PG_SCHED
}

struct SchedDense {
    static constexpr bool GATHER = false;
    int nM, nN, nwg, G, c; const char* Bt;
    __device__ __forceinline__ bool next(int i, Unit& u) const {
        const long L = (long)i * G + c; if (L >= nwg) return false;
        int wgid = (int)L; { const int q = nwg / 8, r = nwg % 8, xcd = wgid % 8, off = wgid / 8; wgid = (xcd < r ? xcd * (q + 1) : r * (q + 1) + (xcd - r) * q) + off; }
        const int nig = 8 * nN, gid = wgid / nig, fm = gid * 8, gsz = (nM - fm) < 8 ? (nM - fm) : 8;
        u.pm = fm + ((wgid % nig) % gsz); u.pn = (wgid % nig) / gsz; u.e = 0; return true;
    }
    __device__ __forceinline__ int arow(const Unit&, int) const { return 0; }
    __device__ __forceinline__ const int* arowp(const Unit&, int) const { return nullptr; }
    __device__ __forceinline__ size_t aunit(const Unit& u, int K) const { return (size_t)u.pm * 256 * K * 2; }
    __device__ __forceinline__ const char* bptr(const Unit& u, int K) const { return Bt + (size_t)u.pn * 256 * K * 2; }
};
struct SchedMoE1 {
    static constexpr bool GATHER = true;
    int G, c; const int* ridx; const char* Bt;
    __device__ __forceinline__ bool next(int i, Unit& u) const {
        const int L = i * G + c; if (L >= NEXP * 17 * 16) return false;
        u.e = L / 272; const int rem = L % 272; u.pm = rem % 17; u.pn = rem / 17; return true;
    }
    __device__ __forceinline__ int arow(const Unit& u, int r) const { return ridx[u.e * EROWS + u.pm * 256 + r]; }
    __device__ __forceinline__ const int* arowp(const Unit& u, int r) const { return ridx + u.e * EROWS + u.pm * 256 + r; }
    __device__ __forceinline__ size_t aunit(const Unit&, int) const { return 0; }
    __device__ __forceinline__ const char* bptr(const Unit& u, int K) const { return Bt + ((size_t)u.e * 4096 + (size_t)u.pn * 256) * K * 2; }
};
struct SchedMoE2 {
    static constexpr bool GATHER = false;
    int G, c; const char* Bt;
    __device__ __forceinline__ bool next(int i, Unit& u) const {
        const int L = i * G + c; if (L >= NEXP * 17 * 4) return false;
        u.e = L / 68; const int rem = L % 68; u.pm = rem % 17; u.pn = rem / 17; return true;
    }
    __device__ __forceinline__ int arow(const Unit&, int) const { return 0; }
    __device__ __forceinline__ const int* arowp(const Unit&, int) const { return nullptr; }
    __device__ __forceinline__ size_t aunit(const Unit& u, int K) const { return (size_t)(u.e * EROWS + u.pm * 256) * K * 2; }
    __device__ __forceinline__ const char* bptr(const Unit& u, int K) const { return Bt + ((size_t)u.e * 1024 + (size_t)u.pn * 256) * K * 2; }
};

struct EpiProj {
    static constexpr bool PERM = true;
    bf16_t* O; int ldc;
    __device__ __forceinline__ void operator()(const f32x4 (&acc)[2][2][4][2], const Unit& u, int wr, int wc, int fr, int fq) const {
        const int row0 = u.pm * BM + wr * 64 + fr, col0 = u.pn * BM + wc * 32 + 8 * fq;
#pragma unroll
        for (int ai = 0; ai < 2; ++ai)
#pragma unroll
            for (int m = 0; m < 4; ++m) { bf16_t* rowp = O + (size_t)(row0 + ai * HALF + m * 16) * ldc + col0;
#pragma unroll
                for (int bj = 0; bj < 2; ++bj) { const f32x4 v0 = acc[ai][bj][m][0], v1 = acc[ai][bj][m][1];
                    u32x4 w; w.x = cvt_pk_bf16(v0[0], v0[1]); w.y = cvt_pk_bf16(v0[2], v0[3]); w.z = cvt_pk_bf16(v1[0], v1[1]); w.w = cvt_pk_bf16(v1[2], v1[3]);
                    *(u32x4*)(rowp + bj * HALF) = w; } }
    }
};
struct EpiResid {
    static constexpr bool PERM = false;
    float* H; int ldc;
    __device__ __forceinline__ void operator()(const f32x4 (&acc)[2][2][4][2], const Unit& u, int wr, int wc, int fr, int fq) const {
        const int row0 = u.pm * BM + wr * 64 + fr, col0 = u.pn * BM + wc * 32 + 4 * fq;
#pragma unroll
        for (int ai = 0; ai < 2; ++ai)
#pragma unroll
            for (int m = 0; m < 4; ++m) { float* rowp = H + (size_t)(row0 + ai * HALF + m * 16) * ldc + col0;
#pragma unroll
                for (int bj = 0; bj < 2; ++bj)
#pragma unroll
                    for (int n = 0; n < 2; ++n) { f32x4* p = (f32x4*)(rowp + bj * HALF + n * 16); *p = *p + acc[ai][bj][m][n]; } }
    }
};
struct EpiGateUp {
    static constexpr bool PERM = true;
    bf16_t* ACT;
    __device__ __forceinline__ void operator()(const f32x4 (&acc)[2][2][4][2], const Unit& u, int wr, int wc, int fr, int fq) const {
        const int row0 = u.e * EROWS + u.pm * BM + wr * 64 + fr, col0 = u.pn * 128 + wc * 32 + 8 * fq;
#pragma unroll
        for (int ai = 0; ai < 2; ++ai)
#pragma unroll
            for (int m = 0; m < 4; ++m) { bf16_t* p = ACT + (size_t)(row0 + ai * HALF + m * 16) * FF + col0;
                float r[8];
#pragma unroll
                for (int n = 0; n < 2; ++n)
#pragma unroll
                    for (int j = 0; j < 4; ++j) r[n * 4 + j] = silu_f(acc[ai][0][m][n][j]) * acc[ai][1][m][n][j];
                u32x4 w; w.x = cvt_pk_bf16(r[0], r[1]); w.y = cvt_pk_bf16(r[2], r[3]); w.z = cvt_pk_bf16(r[4], r[5]); w.w = cvt_pk_bf16(r[6], r[7]);
                *(u32x4*)p = w; }
    }
};
struct EpiDown {
    static constexpr bool PERM = true;
    bf16_t* Y; const float* gate;
    __device__ __forceinline__ void operator()(const f32x4 (&acc)[2][2][4][2], const Unit& u, int wr, int wc, int fr, int fq) const {
        const int row0 = u.e * EROWS + u.pm * BM + wr * 64 + fr, col0 = u.pn * BM + wc * 32 + 8 * fq;
#pragma unroll
        for (int ai = 0; ai < 2; ++ai)
#pragma unroll
            for (int m = 0; m < 4; ++m) { const int row = row0 + ai * HALF + m * 16; const float g = gate[row]; bf16_t* rowp = Y + (size_t)row * DM + col0;
#pragma unroll
                for (int bj = 0; bj < 2; ++bj) { const f32x4 v0 = acc[ai][bj][m][0] * g, v1 = acc[ai][bj][m][1] * g;
                    u32x4 w; w.x = cvt_pk_bf16(v0[0], v0[1]); w.y = cvt_pk_bf16(v0[2], v0[3]); w.z = cvt_pk_bf16(v1[0], v1[1]); w.w = cvt_pk_bf16(v1[2], v1[3]);
                    *(u32x4*)(rowp + bj * HALF) = w; } }
    }
};
}

struct Args { const float* in[21]; float* out; unsigned char* ws; int ph_lo, ph_hi; };
enum { I_X = 0, I_META, I_NORM1, I_WIN, I_QNW, I_KNW, I_ANW, I_HLB, I_HNW, I_CONVW, I_CONVB, I_DTB, I_ALOG, I_DSKIP, I_SNW, I_WOUT, I_NORM2, I_ROUTER, I_WGATE, I_WUP, I_WDOWN };

struct Ctx {
    const Args* a; unsigned char* ws; char* smem; int tid, lane, wid, G, bid;
#define CTX_PTR(name, type, off) __device__ __forceinline__ type* name() const { return (type*)(ws + (off)); }
    CTX_PTR(H, float, WS_H) CTX_PTR(U, bf16_t, WS_U) CTX_PTR(DT, float, WS_DT) CTX_PTR(AFFT, float, WS_AFFT) CTX_PTR(SEL, int, WS_SEL) CTX_PTR(RIDX, int, WS_RIDX) CTX_PTR(GATE, float, WS_GATE)
    CTX_PTR(XBC, bf16_t, WS_XBC) CTX_PTR(ATT, bf16_t, WS_ATT) CTX_PTR(OF, bf16_t, WS_OF) CTX_PTR(OB, bf16_t, WS_OB) CTX_PTR(YF, bf16_t, WS_YF) CTX_PTR(YB, bf16_t, WS_YB)
    CTX_PTR(MIX, bf16_t, WS_MIX) CTX_PTR(PROJ, bf16_t, WS_PROJ) CTX_PTR(ACT, bf16_t, WS_ACT) CTX_PTR(Y, bf16_t, WS_Y)
    CTX_PTR(WIN, bf16_t, WS_WIN) CTX_PTR(WOUT, bf16_t, WS_WOUT) CTX_PTR(WGU, bf16_t, WS_WGU) CTX_PTR(WD, bf16_t, WS_WD) CTX_PTR(ROPE, float, WS_ROPE) CTX_PTR(LB, float, WS_LB)
#undef CTX_PTR
};

__device__ __forceinline__ int og(int v) { asm volatile("" : "+s"(v)); return v; }
__device__ __forceinline__ Ctx fresh(const Ctx& c0) {
    Ctx c = c0; int w_ = c0.wid, g_ = c0.G, b_ = c0.bid; unsigned z_ = 0u; asm volatile("" : "+s"(w_), "+s"(g_), "+s"(b_), "+s"(z_)); c.wid = w_; c.G = g_; c.bid = b_;
    c.lane = (int)__builtin_amdgcn_mbcnt_hi(~0u, __builtin_amdgcn_mbcnt_lo(~0u, z_)); c.tid = w_ * 64 + c.lane;
    unsigned char* w = c0.ws; asm volatile("" : "+s"(w)); c.ws = w; return c;
}
__device__ void phase_tables(const Ctx& c0) {
    const Ctx c = fresh(c0);
    const int gt = c.bid * 512 + c.tid, gs = c.G * 512;
    for (int idx = gt; idx < 4096 * 32; idx += gs) {
        const int tok = idx >> 5, i = idx & 31;
        const float pos = (float)((i < 16) ? (tok >> 6) : (tok & 63));
        const float inv = powf(10000.0f, -(float)(i & 15) / 16.0f);
        const float ang = pos * inv;
        c.ROPE()[idx] = cosf(ang); c.ROPE()[4096 * 32 + idx] = sinf(ang);
    }
    for (int idx = gt; idx < 2 * 512; idx += gs) {
        const int dir = idx >> 9, d = idx & 511;
        const float* lbp = c.a->in[I_HLB] + (size_t)dir * DEPTH * 512 + d;
        float v[DEPTH], mx = -INFINITY;
        for (int l = 0; l < DEPTH; ++l) { v[l] = lbp[l * 512]; mx = fmaxf(mx, v[l]); }
        float s = 0.f; for (int l = 0; l < DEPTH; ++l) { v[l] = expf(v[l] - mx); s += v[l]; }
        float cum = 0.f;
        for (int l = 0; l < DEPTH; ++l) { const float p = v[l] / s; cum += p; const float lb = fminf(fmaxf(cum - v[0] / s, 0.f), 1.f); c.LB()[(dir * DEPTH + l) * 512 + d] = lb; }
    }
    for (int idx = gt; idx < NEXP * (EROWS - NB * CAP); idx += gs) { const int e = idx / (EROWS - NB * CAP), r = idx % (EROWS - NB * CAP); c.RIDX()[e * EROWS + NB * CAP + r] = 0; }
}

__device__ __forceinline__ void convert_tile(const Ctx& c, const float* src, int ld_src, int k0, int n0, bf16_t* dst, int ld_dst, int nrow0, float* T) {
    const int tid = c.tid;
    __syncthreads();
#pragma unroll
    for (int i = 0; i < 2; ++i) { const int k = (tid >> 4) + 32 * i, n4 = (tid & 15) * 4; const f32x4 v = *(const f32x4*)(src + (size_t)(k0 + k) * ld_src + n0 + n4);
        T[k * 65 + n4 + 0] = v[0]; T[k * 65 + n4 + 1] = v[1]; T[k * 65 + n4 + 2] = v[2]; T[k * 65 + n4 + 3] = v[3]; }
    __syncthreads();
    { const int n = tid >> 3, k8 = (tid & 7) * 8; float r[8];
#pragma unroll
      for (int j = 0; j < 8; ++j) r[j] = T[(k8 + j) * 65 + n];
      u32x4 w; w.x = cvt_pk_bf16(r[0], r[1]); w.y = cvt_pk_bf16(r[2], r[3]); w.z = cvt_pk_bf16(r[4], r[5]); w.w = cvt_pk_bf16(r[6], r[7]);
      *(u32x4*)(dst + (size_t)(nrow0 + n) * ld_dst + k0 + k8) = w; }
}
__device__ void convert_weights(const Ctx& c0, int layer, float* T) {
    const Ctx c = fresh(c0);
    constexpr int T_IN = 16 * 72, T_OUT = 24 * 16, T_G = 16 * 16 * 32, T_D = 16 * 32 * 16, T_ALL = T_IN + T_OUT + 2 * T_G + T_D;
    for (int t = c.bid; t < T_ALL; t += c.G) {
        if (t < T_IN) { const int kt = t % 16, ntl = t / 16;
            convert_tile(c, c.a->in[I_WIN] + (size_t)layer * DM * INW, INW, kt * 64, ntl * 64, c.WIN(), DM, ntl * 64, T);
        } else if (t < T_IN + T_OUT) { const int u = t - T_IN, kt = u % 24, ntl = u / 24;
            convert_tile(c, c.a->in[I_WOUT] + (size_t)layer * MIXW * DM, DM, kt * 64, ntl * 64, c.WOUT(), MIXW, ntl * 64, T);
        } else if (t < T_IN + T_OUT + 2 * T_G) { int u = t - T_IN - T_OUT; const int which = u / T_G; u %= T_G; const int e = u / 512, r = u % 512, kt = r % 16, ntl = r / 16;
            const float* src = c.a->in[which ? I_WUP : I_WGATE] + ((size_t)layer * NEXP + e) * DM * FF;
            const int f0 = ntl * 64, pn = f0 >> 7, j0 = f0 & 127;
            convert_tile(c, src, FF, kt * 64, f0, c.WGU() + (size_t)e * 4096 * DM, DM, pn * 256 + which * 128 + j0, T);
        } else { const int u = t - T_IN - T_OUT - 2 * T_G; const int e = u / 512, r = u % 512, kt = r % 32, ntl = r / 32;
            const float* src = c.a->in[I_WDOWN] + ((size_t)layer * NEXP + e) * FF * DM;
            convert_tile(c, src, DM, kt * 64, ntl * 64, c.WD() + (size_t)e * DM * FF, FF, ntl * 64, T);
        }
    }
}

template <bool ROUTER>
__device__ void phase_norm(const Ctx& c0, int layer) {
    const Ctx c = fresh(c0);
    float* W16 = (float*)c.smem;
    if (ROUTER) { const float* src = c.a->in[I_ROUTER] + (size_t)layer * DM * NEXP; for (int i = c.tid; i < DM * 16; i += 512) W16[(i & 15) * DM + (i >> 4)] = src[i]; }
    else { const float* src = c.a->in[I_WIN] + (size_t)layer * DM * INW + C_DT; for (int i = c.tid; i < DM * 16; i += 512) W16[(i & 15) * DM + (i >> 4)] = src[(size_t)(i >> 4) * INW + (i & 15)]; }
    __syncthreads();
    const float* wn = c.a->in[ROUTER ? I_NORM2 : I_NORM1] + (size_t)layer * DM;
    const int lane = c.lane;
    for (int row = c.bid * 8 + c.wid; row < ROWS; row += c.G * 8) {
        f32x4 v[4];
        if (!ROUTER && layer == 0) {
            const float* src = row < ROWS_REAL ? c.a->in[I_X] + (size_t)row * DM : c.a->in[I_META] + (size_t)((row - ROWS_REAL) & 15) * DM;
#pragma unroll
            for (int i = 0; i < 4; ++i) v[i] = *(const f32x4*)(src + 4 * lane + 256 * i);
        } else {
#pragma unroll
            for (int i = 0; i < 4; ++i) v[i] = *(const f32x4*)(c.H() + (size_t)row * DM + 4 * lane + 256 * i);
        }
        if (!ROUTER && layer > 0) {
            const int s = lane < 16 ? c.SEL()[row * 16 + lane] : -1;
            for (int e = 0; e < 16; ++e) { const int se = __shfl(s, e);
                if (se >= 0) {
#pragma unroll
                    for (int i = 0; i < 4; ++i) { const u32x2 w = *(const u32x2*)(c.Y() + (size_t)se * DM + 4 * lane + 256 * i);
                        v[i][0] += bflo(w.x); v[i][1] += bfhi(w.x); v[i][2] += bflo(w.y); v[i][3] += bfhi(w.y); } } }
        }
        if (!ROUTER) {
#pragma unroll
            for (int i = 0; i < 4; ++i) *(f32x4*)(c.H() + (size_t)row * DM + 4 * lane + 256 * i) = v[i];
        }
        float ss = 0.f;
#pragma unroll
        for (int i = 0; i < 4; ++i) ss += v[i][0] * v[i][0] + v[i][1] * v[i][1] + v[i][2] * v[i][2] + v[i][3] * v[i][3];
        ss = wave_sum(ss);
        const float rstd = rsqrtf(ss * (1.0f / DM) + EPS);
        float acc[16];
#pragma unroll
        for (int j = 0; j < 16; ++j) acc[j] = 0.f;
#pragma unroll
        for (int i = 0; i < 4; ++i) { const f32x4 w = *(const f32x4*)(wn + 4 * lane + 256 * i); f32x4 un = v[i] * rstd * w;
            u32x2 pk; pk.x = cvt_pk_bf16(un[0], un[1]); pk.y = cvt_pk_bf16(un[2], un[3]);
            *(u32x2*)(c.U() + (size_t)row * DM + 4 * lane + 256 * i) = pk;
#pragma unroll
            for (int j = 0; j < 16; ++j) { const f32x4 ww = *(const f32x4*)(W16 + j * DM + 4 * lane + 256 * i);
                acc[j] += un[0] * ww[0] + un[1] * ww[1] + un[2] * ww[2] + un[3] * ww[3]; } }
#pragma unroll
        for (int j = 0; j < 16; ++j) acc[j] = wave_sum(acc[j]);
        if (!ROUTER) {
            float o = 0.f;
#pragma unroll
            for (int j = 0; j < 16; ++j) o = (lane == j) ? acc[j] : o;
            if (lane < 16) c.DT()[row * 16 + lane] = o;
        } else {
            float mx = acc[0];
#pragma unroll
            for (int j = 1; j < 16; ++j) mx = fmaxf(mx, acc[j]);
            float s = 0.f;
#pragma unroll
            for (int j = 0; j < 16; ++j) { acc[j] = __expf(acc[j] - mx); s += acc[j]; }
            const float inv = 1.0f / s;
            float o = 0.f;
#pragma unroll
            for (int j = 0; j < 16; ++j) o = (lane == j) ? acc[j] * inv : o;
            int b, t; if (row < ROWS_REAL) { b = row >> 12; t = (row & 4095) + NMETA; } else { b = (row - ROWS_REAL) >> 4; t = (row - ROWS_REAL) & 15; }
            if (lane < 16) c.AFFT()[(size_t)(b * 16 + lane) * LTOK + t] = o;
        }
    }
}

__device__ void phase_prep(const Ctx& c0, int layer) {
    const Ctx c = fresh(c0);
    float* CW = (float*)c.smem;
    { const float* cw = c.a->in[I_CONVW] + (size_t)layer * 768 * 7; const float* cb = c.a->in[I_CONVB] + (size_t)layer * 768;
      for (int i = c.tid; i < 768 * 8; i += 512) { const int ch = i >> 3, tp = i & 7; CW[i] = tp < 7 ? cw[ch * 7 + tp] : cb[ch]; } }
    __syncthreads();
    const int lane = c.lane;
    const float* qw = c.a->in[I_QNW] + layer * 64; const float* kw = c.a->in[I_KNW] + layer * 64;
    for (int row = c.bid * 8 + c.wid; row < ROWS; row += c.G * 8) {
        int b, t; if (row < ROWS_REAL) { b = row >> 12; t = (row & 4095) + NMETA; } else { b = (row - ROWS_REAL) >> 4; t = (row - ROWS_REAL) & 15; }
        bf16_t* prow = c.PROJ() + (size_t)row * PROJW;
#pragma unroll
        for (int pass = 0; pass < 2; ++pass) {
            const bool act = pass == 0 || lane < 16;
            bf16_t* p = prow + (pass == 0 ? C_AQ : C_AK) + 8 * lane;
            float x[8];
            if (act) { const u32x4 w = *(const u32x4*)p; x[0] = bflo(w.x); x[1] = bfhi(w.x); x[2] = bflo(w.y); x[3] = bfhi(w.y); x[4] = bflo(w.z); x[5] = bfhi(w.z); x[6] = bflo(w.w); x[7] = bfhi(w.w); }
            else {
#pragma unroll
                for (int j = 0; j < 8; ++j) x[j] = 0.f; }
            float ss = 0.f;
#pragma unroll
            for (int j = 0; j < 8; ++j) ss += x[j] * x[j];
            ss += __shfl_xor(ss, 1); ss += __shfl_xor(ss, 2); ss += __shfl_xor(ss, 4);
            const float rstd = rsqrtf(ss * (1.0f / 64.0f) + EPS);
            const int d0 = 8 * (lane & 7);
            const float* nw = pass == 0 ? qw : kw;
            float xn[8], xp[8];
#pragma unroll
            for (int j = 0; j < 8; ++j) xn[j] = x[j] * rstd * nw[d0 + j];
#pragma unroll
            for (int j = 0; j < 8; ++j) xp[j] = __shfl_xor(xn[j], 4);
            float o[8];
            if (t >= NMETA) {
                const int tok = t - NMETA; const float* cs = c.ROPE() + (size_t)tok * 32 + (d0 & 31); const float* sn = c.ROPE() + 4096 * 32 + (size_t)tok * 32 + (d0 & 31);
#pragma unroll
                for (int j = 0; j < 8; ++j) { const float cc = cs[j], s = sn[j]; o[j] = (d0 < 32) ? (xn[j] * cc - xp[j] * s) : (xp[j] * s + xn[j] * cc); }
            } else {
#pragma unroll
                for (int j = 0; j < 8; ++j) o[j] = xn[j];
            }
            const float sc = pass == 0 ? QSCALE : 1.0f;
            if (act) { u32x4 w; w.x = cvt_pk_bf16(o[0] * sc, o[1] * sc); w.y = cvt_pk_bf16(o[2] * sc, o[3] * sc); w.z = cvt_pk_bf16(o[4] * sc, o[5] * sc); w.w = cvt_pk_bf16(o[6] * sc, o[7] * sc); *(u32x4*)p = w; }
        }
        float a[3][4];
#pragma unroll
        for (int i = 0; i < 3; ++i)
#pragma unroll
            for (int q = 0; q < 4; ++q) a[i][q] = CW[(4 * lane + 256 * i + q) * 8 + 7];
#pragma unroll
        for (int tp = 0; tp < 7; ++tp) { const int tt = t + tp - 3;
            if (tt >= 0 && tt < LTOK) { const bf16_t* nr = c.PROJ() + (size_t)row_of(b, tt) * PROJW + C_XBC;
#pragma unroll
                for (int i = 0; i < 3; ++i) { const u32x2 w = *(const u32x2*)(nr + 4 * lane + 256 * i); const int ch = 4 * lane + 256 * i;
                    a[i][0] += CW[(ch + 0) * 8 + tp] * bflo(w.x); a[i][1] += CW[(ch + 1) * 8 + tp] * bfhi(w.x); a[i][2] += CW[(ch + 2) * 8 + tp] * bflo(w.y); a[i][3] += CW[(ch + 3) * 8 + tp] * bfhi(w.y); } } }
#pragma unroll
        for (int i = 0; i < 3; ++i) { u32x2 w; w.x = cvt_pk_bf16(silu_f(a[i][0]), silu_f(a[i][1])); w.y = cvt_pk_bf16(silu_f(a[i][2]), silu_f(a[i][3]));
            *(u32x2*)(c.XBC() + (size_t)row * 768 + 4 * lane + 256 * i) = w; }
    }
}

__device__ __forceinline__ void chunk_rows(int b, int ch, int& base, int& n) { if (ch == 0) { base = ROWS_REAL + b * NMETA; n = NMETA; } else { base = b * SEQ + (ch - 1) * 64; n = 64; } }

__device__ void attn_item(const Ctx& c, int b, int hd, int qblk) {
    float* KT = (float*)c.smem; float* VT = KT + 64 * 64;
    const int tid = c.tid, g = hd >> 2;
    int row = -1; if (qblk < 8) row = b * SEQ + qblk * 512 + tid; else if (tid < NMETA) row = ROWS_REAL + b * NMETA + tid;
    float q[64], o[64];
    if (row >= 0) {
#pragma unroll
        for (int j = 0; j < 8; ++j) { const u32x4 w = *(const u32x4*)(c.PROJ() + (size_t)row * PROJW + C_AQ + hd * 64 + 8 * j);
            q[8 * j + 0] = bflo(w.x); q[8 * j + 1] = bfhi(w.x); q[8 * j + 2] = bflo(w.y); q[8 * j + 3] = bfhi(w.y); q[8 * j + 4] = bflo(w.z); q[8 * j + 5] = bfhi(w.z); q[8 * j + 6] = bflo(w.w); q[8 * j + 7] = bfhi(w.w); }
    } else {
#pragma unroll
        for (int j = 0; j < 64; ++j) q[j] = 0.f;
    }
#pragma unroll
    for (int j = 0; j < 64; ++j) o[j] = 0.f;
    float m = -1e30f, l = 0.f;
    for (int tile = 0; tile < 65; ++tile) {
        int kbase, nk; chunk_rows(b, tile == 64 ? 0 : tile + 1, kbase, nk);
        __syncthreads();
        { const int kr = tid >> 3, c8 = (tid & 7) * 8;
          if (kr < nk) { const u32x4 wk = *(const u32x4*)(c.PROJ() + (size_t)(kbase + kr) * PROJW + C_AK + g * 64 + c8); const u32x4 wv = *(const u32x4*)(c.PROJ() + (size_t)(kbase + kr) * PROJW + C_AV + g * 64 + c8);
            float* kp = KT + kr * 64 + c8; float* vp = VT + kr * 64 + c8;
            kp[0] = bflo(wk.x); kp[1] = bfhi(wk.x); kp[2] = bflo(wk.y); kp[3] = bfhi(wk.y); kp[4] = bflo(wk.z); kp[5] = bfhi(wk.z); kp[6] = bflo(wk.w); kp[7] = bfhi(wk.w);
            vp[0] = bflo(wv.x); vp[1] = bfhi(wv.x); vp[2] = bflo(wv.y); vp[3] = bfhi(wv.y); vp[4] = bflo(wv.z); vp[5] = bfhi(wv.z); vp[6] = bflo(wv.w); vp[7] = bfhi(wv.w); } }
        __syncthreads();
        for (int j = 0; j < nk; ++j) {
            float s = 0.f;
#pragma unroll
            for (int d4 = 0; d4 < 16; ++d4) { const f32x4 kk = *(const f32x4*)(KT + j * 64 + 4 * d4); s += q[4 * d4] * kk[0] + q[4 * d4 + 1] * kk[1] + q[4 * d4 + 2] * kk[2] + q[4 * d4 + 3] * kk[3]; }
            if (s > m) { const float corr = __builtin_amdgcn_exp2f(m - s); l *= corr;
#pragma unroll
                for (int d = 0; d < 64; ++d) o[d] *= corr;
                m = s; }
            const float p = __builtin_amdgcn_exp2f(s - m); l += p;
#pragma unroll
            for (int d4 = 0; d4 < 16; ++d4) { const f32x4 vv = *(const f32x4*)(VT + j * 64 + 4 * d4); o[4 * d4] += p * vv[0]; o[4 * d4 + 1] += p * vv[1]; o[4 * d4 + 2] += p * vv[2]; o[4 * d4 + 3] += p * vv[3]; }
        }
    }
    if (row >= 0) { const float inv = 1.0f / l;
#pragma unroll
        for (int j = 0; j < 8; ++j) { u32x4 w; w.x = cvt_pk_bf16(o[8 * j] * inv, o[8 * j + 1] * inv); w.y = cvt_pk_bf16(o[8 * j + 2] * inv, o[8 * j + 3] * inv); w.z = cvt_pk_bf16(o[8 * j + 4] * inv, o[8 * j + 5] * inv); w.w = cvt_pk_bf16(o[8 * j + 6] * inv, o[8 * j + 7] * inv);
            *(u32x4*)(c.ATT() + (size_t)row * 512 + hd * 64 + 8 * j) = w; } }
    __syncthreads();
}

__device__ void hgrn_item(const Ctx& c, int layer, int b, int h, int dir) {
    const int tid = c.tid, lane = c.lane, wid = c.wid;
    bf16_t* TQ = (bf16_t*)c.smem;
    bf16_t* TF = TQ + 64 * 128; bf16_t* TV = TF + 64 * 128;
    float* GA = (float*)(c.smem + 49152) + wid * 384;
    const float lb0 = c.LB()[(dir * DEPTH + layer) * 512 + h * 128 + lane], lb1 = c.LB()[(dir * DEPTH + layer) * 512 + h * 128 + 64 + lane];
    bf16_t* OUT = dir ? c.OB() : c.OF();
    const int fcol = dir ? C_HB : C_HF;
    const int el = lane & 15, dg = lane >> 4;
    float S[32];
#pragma unroll
    for (int j = 0; j < 32; ++j) S[j] = 0.f;
    for (int ci = 0; ci < 65; ++ci) {
        const int ch = dir ? 64 - ci : ci;
        int base, n; chunk_rows(b, ch, base, n);
        __syncthreads();
#pragma unroll
        for (int i = 0; i < 2; ++i) { const int idx = tid + 512 * i, r = idx >> 4, c16 = idx & 15;
            if (r < n) { const bf16_t* pr = c.PROJ() + (size_t)(base + r) * PROJW + h * 128 + c16 * 8;
                *(u32x4*)(TQ + r * 128 + c16 * 8) = *(const u32x4*)(pr + C_HQ); *(u32x4*)(TF + r * 128 + c16 * 8) = *(const u32x4*)(pr + fcol); *(u32x4*)(TV + r * 128 + c16 * 8) = *(const u32x4*)(pr + C_HI); } }
        __syncthreads();
        for (int ri = 0; ri < n; ++ri) {
            const int r = dir ? n - 1 - ri : ri;
#pragma unroll
            for (int half = 0; half < 2; ++half) { const int d = lane + 64 * half; const float xf = bf2f(TF[r * 128 + d]), xq = bf2f(TQ[r * 128 + d]);
                const float e = __expf(-xf), ec = fminf(e, 1.0686474581524463e13f);
                float f = (1.0f + (half ? lb1 : lb0) * ec) / (1.0f + e); f = fminf(f, 1.0f);
                GA[d] = f; GA[128 + d] = 1.0f - f; GA[256 + d] = silu_f(xq); }
            asm volatile("s_waitcnt lgkmcnt(0)" ::: "memory");
            const float v = bf2f(TV[r * 128 + 16 * wid + el]);
            float acc = 0.f;
#pragma unroll
            for (int j4 = 0; j4 < 8; ++j4) { const f32x4 ff = *(const f32x4*)(GA + 32 * dg + 4 * j4), kk = *(const f32x4*)(GA + 128 + 32 * dg + 4 * j4), qq = *(const f32x4*)(GA + 256 + 32 * dg + 4 * j4);
#pragma unroll
                for (int q = 0; q < 4; ++q) { S[4 * j4 + q] = ff[q] * S[4 * j4 + q] + kk[q] * v; acc += S[4 * j4 + q] * qq[q]; } }
            asm volatile("s_waitcnt lgkmcnt(0)" ::: "memory");
            acc += __shfl_xor(acc, 16); acc += __shfl_xor(acc, 32);
            if (lane < 16) OUT[(size_t)(base + r) * 512 + h * 128 + 16 * wid + el] = f2bf(acc);
        }
    }
    __syncthreads();
}

__device__ void ssd_item(const Ctx& c, int layer, int b, int g, int dir) {
    const int tid = c.tid, lane = c.lane, wid = c.wid;
    bf16_t* TX = (bf16_t*)c.smem;
    float* TD = (float*)(c.smem + 49152);
    const int hh = wid & 3, ph = wid >> 2, head = 4 * g + hh, pl = lane & 31, nh = lane >> 5, p = 32 * ph + pl;
    const float dtb = c.a->in[I_DTB][(layer * 2 + dir) * 8 + head];
    const float A = -__expf(c.a->in[I_ALOG][(layer * 2 + dir) * 8 + head]);
    bf16_t* OUT = dir ? c.YB() : c.YF();
    float S[32];
#pragma unroll
    for (int j = 0; j < 32; ++j) S[j] = 0.f;
    for (int ci = 0; ci < 65; ++ci) {
        const int ch = dir ? 64 - ci : ci;
        int base, n; chunk_rows(b, ch, base, n);
        __syncthreads();
#pragma unroll
        for (int i = 0; i < 6; ++i) { const int idx = tid + 512 * i, r = idx / 48, c16 = idx % 48;
            if (r < n) { const int col = c16 < 32 ? 256 * g + c16 * 8 : (c16 < 40 ? 512 + 64 * g + (c16 - 32) * 8 : 640 + 64 * g + (c16 - 40) * 8);
                *(u32x4*)(TX + r * 384 + c16 * 8) = *(const u32x4*)(c.XBC() + (size_t)(base + r) * 768 + col); } }
        if (tid < 256) { const int r = tid >> 2, q = tid & 3; if (r < n) TD[tid] = c.DT()[(size_t)(base + r) * 16 + dir * 8 + 4 * g + q]; }
        __syncthreads();
        for (int ri = 0; ri < n; ++ri) {
            const int r = dir ? n - 1 - ri : ri;
            const float xd = TD[r * 4 + hh] + dtb;
            const float dt = xd > 20.f ? xd : log1pf(__expf(xd));
            const float a = __expf(dt * A);
            const float x = bf2f(TX[r * 384 + 64 * hh + p]);
            const float dx = dt * x;
            float acc = 0.f;
#pragma unroll
            for (int j8 = 0; j8 < 4; ++j8) { const u32x4 wb = *(const u32x4*)(TX + r * 384 + 256 + 32 * nh + 8 * j8), wc = *(const u32x4*)(TX + r * 384 + 320 + 32 * nh + 8 * j8);
                const float Bv[8] = {bflo(wb.x), bfhi(wb.x), bflo(wb.y), bfhi(wb.y), bflo(wb.z), bfhi(wb.z), bflo(wb.w), bfhi(wb.w)};
                const float Cv[8] = {bflo(wc.x), bfhi(wc.x), bflo(wc.y), bfhi(wc.y), bflo(wc.z), bfhi(wc.z), bflo(wc.w), bfhi(wc.w)};
#pragma unroll
                for (int q = 0; q < 8; ++q) { S[8 * j8 + q] = a * S[8 * j8 + q] + Bv[q] * dx; acc += Cv[q] * S[8 * j8 + q]; } }
            acc += __shfl_xor(acc, 32);
            if (nh == 0) OUT[(size_t)(base + r) * 512 + head * 64 + p] = f2bf(acc);
        }
    }
    __syncthreads();
}

__device__ void phase_mixers(const Ctx& c0, int layer) {
    const Ctx c = fresh(c0);
    constexpr int N_H = 64, N_S = 32, N_A = NB * 8 * 9, N_ALL = N_H + N_S + N_A;
    for (int it = c.bid; it < N_ALL; it += c.G) {
        if (it < N_H) { hgrn_item(c, layer, it >> 3, (it >> 1) & 3, it & 1); }
        else if (it < N_H + N_S) { const int u = it - N_H; ssd_item(c, layer, u >> 2, (u >> 1) & 1, u & 1); }
        else { const int u = it - N_H - N_S; attn_item(c, u / 72, (u % 72) / 9, u % 9); }
    }
}

__device__ void phase_mix(const Ctx& c0, int layer) {
    const Ctx c = fresh(c0);
    const int lane = c.lane;
    const float* anw = c.a->in[I_ANW] + layer * 512; const float* hnw = c.a->in[I_HNW] + layer * 512; const float* snw = c.a->in[I_SNW] + layer * 512;
    const float dsk = c.a->in[I_DSKIP][layer * 8 + (lane >> 3)];
    auto ld8 = [](const bf16_t* p, float (&x)[8]) { const u32x4 w = *(const u32x4*)p; x[0] = bflo(w.x); x[1] = bfhi(w.x); x[2] = bflo(w.y); x[3] = bfhi(w.y); x[4] = bflo(w.z); x[5] = bfhi(w.z); x[6] = bflo(w.w); x[7] = bfhi(w.w); };
    auto st8 = [](bf16_t* p, const float (&x)[8]) { u32x4 w; w.x = cvt_pk_bf16(x[0], x[1]); w.y = cvt_pk_bf16(x[2], x[3]); w.z = cvt_pk_bf16(x[4], x[5]); w.w = cvt_pk_bf16(x[6], x[7]); *(u32x4*)p = w; };
    for (int row = c.bid * 8 + c.wid; row < ROWS; row += c.G * 8) {
        const bf16_t* prow = c.PROJ() + (size_t)row * PROJW;
        bf16_t* mrow = c.MIX() + (size_t)row * MIXW;
        float x[8], y[8], z[8];
        { ld8(c.ATT() + (size_t)row * 512 + 8 * lane, x); float ss = 0.f;
#pragma unroll
          for (int j = 0; j < 8; ++j) ss += x[j] * x[j];
          ss = wave_sum(ss); const float rstd = rsqrtf(ss * (1.0f / 512.0f) + EPS);
#pragma unroll
          for (int j = 0; j < 8; ++j) x[j] = x[j] * rstd * anw[8 * lane + j];
          st8(mrow + 8 * lane, x); }
        { ld8(c.OF() + (size_t)row * 512 + 8 * lane, x); ld8(c.OB() + (size_t)row * 512 + 8 * lane, y); ld8(prow + C_HG + 8 * lane, z); float ss = 0.f;
#pragma unroll
          for (int j = 0; j < 8; ++j) { x[j] += y[j]; ss += x[j] * x[j]; }
          ss += __shfl_xor(ss, 1); ss += __shfl_xor(ss, 2); ss += __shfl_xor(ss, 4); ss += __shfl_xor(ss, 8);
          const float rstd = rsqrtf(ss * (1.0f / 128.0f) + EPS);
#pragma unroll
          for (int j = 0; j < 8; ++j) x[j] = x[j] * rstd * hnw[8 * lane + j] * silu_f(z[j]);
          st8(mrow + 512 + 8 * lane, x); }
        { ld8(c.YF() + (size_t)row * 512 + 8 * lane, x); ld8(c.YB() + (size_t)row * 512 + 8 * lane, y); ld8(prow + C_SZ + 8 * lane, z); float xs[8]; ld8(c.XBC() + (size_t)row * 768 + 8 * lane, xs); float ss = 0.f;
#pragma unroll
          for (int j = 0; j < 8; ++j) { x[j] = (x[j] + y[j] + dsk * xs[j]) * silu_f(z[j]); ss += x[j] * x[j]; }
          ss = wave_sum(ss); const float rstd = rsqrtf(ss * (1.0f / 512.0f) + EPS);
#pragma unroll
          for (int j = 0; j < 8; ++j) x[j] = x[j] * rstd * snw[8 * lane + j];
          st8(mrow + 1024 + 8 * lane, x); }
    }
}

__device__ void phase_topk(const Ctx& c0) {
    const Ctx c = fresh(c0);
    float* V = (float*)c.smem;
    const int tid = c.tid;
    for (int it = c.bid; it < NB * NEXP; it += c.G) {
        const int b = it >> 4, e = it & 15;
        __syncthreads();
        for (int i = tid; i < LTOK; i += 512) V[i] = c.AFFT()[(size_t)it * LTOK + i];
        __syncthreads();
        float a[9]; int cnt[9];
#pragma unroll
        for (int k = 0; k < 9; ++k) { const int i = tid + 512 * k; a[k] = i < LTOK ? V[i] : -1.f; cnt[k] = 0; }
        for (int j4 = 0; j4 < LTOK / 4; ++j4) { const f32x4 v = *(const f32x4*)(V + 4 * j4);
#pragma unroll
            for (int q = 0; q < 4; ++q) { const float aj = v[q]; const int j = 4 * j4 + q;
#pragma unroll
                for (int k = 0; k < 9; ++k) cnt[k] += (aj > a[k]) || (aj == a[k] && j < tid + 512 * k); } }
#pragma unroll
        for (int k = 0; k < 9; ++k) { const int i = tid + 512 * k;
            if (i < LTOK) { const int row = row_of(b, i);
                if (cnt[k] < CAP) { const int mrow = e * EROWS + b * CAP + cnt[k]; c.RIDX()[mrow] = row; c.GATE()[mrow] = a[k]; c.SEL()[row * 16 + e] = mrow; }
                else c.SEL()[row * 16 + e] = -1; } }
    }
}

__device__ void phase_final(const Ctx& c0) {
    const Ctx c = fresh(c0);
    const int lane = c.lane;
    for (int row = c.bid * 8 + c.wid; row < ROWS_REAL; row += c.G * 8) {
        f32x4 v[4];
#pragma unroll
        for (int i = 0; i < 4; ++i) v[i] = *(const f32x4*)(c.H() + (size_t)row * DM + 4 * lane + 256 * i);
        const int s = lane < 16 ? c.SEL()[row * 16 + lane] : -1;
        for (int e = 0; e < 16; ++e) { const int se = __shfl(s, e);
            if (se >= 0) {
#pragma unroll
                for (int i = 0; i < 4; ++i) { const u32x2 w = *(const u32x2*)(c.Y() + (size_t)se * DM + 4 * lane + 256 * i);
                    v[i][0] += bflo(w.x); v[i][1] += bfhi(w.x); v[i][2] += bflo(w.y); v[i][3] += bfhi(w.y); } } }
#pragma unroll
        for (int i = 0; i < 4; ++i) *(f32x4*)(c.a->out + (size_t)row * DM + 4 * lane + 256 * i) = v[i];
    }
}

constexpr int NPH_LAYER = 10, NPH = 1 + DEPTH * NPH_LAYER + 1;
__global__ void __launch_bounds__(512, 2) mega(Args args) {
    extern __shared__ __attribute__((aligned(16))) unsigned char lds[];
    Ctx c;
    c.a = &args; c.ws = args.ws; c.smem = (char*)lds; c.tid = threadIdx.x; c.lane = c.tid & 63; c.wid = __builtin_amdgcn_readfirstlane(c.tid >> 6); c.G = gridDim.x; c.bid = blockIdx.x;
    unsigned char* ws = args.ws;
    LAS unsigned char* l3 = (LAS unsigned char*)lds;
    volatile LAS unsigned* MISC = (volatile LAS unsigned*)(l3 + LDS_MISC);
    if (c.tid < 4) MISC[c.tid] = 0u;
    __syncthreads();
    const int lo = args.ph_lo, hi = args.ph_hi;
    XcdBarrier bar; bar.bar = (unsigned*)(ws + WS_CTL) + 4096; bar.x = 0; bar.st = MISC;
    if (hi - lo > 1) bar = xcd_barrier_post((unsigned*)(ws + WS_CTL) + 4096, MISC);
#define IN(k) (lo <= (k) && (k) < hi)
#define SEAM(k) do { if (IN(k) && IN((k) + 1)) xcd_barrier(bar); } while (0)
    if ((PH_MASK & 1) && IN(0)) { phase_tables(c); }
    SEAM(0);
    for (int layer_ = 0; layer_ < DEPTH; ++layer_) {
        int layer = layer_; asm volatile("" : "+s"(layer));
        const int p0 = 1 + layer_ * NPH_LAYER;
        if ((PH_MASK & (2 << 0)) && IN(p0 + 0)) { phase_norm<false>(c, layer); convert_weights(c, layer, (float*)(c.smem + 65536)); }
        SEAM(p0 + 0);
        if ((PH_MASK & (2 << 1)) && IN(p0 + 1)) { pg::SchedDense S{ROWS_PAD / 256, PROJW / 256, (ROWS_PAD / 256) * (PROJW / 256), og(c.G), og(c.bid), (const char*)c.WIN()}; pg::EpiProj E{c.PROJ(), PROJW};
            pg::gemm_phase(l3, c.wid, (const char*)c.U(), DM, S, E); }
        SEAM(p0 + 1);
        if ((PH_MASK & (2 << 2)) && IN(p0 + 2)) { phase_prep(c, layer); }
        SEAM(p0 + 2);
        if ((PH_MASK & (2 << 3)) && IN(p0 + 3)) { phase_mixers(c, layer); }
        SEAM(p0 + 3);
        if ((PH_MASK & (2 << 4)) && IN(p0 + 4)) { phase_mix(c, layer); }
        SEAM(p0 + 4);
        if ((PH_MASK & (2 << 5)) && IN(p0 + 5)) { pg::SchedDense S{ROWS_PAD / 256, DM / 256, (ROWS_PAD / 256) * (DM / 256), og(c.G), og(c.bid), (const char*)c.WOUT()}; pg::EpiResid E{c.H(), DM};
            pg::gemm_phase(l3, c.wid, (const char*)c.MIX(), MIXW, S, E); }
        SEAM(p0 + 5);
        if ((PH_MASK & (2 << 6)) && IN(p0 + 6)) { phase_norm<true>(c, layer); }
        SEAM(p0 + 6);
        if ((PH_MASK & (2 << 7)) && IN(p0 + 7)) { phase_topk(c); }
        SEAM(p0 + 7);
        if ((PH_MASK & (2 << 8)) && IN(p0 + 8)) { pg::SchedMoE1 S{og(c.G), og(c.bid), c.RIDX(), (const char*)c.WGU()}; pg::EpiGateUp E{c.ACT()};
            pg::gemm_phase(l3, c.wid, (const char*)c.U(), DM, S, E); }
        SEAM(p0 + 8);
        if ((PH_MASK & (2 << 9)) && IN(p0 + 9)) { pg::SchedMoE2 S{og(c.G), og(c.bid), (const char*)c.WD()}; pg::EpiDown E{c.Y(), c.GATE()};
            pg::gemm_phase(l3, c.wid, (const char*)c.ACT(), FF, S, E); }
        SEAM(p0 + 9);
    }
    if ((PH_MASK & (2 << 10)) && IN(NPH - 1)) { phase_final(c); }
#undef IN
#undef SEAM
}

extern "C" void kernel_launch(void* const* d_in, const int* in_sizes, int n_in, void* d_out, int out_size, void* d_ws, size_t ws_size, hipStream_t stream) {
    static int grid = 0;
    if (grid == 0) {
        if (n_in != 21 || out_size != ROWS_REAL * DM || ws_size < WS_END) { fprintf(stderr, "kernel_launch: unexpected problem (n_in %d, out %d, ws %zu)\n", n_in, out_size, ws_size); grid = -1; return; }
        int dev = 0, cus = 0, per_cu = 0;
        if (hipGetDevice(&dev) != hipSuccess || hipDeviceGetAttribute(&cus, hipDeviceAttributeMultiprocessorCount, dev) != hipSuccess) { grid = -1; return; }
        if (hipFuncSetAttribute((const void*)mega, hipFuncAttributeMaxDynamicSharedMemorySize, LDS_BYTES) != hipSuccess) { fprintf(stderr, "kernel_launch: hipFuncSetAttribute failed\n"); grid = -1; return; }
        if (hipOccupancyMaxActiveBlocksPerMultiprocessor(&per_cu, (const void*)mega, 512, LDS_BYTES) != hipSuccess || per_cu < 1) fprintf(stderr, "kernel_launch: occupancy query says %d\n", per_cu);
        (void)hipGetLastError();
        grid = cus;
    }
    if (grid < 0) return;
    (void)hipMemsetAsync((char*)d_ws + WS_CTL, 0, CTL_BYTES, stream);
    Args a{};
    for (int i = 0; i < 21; ++i) a.in[i] = (const float*)d_in[i];
    a.out = (float*)d_out; a.ws = (unsigned char*)d_ws;
#if LAUNCH_PER_PHASE
    for (int ph = 0; ph < NPH; ++ph) { a.ph_lo = ph; a.ph_hi = ph + 1; hipLaunchKernelGGL(mega, dim3(grid), dim3(512), LDS_BYTES, stream, a); }
#else
    a.ph_lo = 0; a.ph_hi = NPH; hipLaunchKernelGGL(mega, dim3(grid), dim3(512), LDS_BYTES, stream, a);
#endif
}
```

```cpp
#include <hip/hip_runtime.h>
#include <cstdio>
#include <cstdint>

#define LAS __attribute__((address_space(3)))
typedef unsigned short bf16_t;
typedef short bf16x8 __attribute__((ext_vector_type(8)));
typedef float f32x4 __attribute__((ext_vector_type(4)));
typedef float f32x2 __attribute__((ext_vector_type(2)));
typedef unsigned u32x4 __attribute__((ext_vector_type(4)));
typedef unsigned u32x2 __attribute__((ext_vector_type(2)));

#ifndef PH_MASK
#define PH_MASK 0xFFFFF
#endif
#ifndef LAUNCH_PER_PHASE
#define LAUNCH_PER_PHASE 0
#endif

constexpr int DM = 1024, NB = 8, SEQ = 4096, DEPTH = 4, NMETA = 16, LTOK = SEQ + NMETA;
constexpr int ROWS_REAL = NB * SEQ, ROWS = NB * LTOK, ROWS_PAD = 33024;
constexpr int INW = 4624, PROJW = 4608;
constexpr int C_AQ = 0, C_AK = 512, C_AV = 640, C_HQ = 768, C_HF = 1280, C_HB = 1792, C_HI = 2304, C_HG = 2816, C_SZ = 3328, C_XBC = 3840, C_DT = 4608;
constexpr int MIXW = 1536, NEXP = 16, FF = 2048, CAP = 514, EROWS = 4352, MOE_ROWS = NEXP * EROWS;
constexpr float EPS = 1e-6f;
constexpr float QSCALE = 0.125f * 1.4426950408889634f;

constexpr size_t MiB = 1u << 20;
constexpr size_t WS_CTL = 0, CTL_BYTES = 1 * MiB;
constexpr size_t WS_ROPE = 1 * MiB;
constexpr size_t WS_LB = WS_ROPE + 2u * 4096 * 32 * 4;
constexpr size_t WS_H = 3 * MiB;
constexpr size_t WS_U = 133 * MiB;
constexpr size_t WS_DT = 198 * MiB;
constexpr size_t WS_AFFT = 201 * MiB;
constexpr size_t WS_SEL = 204 * MiB;
constexpr size_t WS_RIDX = 207 * MiB;
constexpr size_t WS_GATE = 208 * MiB;
constexpr size_t WS_XBC = 209 * MiB;
constexpr size_t WS_ATT = 258 * MiB;
constexpr size_t WS_OF = 291 * MiB, WS_OB = 324 * MiB, WS_YF = 357 * MiB, WS_YB = 390 * MiB;
constexpr size_t WS_MIX = 423 * MiB;
constexpr size_t WS_PROJ = 520 * MiB;
constexpr size_t WS_ACT = WS_PROJ;
constexpr size_t WS_Y = 811 * MiB;
constexpr size_t WS_WIN = 947 * MiB;
constexpr size_t WS_WOUT = 956 * MiB;
constexpr size_t WS_WGU = 959 * MiB;
constexpr size_t WS_WD = 1087 * MiB;
constexpr size_t WS_END = 1151 * MiB;

constexpr int LDS_BYTES = 147456;
constexpr int LDS_MISC = 145408;

typedef __bf16 bf16x2_t __attribute__((ext_vector_type(2)));
__device__ __forceinline__ unsigned cvt_pk_bf16(float lo, float hi) { f32x2 v = {lo, hi}; bf16x2_t b = __builtin_convertvector(v, bf16x2_t); return __builtin_bit_cast(unsigned, b); }
__device__ __forceinline__ bf16_t f2bf(float f) { return (bf16_t)(cvt_pk_bf16(f, 0.f) & 0xffffu); }
__device__ __forceinline__ float bf2f(bf16_t b) { return __uint_as_float(((unsigned)b) << 16); }
__device__ __forceinline__ float bflo(unsigned w) { return __uint_as_float(w << 16); }
__device__ __forceinline__ float bfhi(unsigned w) { return __uint_as_float(w & 0xffff0000u); }
__device__ __forceinline__ float wave_sum(float v) {
#pragma unroll
    for (int o = 1; o < 64; o <<= 1) v += __shfl_xor(v, o);
    return v;
}
__device__ __forceinline__ float silu_f(float x) { return x * __builtin_amdgcn_rcpf(1.0f + __expf(-x)); }
__device__ __forceinline__ int row_of(int b, int t) { return t < NMETA ? ROWS_REAL + b * NMETA + t : b * SEQ + (t - NMETA); }

#define XB_TMO      128
#define XB_XCNT(j)  (256  + 64 * (j))
#define XB_XSUB(j)  (1280 + 64 * (j))
#define XB_XGEN(j)  (2304 + 64 * (j))
#define XB_TOP      3328
#define XB_TOPGEN   3392
#define XCD_BAR_WORDS 3456
#define XB_SPIN_CAP (1u << 18)
__device__ __forceinline__ unsigned xb_ld(unsigned* p)              { return __hip_atomic_load(p, __ATOMIC_RELAXED, __HIP_MEMORY_SCOPE_AGENT); }
__device__ __forceinline__ unsigned xb_add(unsigned* p, unsigned v) { return __hip_atomic_fetch_add(p, v, __ATOMIC_RELAXED, __HIP_MEMORY_SCOPE_AGENT); }
__device__ __forceinline__ unsigned xb_xcc_id() { return (unsigned)__builtin_amdgcn_s_getreg((3 << 11) | 20) & 0xFu; }
#define XB_SPIN(cond, bar) do { unsigned _sp = 0; while (cond) { __builtin_amdgcn_s_sleep(1); \
    if ((++_sp & 255u) == 0u) { if (xb_ld(&(bar)[XB_TMO])) break; if (_sp > XB_SPIN_CAP) { atomicAdd(&(bar)[XB_TMO], 1u); break; } } } } while (0)
struct XcdBarrier { unsigned* bar; unsigned x; volatile LAS unsigned* st; };
__device__ __forceinline__ XcdBarrier xcd_barrier_post(unsigned* bar, volatile LAS unsigned* st) {
    XcdBarrier b; b.bar = bar; b.x = xb_xcc_id(); b.st = st;
    if (threadIdx.x == 0) (void)xb_add(&bar[XB_XCNT(b.x)], 1u);
    return b;
}
__device__ __forceinline__ void xcd_barrier_complete(unsigned* bar, unsigned x, unsigned& nloc, unsigned& nx) {
    const unsigned G = gridDim.x * gridDim.y * gridDim.z;
    unsigned sum, cnt, mine, sp = 0u;
    for (;;) {
        sum = 0u; cnt = 0u; mine = 0u;
#pragma unroll
        for (unsigned j = 0; j < 16; ++j) { const unsigned c = xb_ld(&bar[XB_XCNT(j)]); sum += c; cnt += (c > 0u) ? 1u : 0u; mine = (j == x) ? c : mine; }
        if (sum == G) break;
        __builtin_amdgcn_s_sleep(1);
        if ((++sp & 255u) == 0u) { if (xb_ld(&bar[XB_TMO])) break; if (sp > XB_SPIN_CAP) { atomicAdd(&bar[XB_TMO], 1u); break; } }
    }
    nloc = mine > 0u ? mine : 1u; nx = cnt > 0u ? cnt : 1u;
}
__device__ __forceinline__ void xcd_barrier(const XcdBarrier& b, const int wid) {
    asm volatile("s_waitcnt vmcnt(0)" ::: "memory");
    __syncthreads();
    if (wid == 0 && __builtin_amdgcn_mbcnt_hi(~0u, __builtin_amdgcn_mbcnt_lo(~0u, 0u)) == 0u) {
        unsigned* bar = b.bar;
        __builtin_amdgcn_s_waitcnt(0);
        unsigned nloc = b.st[0], nx = b.st[1];
        if (nloc == 0u) { xcd_barrier_complete(bar, b.x, nloc, nx); b.st[0] = nloc; b.st[1] = nx; }
        const unsigned old = xb_add(&bar[XB_XSUB(b.x)], 1u);
        const unsigned gen = old / nloc;
        if (old + 1u == (gen + 1u) * nloc) {
            __builtin_amdgcn_fence(__ATOMIC_RELEASE, "agent");
            asm volatile("s_waitcnt vmcnt(0)" ::: "memory");
            const unsigned og = xb_add(&bar[XB_TOP], 1u);
            const unsigned tg = og / nx;
            if (og + 1u == (tg + 1u) * nx) xb_add(&bar[XB_TOPGEN], 1u);
            else XB_SPIN(xb_ld(&bar[XB_TOPGEN]) == tg, bar);
            __builtin_amdgcn_fence(__ATOMIC_ACQUIRE, "agent");
            xb_add(&bar[XB_XGEN(b.x)], 1u);
            asm volatile("s_waitcnt vmcnt(0)" ::: "memory");
        } else {
            XB_SPIN(xb_ld(&bar[XB_XGEN(b.x)]) == gen, bar);
            __builtin_amdgcn_fence(__ATOMIC_ACQUIRE, "agent");
            asm volatile("s_waitcnt vmcnt(0)" ::: "memory");
        }
    }
    __syncthreads();
}

namespace pg {
constexpr int BM = 256, BK = 64, HALF = 128, HTB = HALF * BK * 2, STAGE_BYTES = 8 * HTB;
__device__ __forceinline__ int lds_byte(int r, int c) { const int st = (r >> 4) * 2 + (c >> 5), rr = r & 15, cc = c & 31, ob = rr * 64 + cc * 2; return st * 1024 + (ob ^ (((ob >> 9) & 1) << 5)); }
__device__ __forceinline__ void stage_rc(int b, int& R, int& C) { const int st = b / 1024, sb = b % 1024, swz = sb ^ (((sb >> 9) & 1) << 5); R = (st >> 1) * 16 + swz / 64; C = (st & 1) * 32 + (swz % 64) / 2; }
__device__ __forceinline__ int perm32(int rho) { const int n = rho >> 4, i = rho & 15; return 8 * (i >> 2) + 4 * n + (i & 3); }
struct Unit { int pm, pn, e; };

template <class Epi, class Sched>
__device__ __forceinline__ void gemm_phase(LAS unsigned char* lds, const int wid_in, const char* Abase, const int K, const Sched& S, const Epi& E) {
    int wid = wid_in; asm volatile("" : "+s"(wid));
    unsigned z_ = 0u; asm volatile("" : "+s"(z_));
    const int lane = (int)__builtin_amdgcn_mbcnt_hi(~0u, __builtin_amdgcn_mbcnt_lo(~0u, z_)), tid = wid * 64 + lane;
    const int wr = wid >> 2, wc = wid & 3, fr = lane & 15, fq = lane >> 4;
    const int nt = K / BK;
    constexpr bool GA = Sched::GATHER;
    unsigned voffA[2], voffB[2];
#pragma unroll
    for (int i = 0; i < 2; ++i) { int R, C; stage_rc(tid * 16 + i * 8192, R, C); const int Rb = Epi::PERM ? ((R & ~31) + perm32(R & 31)) : R; voffA[i] = (unsigned)(R * K + C) * 2u; voffB[i] = (unsigned)(Rb * K + C) * 2u; }
    const size_t kstep = (size_t)(BK * 2);
    const size_t hstep = (size_t)HALF * K * 2;
    const unsigned ldsw = (unsigned)wid * 1024u;
    const int aoff = lds_byte(wr * 64 + fr, fq * 8), boff = lds_byte(wc * 32 + fr, fq * 8);
#define PG_SA(b, h) (((b) * 2 + (h)) * HTB)
#define PG_SB(b, h) ((4 + (b) * 2 + (h)) * HTB)
#define PG_STAGE(bufoff, gbase, voff) do { _Pragma("unroll") for (int _i = 0; _i < 2; ++_i) \
        __builtin_amdgcn_global_load_lds((const unsigned*)((const char*)(gbase) + (voff)[_i]), (LAS unsigned*)(lds + (bufoff) + ldsw + _i * 8192), 16, 0, 0); } while (0)
#define PG_STAGE_A(bufoff, ab, av, h, koff) do { if (GA) { const u32x2 o2_ = *(const LAS u32x2*)(aol + 2 * (h)); unsigned ov_[2] = {o2_.x, o2_.y}; PG_STAGE(bufoff, Abase + (koff), ov_); } else { PG_STAGE(bufoff, (ab) + (h) * hstep + (koff), voffA); } } while (0)
#define PG_LDA(dst, b, h) do { _Pragma("unroll") for (int m = 0; m < 4; ++m) _Pragma("unroll") for (int k = 0; k < 2; ++k) dst[m][k] = *(const LAS bf16x8*)(lds + PG_SA(b, h) + aoff + m * 2048 + k * 1024); } while (0)
#define PG_LDB(dst, b, h) do { _Pragma("unroll") for (int n = 0; n < 2; ++n) _Pragma("unroll") for (int k = 0; k < 2; ++k) dst[n][k] = *(const LAS bf16x8*)(lds + PG_SB(b, h) + boff + n * 2048 + k * 1024); } while (0)
#define PG_MMA(ai, bj, At, Bt) do { __builtin_amdgcn_s_setprio(1); _Pragma("unroll") for (int m = 0; m < 4; ++m) _Pragma("unroll") for (int n = 0; n < 2; ++n) _Pragma("unroll") for (int k = 0; k < 2; ++k) \
        acc[ai][bj][m][n] = __builtin_amdgcn_mfma_f32_16x16x32_bf16(Bt[n][k], At[m][k], acc[ai][bj][m][n], 0, 0, 0); __builtin_amdgcn_s_setprio(0); } while (0)
#define PG_WAIT_V(n) asm volatile("s_waitcnt vmcnt(" #n ")" ::: "memory")
#define PG_WAIT_L(n) asm volatile("s_waitcnt lgkmcnt(" #n ")" ::: "memory")
#define PG_BAR __builtin_amdgcn_s_barrier()
#define PG_SCHED __builtin_amdgcn_sched_barrier(0)
    Unit cur, nxt; int ui = 0;
    if (!S.next(0, cur)) return;
    LAS int* rtab = (LAS int*)(lds + STAGE_BYTES);
    LAS unsigned* aol = (LAS unsigned*)(lds + STAGE_BYTES + 2048) + tid * 4;
#define PG_AO_FROM_TABLE(tb) do { u32x4 o_; { int R_, C_; stage_rc(tid * 16, R_, C_); o_.x = (unsigned)(rtab[(tb) * 256 + R_] * K + C_) * 2u; o_.z = (unsigned)(rtab[(tb) * 256 + 128 + R_] * K + C_) * 2u; } \
        { int R_, C_; stage_rc(tid * 16 + 8192, R_, C_); o_.y = (unsigned)(rtab[(tb) * 256 + R_] * K + C_) * 2u; o_.w = (unsigned)(rtab[(tb) * 256 + 128 + R_] * K + C_) * 2u; } *(LAS u32x4*)aol = o_; } while (0)
    if (GA) { if (tid < 256) rtab[tid] = S.arow(cur, tid); __syncthreads(); PG_AO_FROM_TABLE(0); }
    const char* cA = GA ? Abase : Abase + S.aunit(cur, K);
    const char* cB = S.bptr(cur, K);
    f32x4 acc[2][2][4][2];
#pragma unroll
    for (int a = 0; a < 2; ++a)
#pragma unroll
        for (int b = 0; b < 2; ++b)
#pragma unroll
            for (int m = 0; m < 4; ++m)
#pragma unroll
                for (int n = 0; n < 2; ++n) acc[a][b][m][n] = (f32x4){0.f, 0.f, 0.f, 0.f};
    bf16x8 At[4][2], B0[2][2], B1[2][2];
    PG_STAGE(PG_SB(0, 0), cB, voffB); PG_STAGE_A(PG_SA(0, 0), cA, 0, 0, 0); PG_STAGE(PG_SB(0, 1), cB + hstep, voffB); PG_STAGE_A(PG_SA(0, 1), cA, 0, 1, 0);
    if (wr == 1) PG_BAR;
    PG_WAIT_V(4); PG_BAR;
    PG_STAGE(PG_SB(1, 0), cB + kstep, voffB); PG_STAGE_A(PG_SA(1, 0), cA, 0, 0, kstep); PG_STAGE(PG_SB(1, 1), cB + hstep + kstep, voffB);
    PG_WAIT_V(6); PG_BAR;
    for (;;) {
        const bool has_next = S.next(ui + 1, nxt);
        const char* nA = cA; const char* nB = cB;
        if (has_next) { if (GA) { if (wid < 4) __builtin_amdgcn_global_load_lds((const unsigned*)S.arowp(nxt, tid), (LAS unsigned*)(rtab + ((ui + 1) & 1) * 256 + wid * 64), 4, 0, 0); }
            else nA = Abase + S.aunit(nxt, K); nB = S.bptr(nxt, K); }
        for (int t = 0; t < nt; t += 2) {
            const bool last = (t == nt - 2);
            const size_t k1 = (size_t)(t + 1) * kstep, k2 = last ? 0 : (size_t)(t + 2) * kstep, k3 = k2 + kstep;
            const char* a2 = last ? nA : cA; const char* b2 = last ? nB : cB;
            PG_LDB(B0, 0, 0); PG_SCHED; PG_LDA(At, 0, 0); PG_STAGE_A(PG_SA(1, 1), cA, 0, 1, k1);
            if (GA && last && has_next) { PG_AO_FROM_TABLE((ui + 1) & 1); }
            PG_WAIT_L(8); PG_BAR; PG_WAIT_L(0); PG_MMA(0, 0, At, B0); PG_BAR; PG_SCHED;
            PG_LDB(B1, 0, 1); PG_STAGE(PG_SB(0, 0), b2 + k2, voffB);
            PG_BAR; PG_WAIT_L(0); PG_MMA(0, 1, At, B1); PG_BAR;
            PG_LDA(At, 0, 1); PG_STAGE_A(PG_SA(0, 0), a2, 0, 0, k2);
            PG_BAR; PG_WAIT_L(0); PG_MMA(1, 0, At, B0); PG_BAR; PG_SCHED;
            PG_STAGE(PG_SB(0, 1), b2 + hstep + k2, voffB);
            PG_WAIT_V(6); PG_BAR; PG_MMA(1, 1, At, B1); PG_BAR;
            PG_LDB(B0, 1, 0); PG_SCHED; PG_LDA(At, 1, 0); PG_STAGE_A(PG_SA(0, 1), a2, 0, 1, k2);
            PG_WAIT_L(8); PG_BAR; PG_WAIT_L(0); PG_MMA(0, 0, At, B0); PG_BAR; PG_SCHED;
            PG_LDB(B1, 1, 1); PG_STAGE(PG_SB(1, 0), b2 + k3, voffB);
            PG_BAR; PG_WAIT_L(0); PG_MMA(0, 1, At, B1); PG_BAR;
            PG_LDA(At, 1, 1); PG_STAGE_A(PG_SA(1, 0), a2, 0, 0, k3);
            PG_BAR; PG_WAIT_L(0); PG_MMA(1, 0, At, B0); PG_BAR; PG_SCHED;
            PG_STAGE(PG_SB(1, 1), b2 + hstep + k3, voffB);
            PG_WAIT_V(6); PG_BAR; PG_MMA(1, 1, At, B1); PG_BAR;
        }
        E(acc, cur, wr, wc, fr, fq);
        if (!has_next) break;
#pragma unroll
        for (int a = 0; a < 2; ++a)
#pragma unroll
            for (int b = 0; b < 2; ++b)
#pragma unroll
                for (int m = 0; m < 4; ++m)
#pragma unroll
                    for (int n = 0; n < 2; ++n) acc[a][b][m][n] = (f32x4){0.f, 0.f, 0.f, 0.f};
        cur = nxt; cA = nA; cB = nB; ++ui;
    }
    PG_WAIT_V(0);
    if (wr == 0) PG_BAR;
    PG_BAR;
#undef PG_SA
#undef PG_SB
#undef PG_STAGE
#undef PG_STAGE_A
#undef PG_AO_FROM_TABLE
#undef PG_LDA
#undef PG_LDB
#undef PG_MMA
#undef PG_WAIT_V
#undef PG_WAIT_L
#undef PG_BAR
#undef PG_SCHED
}

struct SchedDense {
    static constexpr bool GATHER = false;
    int nM, nN, nwg, G, c; const char* Bt;
    __device__ __forceinline__ bool next(int i, Unit& u) const {
        const long L = (long)i * G + c; if (L >= nwg) return false;
        int wgid = (int)L; { const int q = nwg / 8, r = nwg % 8, xcd = wgid % 8, off = wgid / 8; wgid = (xcd < r ? xcd * (q + 1) : r * (q + 1) + (xcd - r) * q) + off; }
        const int nig = 8 * nN, gid = wgid / nig, fm = gid * 8, gsz = (nM - fm) < 8 ? (nM - fm) : 8;
        u.pm = fm + ((wgid % nig) % gsz); u.pn = (wgid % nig) / gsz; u.e = 0; return true;
    }
    __device__ __forceinline__ int arow(const Unit&, int) const { return 0; }
    __device__ __forceinline__ const int* arowp(const Unit&, int) const { return nullptr; }
    __device__ __forceinline__ size_t aunit(const Unit& u, int K) const { return (size_t)u.pm * 256 * K * 2; }
    __device__ __forceinline__ const char* bptr(const Unit& u, int K) const { return Bt + (size_t)u.pn * 256 * K * 2; }
};
struct SchedMoE1 {
    static constexpr bool GATHER = true;
    int G, c; const int* ridx; const char* Bt;
    __device__ __forceinline__ bool next(int i, Unit& u) const {
        const int L = i * G + c; if (L >= NEXP * 17 * 16) return false;
        u.e = L / 272; const int rem = L % 272; u.pm = rem % 17; u.pn = rem / 17; return true;
    }
    __device__ __forceinline__ int arow(const Unit& u, int r) const { return ridx[u.e * EROWS + u.pm * 256 + r]; }
    __device__ __forceinline__ const int* arowp(const Unit& u, int r) const { return ridx + u.e * EROWS + u.pm * 256 + r; }
    __device__ __forceinline__ size_t aunit(const Unit&, int) const { return 0; }
    __device__ __forceinline__ const char* bptr(const Unit& u, int K) const { return Bt + ((size_t)u.e * 4096 + (size_t)u.pn * 256) * K * 2; }
};
struct SchedMoE2 {
    static constexpr bool GATHER = false;
    int G, c; const char* Bt;
    __device__ __forceinline__ bool next(int i, Unit& u) const {
        const int L = i * G + c; if (L >= NEXP * 17 * 4) return false;
        u.e = L / 68; const int rem = L % 68; u.pm = rem % 17; u.pn = rem / 17; return true;
    }
    __device__ __forceinline__ int arow(const Unit&, int) const { return 0; }
    __device__ __forceinline__ const int* arowp(const Unit&, int) const { return nullptr; }
    __device__ __forceinline__ size_t aunit(const Unit& u, int K) const { return (size_t)(u.e * EROWS + u.pm * 256) * K * 2; }
    __device__ __forceinline__ const char* bptr(const Unit& u, int K) const { return Bt + ((size_t)u.e * 1024 + (size_t)u.pn * 256) * K * 2; }
};

struct EpiProj {
    static constexpr bool PERM = true;
    bf16_t* O; int ldc;
    __device__ __forceinline__ void operator()(const f32x4 (&acc)[2][2][4][2], const Unit& u, int wr, int wc, int fr, int fq) const {
        const int row0 = u.pm * BM + wr * 64 + fr, col0 = u.pn * BM + wc * 32 + 8 * fq;
#pragma unroll
        for (int ai = 0; ai < 2; ++ai)
#pragma unroll
            for (int m = 0; m < 4; ++m) { bf16_t* rowp = O + (size_t)(row0 + ai * HALF + m * 16) * ldc + col0;
#pragma unroll
                for (int bj = 0; bj < 2; ++bj) { const f32x4 v0 = acc[ai][bj][m][0], v1 = acc[ai][bj][m][1];
                    u32x4 w; w.x = cvt_pk_bf16(v0[0], v0[1]); w.y = cvt_pk_bf16(v0[2], v0[3]); w.z = cvt_pk_bf16(v1[0], v1[1]); w.w = cvt_pk_bf16(v1[2], v1[3]);
                    *(u32x4*)(rowp + bj * HALF) = w; } }
    }
};
struct EpiResid {
    static constexpr bool PERM = false;
    float* H; int ldc;
    __device__ __forceinline__ void operator()(const f32x4 (&acc)[2][2][4][2], const Unit& u, int wr, int wc, int fr, int fq) const {
        const int row0 = u.pm * BM + wr * 64 + fr, col0 = u.pn * BM + wc * 32 + 4 * fq;
#pragma unroll
        for (int ai = 0; ai < 2; ++ai)
#pragma unroll
            for (int m = 0; m < 4; ++m) { float* rowp = H + (size_t)(row0 + ai * HALF + m * 16) * ldc + col0;
#pragma unroll
                for (int bj = 0; bj < 2; ++bj)
#pragma unroll
                    for (int n = 0; n < 2; ++n) { f32x4* p = (f32x4*)(rowp + bj * HALF + n * 16); *p = *p + acc[ai][bj][m][n]; } }
    }
};
struct EpiGateUp {
    static constexpr bool PERM = true;
    bf16_t* ACT;
    __device__ __forceinline__ void operator()(const f32x4 (&acc)[2][2][4][2], const Unit& u, int wr, int wc, int fr, int fq) const {
        const int row0 = u.e * EROWS + u.pm * BM + wr * 64 + fr, col0 = u.pn * 128 + wc * 32 + 8 * fq;
#pragma unroll
        for (int ai = 0; ai < 2; ++ai)
#pragma unroll
            for (int m = 0; m < 4; ++m) { bf16_t* p = ACT + (size_t)(row0 + ai * HALF + m * 16) * FF + col0;
                float r[8];
#pragma unroll
                for (int n = 0; n < 2; ++n)
#pragma unroll
                    for (int j = 0; j < 4; ++j) r[n * 4 + j] = silu_f(acc[ai][0][m][n][j]) * acc[ai][1][m][n][j];
                u32x4 w; w.x = cvt_pk_bf16(r[0], r[1]); w.y = cvt_pk_bf16(r[2], r[3]); w.z = cvt_pk_bf16(r[4], r[5]); w.w = cvt_pk_bf16(r[6], r[7]);
                *(u32x4*)p = w; }
    }
};
struct EpiDown {
    static constexpr bool PERM = true;
    bf16_t* Y; const float* gate;
    __device__ __forceinline__ void operator()(const f32x4 (&acc)[2][2][4][2], const Unit& u, int wr, int wc, int fr, int fq) const {
        const int row0 = u.e * EROWS + u.pm * BM + wr * 64 + fr, col0 = u.pn * BM + wc * 32 + 8 * fq;
#pragma unroll
        for (int ai = 0; ai < 2; ++ai)
#pragma unroll
            for (int m = 0; m < 4; ++m) { const int row = row0 + ai * HALF + m * 16; const float g = gate[row]; bf16_t* rowp = Y + (size_t)row * DM + col0;
#pragma unroll
                for (int bj = 0; bj < 2; ++bj) { const f32x4 v0 = acc[ai][bj][m][0] * g, v1 = acc[ai][bj][m][1] * g;
                    u32x4 w; w.x = cvt_pk_bf16(v0[0], v0[1]); w.y = cvt_pk_bf16(v0[2], v0[3]); w.z = cvt_pk_bf16(v1[0], v1[1]); w.w = cvt_pk_bf16(v1[2], v1[3]);
                    *(u32x4*)(rowp + bj * HALF) = w; } }
    }
};
}

struct Args { const float* in[21]; float* out; unsigned char* ws; int ph_lo, ph_hi; };
enum { I_X = 0, I_META, I_NORM1, I_WIN, I_QNW, I_KNW, I_ANW, I_HLB, I_HNW, I_CONVW, I_CONVB, I_DTB, I_ALOG, I_DSKIP, I_SNW, I_WOUT, I_NORM2, I_ROUTER, I_WGATE, I_WUP, I_WDOWN };

struct Ctx {
    const Args* a; unsigned char* ws; LAS char* smem; int tid, lane, wid, G, bid;
#define CTX_PTR(name, type, off) __device__ __forceinline__ type* name() const { return (type*)(ws + (off)); }
    CTX_PTR(H, float, WS_H) CTX_PTR(U, bf16_t, WS_U) CTX_PTR(DT, float, WS_DT) CTX_PTR(AFFT, float, WS_AFFT) CTX_PTR(SEL, int, WS_SEL) CTX_PTR(RIDX, int, WS_RIDX) CTX_PTR(GATE, float, WS_GATE)
    CTX_PTR(XBC, bf16_t, WS_XBC) CTX_PTR(ATT, bf16_t, WS_ATT) CTX_PTR(OF, bf16_t, WS_OF) CTX_PTR(OB, bf16_t, WS_OB) CTX_PTR(YF, bf16_t, WS_YF) CTX_PTR(YB, bf16_t, WS_YB)
    CTX_PTR(MIX, bf16_t, WS_MIX) CTX_PTR(PROJ, bf16_t, WS_PROJ) CTX_PTR(ACT, bf16_t, WS_ACT) CTX_PTR(Y, bf16_t, WS_Y)
    CTX_PTR(WIN, bf16_t, WS_WIN) CTX_PTR(WOUT, bf16_t, WS_WOUT) CTX_PTR(WGU, bf16_t, WS_WGU) CTX_PTR(WD, bf16_t, WS_WD) CTX_PTR(ROPE, float, WS_ROPE) CTX_PTR(LB, float, WS_LB)
#undef CTX_PTR
};

__device__ __forceinline__ int og(int v) { asm volatile("" : "+s"(v)); return v; }
__device__ __forceinline__ Ctx fresh(const Ctx& c0) {
    Ctx c = c0; int w_ = c0.wid, g_ = c0.G, b_ = c0.bid; unsigned z_ = 0u; asm volatile("" : "+s"(w_), "+s"(g_), "+s"(b_), "+s"(z_)); c.wid = w_; c.G = g_; c.bid = b_;
    c.lane = (int)__builtin_amdgcn_mbcnt_hi(~0u, __builtin_amdgcn_mbcnt_lo(~0u, z_)); c.tid = w_ * 64 + c.lane;
    unsigned char* w = c0.ws; asm volatile("" : "+s"(w)); c.ws = w; return c;
}
__device__ void phase_tables(const Ctx& c0) {
    const Ctx c = fresh(c0);
    const int gt = c.bid * 512 + c.tid, gs = c.G * 512;
    for (int idx = gt; idx < 4096 * 32; idx += gs) {
        const int tok = idx >> 5, i = idx & 31;
        const float pos = (float)((i < 16) ? (tok >> 6) : (tok & 63));
        const float inv = powf(10000.0f, -(float)(i & 15) / 16.0f);
        const float ang = pos * inv;
        c.ROPE()[idx] = cosf(ang); c.ROPE()[4096 * 32 + idx] = sinf(ang);
    }
    for (int idx = gt; idx < 2 * 512; idx += gs) {
        const int dir = idx >> 9, d = idx & 511;
        const float* lbp = c.a->in[I_HLB] + (size_t)dir * DEPTH * 512 + d;
        float v[DEPTH], mx = -INFINITY;
        for (int l = 0; l < DEPTH; ++l) { v[l] = lbp[l * 512]; mx = fmaxf(mx, v[l]); }
        float s = 0.f; for (int l = 0; l < DEPTH; ++l) { v[l] = expf(v[l] - mx); s += v[l]; }
        float cum = 0.f;
        for (int l = 0; l < DEPTH; ++l) { const float p = v[l] / s; cum += p; const float lb = fminf(fmaxf(cum - v[0] / s, 0.f), 1.f); c.LB()[(dir * DEPTH + l) * 512 + d] = lb; }
    }
    for (int idx = gt; idx < NEXP * (EROWS - NB * CAP); idx += gs) { const int e = idx / (EROWS - NB * CAP), r = idx % (EROWS - NB * CAP); c.RIDX()[e * EROWS + NB * CAP + r] = 0; }
}

__device__ __forceinline__ void convert_tile(const Ctx& c, const float* src, int ld_src, int k0, int n0, bf16_t* dst, int ld_dst, int nrow0, LAS float* T) {
    const int tid = c.tid;
    __syncthreads();
#pragma unroll
    for (int i = 0; i < 2; ++i) { const int k = (tid >> 4) + 32 * i, n4 = (tid & 15) * 4; const f32x4 v = *(const f32x4*)(src + (size_t)(k0 + k) * ld_src + n0 + n4);
        T[k * 65 + n4 + 0] = v[0]; T[k * 65 + n4 + 1] = v[1]; T[k * 65 + n4 + 2] = v[2]; T[k * 65 + n4 + 3] = v[3]; }
    __syncthreads();
    { const int n = tid >> 3, k8 = (tid & 7) * 8; float r[8];
#pragma unroll
      for (int j = 0; j < 8; ++j) r[j] = T[(k8 + j) * 65 + n];
      u32x4 w; w.x = cvt_pk_bf16(r[0], r[1]); w.y = cvt_pk_bf16(r[2], r[3]); w.z = cvt_pk_bf16(r[4], r[5]); w.w = cvt_pk_bf16(r[6], r[7]);
      *(u32x4*)(dst + (size_t)(nrow0 + n) * ld_dst + k0 + k8) = w; }
}
__device__ void convert_weights(const Ctx& c0, int layer, LAS float* T) {
    const Ctx c = fresh(c0);
    constexpr int T_IN = 16 * 72, T_OUT = 24 * 16, T_G = 16 * 16 * 32, T_D = 16 * 32 * 16, T_ALL = T_IN + T_OUT + 2 * T_G + T_D;
    for (int t = c.bid; t < T_ALL; t += c.G) {
        if (t < T_IN) { const int kt = t % 16, ntl = t / 16;
            convert_tile(c, c.a->in[I_WIN] + (size_t)layer * DM * INW, INW, kt * 64, ntl * 64, c.WIN(), DM, ntl * 64, T);
        } else if (t < T_IN + T_OUT) { const int u = t - T_IN, kt = u % 24, ntl = u / 24;
            convert_tile(c, c.a->in[I_WOUT] + (size_t)layer * MIXW * DM, DM, kt * 64, ntl * 64, c.WOUT(), MIXW, ntl * 64, T);
        } else if (t < T_IN + T_OUT + 2 * T_G) { int u = t - T_IN - T_OUT; const int which = u / T_G; u %= T_G; const int e = u / 512, r = u % 512, kt = r % 16, ntl = r / 16;
            const float* src = c.a->in[which ? I_WUP : I_WGATE] + ((size_t)layer * NEXP + e) * DM * FF;
            const int f0 = ntl * 64, pn = f0 >> 7, j0 = f0 & 127;
            convert_tile(c, src, FF, kt * 64, f0, c.WGU() + (size_t)e * 4096 * DM, DM, pn * 256 + which * 128 + j0, T);
        } else { const int u = t - T_IN - T_OUT - 2 * T_G; const int e = u / 512, r = u % 512, kt = r % 32, ntl = r / 32;
            const float* src = c.a->in[I_WDOWN] + ((size_t)layer * NEXP + e) * FF * DM;
            convert_tile(c, src, DM, kt * 64, ntl * 64, c.WD() + (size_t)e * DM * FF, FF, ntl * 64, T);
        }
    }
}

template <bool ROUTER>
__device__ void phase_norm(const Ctx& c0, int layer) {
    const Ctx c = fresh(c0);
    LAS float* W16 = (LAS float*)c.smem;
    if (ROUTER) { const float* src = c.a->in[I_ROUTER] + (size_t)layer * DM * NEXP; for (int i = c.tid; i < DM * 16; i += 512) W16[(i & 15) * DM + (i >> 4)] = src[i]; }
    else { const float* src = c.a->in[I_WIN] + (size_t)layer * DM * INW + C_DT; for (int i = c.tid; i < DM * 16; i += 512) W16[(i & 15) * DM + (i >> 4)] = src[(size_t)(i >> 4) * INW + (i & 15)]; }
    __syncthreads();
    const float* wn = c.a->in[ROUTER ? I_NORM2 : I_NORM1] + (size_t)layer * DM;
    const int lane = c.lane;
    for (int row = c.bid * 8 + c.wid; row < ROWS; row += c.G * 8) {
        f32x4 v[4];
        if (!ROUTER && layer == 0) {
            const float* src = row < ROWS_REAL ? c.a->in[I_X] + (size_t)row * DM : c.a->in[I_META] + (size_t)((row - ROWS_REAL) & 15) * DM;
#pragma unroll
            for (int i = 0; i < 4; ++i) v[i] = *(const f32x4*)(src + 4 * lane + 256 * i);
        } else {
#pragma unroll
            for (int i = 0; i < 4; ++i) v[i] = *(const f32x4*)(c.H() + (size_t)row * DM + 4 * lane + 256 * i);
        }
        if (!ROUTER && layer > 0) {
            const int s = lane < 16 ? c.SEL()[row * 16 + lane] : -1;
            for (int e = 0; e < 16; ++e) { const int se = __shfl(s, e);
                if (se >= 0) {
#pragma unroll
                    for (int i = 0; i < 4; ++i) { const u32x2 w = *(const u32x2*)(c.Y() + (size_t)se * DM + 4 * lane + 256 * i);
                        v[i][0] += bflo(w.x); v[i][1] += bfhi(w.x); v[i][2] += bflo(w.y); v[i][3] += bfhi(w.y); } } }
        }
        if (!ROUTER) {
#pragma unroll
            for (int i = 0; i < 4; ++i) *(f32x4*)(c.H() + (size_t)row * DM + 4 * lane + 256 * i) = v[i];
        }
        float ss = 0.f;
#pragma unroll
        for (int i = 0; i < 4; ++i) ss += v[i][0] * v[i][0] + v[i][1] * v[i][1] + v[i][2] * v[i][2] + v[i][3] * v[i][3];
        ss = wave_sum(ss);
        const float rstd = rsqrtf(ss * (1.0f / DM) + EPS);
        float acc[16];
#pragma unroll
        for (int j = 0; j < 16; ++j) acc[j] = 0.f;
#pragma unroll
        for (int i = 0; i < 4; ++i) { const f32x4 w = *(const f32x4*)(wn + 4 * lane + 256 * i); f32x4 un = v[i] * rstd * w;
            u32x2 pk; pk.x = cvt_pk_bf16(un[0], un[1]); pk.y = cvt_pk_bf16(un[2], un[3]);
            *(u32x2*)(c.U() + (size_t)row * DM + 4 * lane + 256 * i) = pk;
#pragma unroll
            for (int j = 0; j < 16; ++j) { const f32x4 ww = *(const LAS f32x4*)(W16 + j * DM + 4 * lane + 256 * i);
                acc[j] += un[0] * ww[0] + un[1] * ww[1] + un[2] * ww[2] + un[3] * ww[3]; } }
#pragma unroll
        for (int j = 0; j < 16; ++j) acc[j] = wave_sum(acc[j]);
        if (!ROUTER) {
            float o = 0.f;
#pragma unroll
            for (int j = 0; j < 16; ++j) o = (lane == j) ? acc[j] : o;
            if (lane < 16) c.DT()[row * 16 + lane] = o;
        } else {
            float mx = acc[0];
#pragma unroll
            for (int j = 1; j < 16; ++j) mx = fmaxf(mx, acc[j]);
            float s = 0.f;
#pragma unroll
            for (int j = 0; j < 16; ++j) { acc[j] = __expf(acc[j] - mx); s += acc[j]; }
            const float inv = 1.0f / s;
            float o = 0.f;
#pragma unroll
            for (int j = 0; j < 16; ++j) o = (lane == j) ? acc[j] * inv : o;
            int b, t; if (row < ROWS_REAL) { b = row >> 12; t = (row & 4095) + NMETA; } else { b = (row - ROWS_REAL) >> 4; t = (row - ROWS_REAL) & 15; }
            if (lane < 16) c.AFFT()[(size_t)(b * 16 + lane) * LTOK + t] = o;
        }
    }
}

__device__ void phase_prep(const Ctx& c0, int layer) {
    const Ctx c = fresh(c0);
    LAS float* CW = (LAS float*)c.smem;
    { const float* cw = c.a->in[I_CONVW] + (size_t)layer * 768 * 7; const float* cb = c.a->in[I_CONVB] + (size_t)layer * 768;
      for (int i = c.tid; i < 768 * 8; i += 512) { const int ch = i >> 3, tp = i & 7; CW[i] = tp < 7 ? cw[ch * 7 + tp] : cb[ch]; } }
    __syncthreads();
    const int lane = c.lane;
    const float* qw = c.a->in[I_QNW] + layer * 64; const float* kw = c.a->in[I_KNW] + layer * 64;
    for (int row = c.bid * 8 + c.wid; row < ROWS; row += c.G * 8) {
        int b, t; if (row < ROWS_REAL) { b = row >> 12; t = (row & 4095) + NMETA; } else { b = (row - ROWS_REAL) >> 4; t = (row - ROWS_REAL) & 15; }
        bf16_t* prow = c.PROJ() + (size_t)row * PROJW;
#pragma unroll
        for (int pass = 0; pass < 2; ++pass) {
            const bool act = pass == 0 || lane < 16;
            bf16_t* p = prow + (pass == 0 ? C_AQ : C_AK) + 8 * lane;
            float x[8];
            if (act) { const u32x4 w = *(const u32x4*)p; x[0] = bflo(w.x); x[1] = bfhi(w.x); x[2] = bflo(w.y); x[3] = bfhi(w.y); x[4] = bflo(w.z); x[5] = bfhi(w.z); x[6] = bflo(w.w); x[7] = bfhi(w.w); }
            else {
#pragma unroll
                for (int j = 0; j < 8; ++j) x[j] = 0.f; }
            float ss = 0.f;
#pragma unroll
            for (int j = 0; j < 8; ++j) ss += x[j] * x[j];
            ss += __shfl_xor(ss, 1); ss += __shfl_xor(ss, 2); ss += __shfl_xor(ss, 4);
            const float rstd = rsqrtf(ss * (1.0f / 64.0f) + EPS);
            const int d0 = 8 * (lane & 7);
            const float* nw = pass == 0 ? qw : kw;
            float xn[8], xp[8];
#pragma unroll
            for (int j = 0; j < 8; ++j) xn[j] = x[j] * rstd * nw[d0 + j];
#pragma unroll
            for (int j = 0; j < 8; ++j) xp[j] = __shfl_xor(xn[j], 4);
            float o[8];
            if (t >= NMETA) {
                const int tok = t - NMETA; const float* cs = c.ROPE() + (size_t)tok * 32 + (d0 & 31); const float* sn = c.ROPE() + 4096 * 32 + (size_t)tok * 32 + (d0 & 31);
#pragma unroll
                for (int j = 0; j < 8; ++j) { const float cc = cs[j], s = sn[j]; o[j] = (d0 < 32) ? (xn[j] * cc - xp[j] * s) : (xp[j] * s + xn[j] * cc); }
            } else {
#pragma unroll
                for (int j = 0; j < 8; ++j) o[j] = xn[j];
            }
            const float sc = pass == 0 ? QSCALE : 1.0f;
            if (act) { u32x4 w; w.x = cvt_pk_bf16(o[0] * sc, o[1] * sc); w.y = cvt_pk_bf16(o[2] * sc, o[3] * sc); w.z = cvt_pk_bf16(o[4] * sc, o[5] * sc); w.w = cvt_pk_bf16(o[6] * sc, o[7] * sc); *(u32x4*)p = w; }
        }
        float a[3][4];
#pragma unroll
        for (int i = 0; i < 3; ++i)
#pragma unroll
            for (int q = 0; q < 4; ++q) a[i][q] = CW[(4 * lane + 256 * i + q) * 8 + 7];
#pragma unroll
        for (int tp = 0; tp < 7; ++tp) { const int tt = t + tp - 3;
            if (tt >= 0 && tt < LTOK) { const bf16_t* nr = c.PROJ() + (size_t)row_of(b, tt) * PROJW + C_XBC;
#pragma unroll
                for (int i = 0; i < 3; ++i) { const u32x2 w = *(const u32x2*)(nr + 4 * lane + 256 * i); const int ch = 4 * lane + 256 * i;
                    a[i][0] += CW[(ch + 0) * 8 + tp] * bflo(w.x); a[i][1] += CW[(ch + 1) * 8 + tp] * bfhi(w.x); a[i][2] += CW[(ch + 2) * 8 + tp] * bflo(w.y); a[i][3] += CW[(ch + 3) * 8 + tp] * bfhi(w.y); } } }
#pragma unroll
        for (int i = 0; i < 3; ++i) { u32x2 w; w.x = cvt_pk_bf16(silu_f(a[i][0]), silu_f(a[i][1])); w.y = cvt_pk_bf16(silu_f(a[i][2]), silu_f(a[i][3]));
            *(u32x2*)(c.XBC() + (size_t)row * 768 + 4 * lane + 256 * i) = w; }
    }
}

namespace att {
using bf16=unsigned short;
using bf16x8=__attribute__((ext_vector_type(8)))short;
using s16x4=__attribute__((ext_vector_type(4)))short;
using f32x16=__attribute__((ext_vector_type(16)))float;
using u32x4=__attribute__((ext_vector_type(4)))unsigned;
constexpr int NW=8,QBLK=32,KVBLK=64,NT=65;
__device__ __forceinline__ int crow(int r,int hi){return (r&3)+8*(r>>2)+4*hi;}
#define SBAR() __builtin_amdgcn_sched_barrier(0)
__device__ __forceinline__ void tmask(f32x16&p0,f32x16&p1){
  const float NEG=-INFINITY;
  #pragma unroll
  for(int r=0;r<16;++r){ if(r>=8)p0[r]=NEG; p1[r]=NEG; }
}

constexpr int NSLOT=3, SLOTB=8192;
constexpr int LDS_K=0, LDS_V=NSLOT*SLOTB, LDS_WS=2*NSLOT*SLOTB, LDS_OST=LDS_WS+NW*64*4, LDS_BYTES=LDS_OST+NW*4096;
constexpr float C2=0.125f*1.4426950408889634f;
__device__ __forceinline__ void glds16(const void*sbase,unsigned voff,unsigned lds_dst){unsigned keep;
  asm volatile("s_mov_b32 %0, m0\n\ts_mov_b32 m0, %3\n\ts_nop 0\n\tglobal_load_lds_dwordx4 %1, %2\n\ts_mov_b32 m0, %0":"=&s"(keep):"v"(voff),"s"(sbase),"s"(lds_dst):"memory");}
__device__ __forceinline__ float max3f(float a,float b,float c){float r;asm("v_max3_f32 %0, %1, %2, %3":"=v"(r):"v"(a),"v"(b),"v"(c));return r;}
__device__ __forceinline__ float max2f(float a,float b){float r;asm("v_max_f32_e32 %0, %1, %2":"=v"(r):"v"(a),"v"(b));return r;}
__device__ __forceinline__ float fadd_s(float a,float b){float r;asm("v_add_f32_e32 %0, %1, %2":"=v"(r):"v"(a),"v"(b));return r;}
__device__ __forceinline__ float fsub_s(float a,float b){float r;asm("v_sub_f32_e32 %0, %1, %2":"=v"(r):"v"(a),"v"(b));return r;}
typedef float f32x2_t __attribute__((ext_vector_type(2))); typedef __bf16 bf16x2_t __attribute__((ext_vector_type(2)));
__device__ __forceinline__ unsigned cvtpk_s(float lo,float hi){f32x2_t v={lo,hi};bf16x2_t b=__builtin_convertvector(v,bf16x2_t);return __builtin_bit_cast(unsigned,b);}
#define WAIT_BAR(N) asm volatile("s_waitcnt vmcnt(" #N ") lgkmcnt(0)\n\ts_barrier":::"memory")

__device__ __forceinline__ void qkt(f32x16&p0,f32x16&p1,const char*Kslot,const bf16x8*qr,const f32x16&negm,int r32,int hi){
  const char*kb=Kslot+hi*1024+r32*16;
  #pragma unroll
  for(int d0=0;d0<4;++d0){
    const bf16x8 b0=*reinterpret_cast<const bf16x8*>(kb+d0*2048);
    const bf16x8 b1=*reinterpret_cast<const bf16x8*>(kb+d0*2048+512);
    if(d0==0){p0=__builtin_amdgcn_mfma_f32_32x32x16_bf16(b0,qr[0],negm,0,0,0);p1=__builtin_amdgcn_mfma_f32_32x32x16_bf16(b1,qr[0],negm,0,0,0);}
    else{p0=__builtin_amdgcn_mfma_f32_32x32x16_bf16(b0,qr[d0],p0,0,0,0);p1=__builtin_amdgcn_mfma_f32_32x32x16_bf16(b1,qr[d0],p1,0,0,0);}}
}
typedef __attribute__((address_space(3))) const char* lds_cptr;
typedef short v4i16_t __attribute__((ext_vector_type(4)));
__device__ __forceinline__ void kload8(bf16x8*kf,lds_cptr kp){
  kf[0]=*(const __attribute__((address_space(3))) bf16x8*)(kp);      kf[1]=*(const __attribute__((address_space(3))) bf16x8*)(kp+512);
  kf[2]=*(const __attribute__((address_space(3))) bf16x8*)(kp+2048); kf[3]=*(const __attribute__((address_space(3))) bf16x8*)(kp+2560);
  kf[4]=*(const __attribute__((address_space(3))) bf16x8*)(kp+4096); kf[5]=*(const __attribute__((address_space(3))) bf16x8*)(kp+4608);
  kf[6]=*(const __attribute__((address_space(3))) bf16x8*)(kp+6144); kf[7]=*(const __attribute__((address_space(3))) bf16x8*)(kp+6656);
}
__device__ __forceinline__ void kload2(bf16x8*kf,lds_cptr kp,int j){ kf[2*j]=*(const __attribute__((address_space(3))) bf16x8*)(kp+j*2048); kf[2*j+1]=*(const __attribute__((address_space(3))) bf16x8*)(kp+j*2048+512); }
__device__ __forceinline__ s16x4 vtr(lds_cptr p){ return __builtin_bit_cast(s16x4,__builtin_amdgcn_ds_read_tr16_b64_v4i16((__attribute__((address_space(3))) v4i16_t*)p)); }
__device__ __forceinline__ float rowmax(const f32x16&p0,const f32x16&p1){
  float a=max3f(p0[0],p0[1],p1[0]),b=max3f(p0[2],p0[3],p1[1]);a=max3f(a,p1[2],p1[3]);
  #pragma unroll
  for(int r=4;r<16;r+=4){a=max3f(a,p0[r],p0[r+1]);b=max3f(b,p0[r+2],p0[r+3]);a=max3f(a,p1[r],p1[r+1]);b=max3f(b,p1[r+2],p1[r+3]);}
  const float m=max2f(a,b);
  auto rr=__builtin_amdgcn_permlane32_swap(__float_as_uint(m),__float_as_uint(m),false,false);
  return max2f(__uint_as_float(rr[0]),__uint_as_float(rr[1]));
}
__device__ __forceinline__ void pv(f32x16*o,int vb,bf16x8 pa0,bf16x8 pa1,bf16x8 pa2,bf16x8 pa3){
  #pragma unroll
  for(int d0=0;d0<2;++d0){s16x4 lo[4],hi[4];
    #pragma unroll
    for(int ks=0;ks<4;++ks){
      asm volatile("ds_read_b64_tr_b16 %0,%1 offset:%c2":"=&v"(lo[ks]):"v"(vb),"i"(d0*4096+ks*1024):"memory");
      asm volatile("ds_read_b64_tr_b16 %0,%1 offset:%c2":"=&v"(hi[ks]):"v"(vb),"i"(d0*4096+ks*1024+512):"memory");}
    asm volatile("s_waitcnt lgkmcnt(0)":::"memory");SBAR();
    #define PK(k) (bf16x8){lo[k][0],lo[k][1],lo[k][2],lo[k][3],hi[k][0],hi[k][1],hi[k][2],hi[k][3]}
    o[d0]=__builtin_amdgcn_mfma_f32_32x32x16_bf16(pa0,PK(0),o[d0],0,0,0);
    o[d0]=__builtin_amdgcn_mfma_f32_32x32x16_bf16(pa1,PK(1),o[d0],0,0,0);
    o[d0]=__builtin_amdgcn_mfma_f32_32x32x16_bf16(pa2,PK(2),o[d0],0,0,0);
    o[d0]=__builtin_amdgcn_mfma_f32_32x32x16_bf16(pa3,PK(3),o[d0],0,0,0);
    #undef PK
  }
}

#ifndef ATTN_STORE16
#define ATTN_STORE16(p,v) (*(u32x4*)(p)=(v))
#endif
template<int THRL> __device__ __forceinline__ void attn_unit(int b,int g,int qb,const bf16*P,bf16*O,char*shm,int wid,int lane){
  constexpr int DM=PROJW;
  const int r32=lane&31,hi=lane>>5;
  const bool meta=(qb==64);
  const int head=4*g+(wid>>1);
  const long qrow0=meta?(long)(ROWS_REAL+b*NMETA):(long)b*SEQ+qb*64+(wid&1)*32;
  const long rowbase=(long)b*SEQ; const long metaoff=((long)(ROWS_REAL+b*NMETA)-rowbase)*DM;
  const bf16*Qw=P+qrow0*DM+C_AQ+head*64;
  const bf16*Kh=P+rowbase*DM+C_AK+g*64,*Vh=P+rowbase*DM+C_AV+g*64;
  const unsigned lds0=(unsigned)(uintptr_t)shm;
  float*wsf=(float*)(shm+LDS_WS)+wid*64;
  const unsigned ksrc=(unsigned)(lane*DM+wid*8)*2u;
  const unsigned vsrc=(unsigned)((16*(wid&3)+(lane>>2))*DM+(wid>>2)*32+(lane&3)*8)*2u;
  const unsigned kdst=lds0+LDS_K+wid*1024, vdst=lds0+LDS_V+wid*1024;
  #define TOFF(t) (((t)<NT-1)?(long)(t)*KVBLK*DM:metaoff)
  #define DMA_K(t,slot) glds16(Kh+TOFF(t),ksrc,(unsigned)__builtin_amdgcn_readfirstlane(kdst+(slot)))
  #define DMA_V(t,slot) glds16(Vh+TOFF(t),vsrc,(unsigned)__builtin_amdgcn_readfirstlane(vdst+(slot)))
  const int vb0=(int)(lds0+LDS_V)+((lane>>4)&1)*32+(lane&3)*8+(4*hi+((lane&15)>>2))*64;
  const char*Kbase=shm+LDS_K; bf16x8 kf[8];
  const lds_cptr shm3=(lds_cptr)shm; const lds_cptr kp0=shm3+LDS_K+hi*1024+r32*16; const lds_cptr vp0=shm3+LDS_V+((lane>>4)&1)*32+(lane&3)*8+(4*hi+((lane&15)>>2))*64;
  DMA_K(0,0);DMA_V(0,0);DMA_K(1,SLOTB);
  bf16x8 qr[4];
  #pragma unroll
  for(int d0=0;d0<4;++d0)qr[d0]=*reinterpret_cast<const bf16x8*>(&Qw[(long)(meta?(r32&15):r32)*DM+d0*16+hi*8]);
  float mhat=0.f,l_reg=0.f;f32x16 o[2];f32x16 negm; { const float zz=(float)(qb>>30);
    _Pragma("unroll") for(int r=0;r<16;++r){o[0][r]=zz;o[1][r]=zz;negm[r]=zz;} } asm volatile("":"+v"(negm));
  #define CMASK(P0,P1,t) do{}while(0)
  bool resc=false;
  #define START(P0,P1) do{ const float rm=rowmax(P0,P1); resc=false; \
    { const float dl=rm; mhat=fadd_s(mhat,dl); \
      _Pragma("unroll") for(int r=0;r<16;++r){P0[r]=fsub_s(P0[r],dl);P1[r]=fsub_s(P1[r],dl);} \
      _Pragma("unroll") for(int r=0;r<16;++r)negm[r]=-mhat; asm volatile("":"+v"(negm)); } \
    _Pragma("unroll") for(int r=0;r<16;++r)P0[r]=__builtin_amdgcn_exp2f(P0[r]); }while(0)
  #define RESC() do{ if(resc){ asm volatile("s_waitcnt lgkmcnt(0)":::"memory"); \
      _Pragma("unroll") for(int d_=0;d_<2;++d_) _Pragma("unroll") for(int r=0;r<16;++r)o[d_][r]*=wsf[crow(r,hi)]; } }while(0)
  f32x16 pA0,pA1,pB0,pB1;
  int sl_prev=0,sl_cur=0,sl_next=SLOTB;
  #define ROT() do{sl_prev=sl_cur;sl_cur=sl_next;sl_next=(sl_next==(NSLOT-1)*SLOTB)?0:sl_next+SLOTB;}while(0)
  DMA_K(2,2*SLOTB);
  WAIT_BAR(3);
  qkt(pA0,pA1,Kbase,qr,negm,r32,hi);asm volatile("s_nop 15\n\ts_nop 7":"+v"(pA0),"+v"(pA1));CMASK(pA0,pA1,0);
  START(pA0,pA1);
  _Pragma("unroll") for(int r=0;r<16;++r)pA1[r]=__builtin_amdgcn_exp2f(pA1[r]);
  WAIT_BAR(0);
  DMA_K(3,0);DMA_V(1,SLOTB);
  ROT();
  kload8(kf,kp0+sl_cur);
  WAIT_BAR(2);
  s16x4 vlo[8],vhi[8]; u32x4 pw0,pw1,pw2,pw3;
  #define PKW(P,B) cvtpk_s(P[B],P[B+1])
  #define PAF(k) __builtin_bit_cast(bf16x8,pw##k)
  #define VFR(i) (bf16x8){vlo[i][0],vlo[i][1],vlo[i][2],vlo[i][3],vhi[i][0],vhi[i][1],vhi[i][2],vhi[i][3]}
  #define PIN(x) asm volatile("":"+v"(x))
  #define MX3(a,b,c) __builtin_fmaxf(__builtin_fmaxf((a),(b)),(c))
  #define GAPA(MF,A0,A1,A2,A3,W0,W1,PW) do{ MF; sacc+=A0; sacc+=A1; sacc+=A2; sacc+=A3; PIN(sacc); W0; W1; PIN(PW); SBAR(); }while(0)
  #define EX(v) __builtin_amdgcn_exp2f(v)
  #define GAPB(MF,X,B) do{ MF; X[B]=EX(X[B]); X[B+1]=EX(X[B+1]); X[B+2]=EX(X[B+2]); X[B+3]=EX(X[B+3]); PIN(X); SBAR(); }while(0)
  #define VRD(i) do{ vlo[i]=vtr(vp_+(((i)>>2)*4096+((i)&3)*1024)); vhi[i]=vtr(vp_+(((i)>>2)*4096+((i)&3)*1024+512)); }while(0)
  #define KRD(G,j) do{ if(G){ kload2(kf,kp0+sl_next,j); SBAR(); } }while(0)
  #define STEP(C0,C1,P0,P1,t,GK,GV,GL) do{ SBAR(); \
    const lds_cptr vp_=vp0+sl_prev; \
    VRD(0); SBAR(); float sacc=(P0[0]+P0[1]); \
    GAPA(C0=__builtin_amdgcn_mfma_f32_32x32x16_bf16(kf[0],qr[0],negm,0,0,0), P0[2],P0[3],P0[4],P0[5],     pw0[0]=PKW(P0,0), pw0[1]=PKW(P0,2), pw0); \
    VRD(4); SBAR(); GAPA(C1=__builtin_amdgcn_mfma_f32_32x32x16_bf16(kf[1],qr[0],negm,0,0,0), P0[6],P0[7],P0[8],P0[9],     pw0[2]=PKW(P0,4), pw0[3]=PKW(P0,6), pw0); \
    VRD(1); SBAR(); GAPA(C0=__builtin_amdgcn_mfma_f32_32x32x16_bf16(kf[2],qr[1],C0,0,0,0),   P0[10],P0[11],P0[12],P0[13], pw1[0]=PKW(P0,8), pw1[1]=PKW(P0,10), pw1); \
    VRD(5); SBAR(); GAPA(C1=__builtin_amdgcn_mfma_f32_32x32x16_bf16(kf[3],qr[1],C1,0,0,0),   P0[14],P0[15],P1[0],P1[1],   pw1[2]=PKW(P0,12),pw1[3]=PKW(P0,14), pw1); \
    VRD(2); SBAR(); GAPA(C0=__builtin_amdgcn_mfma_f32_32x32x16_bf16(kf[4],qr[2],C0,0,0,0),   P1[2],P1[3],P1[4],P1[5],     pw2[0]=PKW(P1,0), pw2[1]=PKW(P1,2), pw2); \
    VRD(6); SBAR(); GAPA(C1=__builtin_amdgcn_mfma_f32_32x32x16_bf16(kf[5],qr[2],C1,0,0,0),   P1[6],P1[7],P1[8],P1[9],     pw2[2]=PKW(P1,4), pw2[3]=PKW(P1,6), pw2); \
    VRD(3); SBAR(); GAPA(C0=__builtin_amdgcn_mfma_f32_32x32x16_bf16(kf[6],qr[3],C0,0,0,0),   P1[10],P1[11],P1[12],P1[13], pw3[0]=PKW(P1,8), pw3[1]=PKW(P1,10), pw3); \
    VRD(7); SBAR(); GAPA(C1=__builtin_amdgcn_mfma_f32_32x32x16_bf16(kf[7],qr[3],C1,0,0,0),   P1[14],P1[15],0.f,0.f,       pw3[2]=PKW(P1,12),pw3[3]=PKW(P1,14), pw3); \
    l_reg+=sacc; \
    if(GK){DMA_K((t)+3,sl_cur);} if(GV){DMA_V((t)+1,sl_next);} \
    CMASK(C0,C1,t); \
    { float a=MX3(C0[0],C0[1],C1[0]),b=MX3(C0[2],C0[3],C1[1]); a=MX3(a,C1[2],C1[3]); \
      _Pragma("unroll") for(int r=4;r<16;r+=4){a=MX3(a,C0[r],C0[r+1]);b=MX3(b,C0[r+2],C0[r+3]);a=MX3(a,C1[r],C1[r+1]);b=MX3(b,C1[r+2],C1[r+3]);} \
      float rm=__builtin_fmaxf(a,b); { auto rr=__builtin_amdgcn_permlane32_swap(__float_as_uint(rm),__float_as_uint(rm),false,false); rm=__builtin_fmaxf(__uint_as_float(rr[0]),__uint_as_float(rr[1])); } \
      resc=false; \
      if(__builtin_expect(__any(rm>(float)THRL),0)){ const float dl=__builtin_fmaxf(rm,0.f); mhat+=dl; \
        _Pragma("unroll") for(int r=0;r<16;++r){C0[r]-=dl;C1[r]-=dl;} \
        _Pragma("unroll") for(int r=0;r<16;++r)negm[r]=-mhat; asm volatile("":"+v"(negm)); \
        const float f=__builtin_amdgcn_exp2f(-dl); l_reg*=f; if(hi==0)wsf[r32]=f; resc=true; } } \
    SBAR(); \
    GAPB(o[0]=__builtin_amdgcn_mfma_f32_32x32x16_bf16(PAF(0),VFR(0),o[0],0,0,0), C0,0); \
    GAPB(o[1]=__builtin_amdgcn_mfma_f32_32x32x16_bf16(PAF(0),VFR(4),o[1],0,0,0), C0,4); \
    KRD(GL,0); GAPB(o[0]=__builtin_amdgcn_mfma_f32_32x32x16_bf16(PAF(1),VFR(1),o[0],0,0,0), C0,8); \
    KRD(GL,1); GAPB(o[1]=__builtin_amdgcn_mfma_f32_32x32x16_bf16(PAF(1),VFR(5),o[1],0,0,0), C0,12); \
    KRD(GL,2); GAPB(o[0]=__builtin_amdgcn_mfma_f32_32x32x16_bf16(PAF(2),VFR(2),o[0],0,0,0), C1,0); \
    KRD(GL,3); GAPB(o[1]=__builtin_amdgcn_mfma_f32_32x32x16_bf16(PAF(2),VFR(6),o[1],0,0,0), C1,4); \
    GAPB(o[0]=__builtin_amdgcn_mfma_f32_32x32x16_bf16(PAF(3),VFR(3),o[0],0,0,0), C1,8); \
    GAPB(o[1]=__builtin_amdgcn_mfma_f32_32x32x16_bf16(PAF(3),VFR(7),o[1],0,0,0), C1,12); \
    }while(0)
  int t=1;
  for(;t+5<NT;t+=2){
    STEP(pB0,pB1,pA0,pA1,t,true,true,true);     WAIT_BAR(2); RESC(); ROT();
    STEP(pA0,pA1,pB0,pB1,t+1,true,true,true);   WAIT_BAR(2); RESC(); ROT();
  }
  #undef CMASK
  #define CMASK(P0,P1,t) do{ if((t)==NT-1)tmask(P0,P1); }while(0)
  #define ENDW(tt) do{ if((tt)+3<NT){WAIT_BAR(2);} else if((tt)+2<NT){WAIT_BAR(1);} else {WAIT_BAR(0);} }while(0)
  for(;t+2<NT;t+=2){
    STEP(pB0,pB1,pA0,pA1,t,(t+3<NT),(t+1<NT),(t+1<NT));       ENDW(t);   RESC(); ROT();
    STEP(pA0,pA1,pB0,pB1,t+1,(t+4<NT),(t+2<NT),(t+2<NT));     ENDW(t+1); RESC(); ROT();
  }
  STEP(pB0,pB1,pA0,pA1,NT-2,false,true,true); ENDW(NT-2); RESC(); ROT();
  STEP(pA0,pA1,pB0,pB1,NT-1,false,false,false); RESC();
  { float sacc=pA0[0]+pA0[1]; _Pragma("unroll") for(int r=2;r<16;++r)sacc+=pA0[r]; _Pragma("unroll") for(int r=0;r<16;++r)sacc+=pA1[r]; l_reg+=sacc;
    pw0=(u32x4){PKW(pA0,0),PKW(pA0,2),PKW(pA0,4),PKW(pA0,6)};pw1=(u32x4){PKW(pA0,8),PKW(pA0,10),PKW(pA0,12),PKW(pA0,14)};pw2=(u32x4){PKW(pA1,0),PKW(pA1,2),PKW(pA1,4),PKW(pA1,6)};pw3=(u32x4){PKW(pA1,8),PKW(pA1,10),PKW(pA1,12),PKW(pA1,14)};
    SBAR(); pv(o,vb0+sl_cur,PAF(0),PAF(1),PAF(2),PAF(3)); }
  #undef PKW
  #undef PAF
  #undef VFR
  #undef PIN
  #undef MX3
  #undef GAPA
  #undef GAPB
  #undef EX
  #undef VRD
  #undef KRD
  #undef STEP
  #undef ENDW
  {auto rr=__builtin_amdgcn_permlane32_swap(__float_as_uint(l_reg),__float_as_uint(l_reg),false,false);l_reg=__uint_as_float(rr[0])+__uint_as_float(rr[1]);}
  if(hi==0)wsf[32+r32]=l_reg;asm volatile("s_waitcnt lgkmcnt(0)":::"memory");
  float rli[16];
  #pragma unroll
  for(int r=0;r<16;++r)rli[r]=__builtin_amdgcn_rcpf(wsf[32+crow(r,hi)]);
  bf16*Ow=O+qrow0*512+head*64;
  { bf16*stg=(bf16*)(shm+LDS_OST)+wid*2048;
    #pragma unroll
    for(int r=0;r<16;++r){const int orow=crow(r,hi);
      #pragma unroll
      for(int d0=0;d0<2;++d0)stg[orow*64+d0*32+r32]=f2bf(o[d0][r]*rli[r]);}
    asm volatile("s_waitcnt lgkmcnt(0)":::"memory");
    #pragma unroll
    for(int i=0;i<4;++i){const int row=i*8+(lane>>3),ch=lane&7; const u32x4 v=*(const u32x4*)(stg+row*64+ch*8); if(!meta||((wid&1)==0&&row<NMETA)) ATTN_STORE16(Ow+(long)row*512+ch*8,v);} }
  asm volatile("s_waitcnt lgkmcnt(0)\n\ts_barrier":::"memory");
  #undef DMA_K
  #undef TOFF
  #undef DMA_V
  #undef CMASK
  #undef START
  #undef RESC
  #undef ROT
}
#undef SBAR
#undef WAIT_BAR
}

__device__ __forceinline__ void chunk_rows(int b, int ch, int& base, int& n) { if (ch == 0) { base = ROWS_REAL + b * NMETA; n = NMETA; } else { base = b * SEQ + (ch - 1) * 64; n = 64; } }

typedef float f32x16 __attribute__((ext_vector_type(16)));
__device__ __forceinline__ int crow16(int r, int hi) { return (r & 3) + 8 * (r >> 2) + 4 * hi; }
__device__ void hgrn_chunk_item(const Ctx& c, int layer, int b, int h, int dir) {
    constexpr int PQ = 136, PJ = 72;
    LAS char* sm = c.smem;
    LAS bf16_t* QT = (LAS bf16_t*)(sm);
    LAS bf16_t* QH = (LAS bf16_t*)(sm + 17408);
    LAS bf16_t* R0 = (LAS bf16_t*)(sm + 26112);
    LAS bf16_t* R1 = (LAS bf16_t*)(sm + 34816);
    LAS bf16_t* OT = R1;
    LAS bf16_t* KT = (LAS bf16_t*)(sm + 52224);
    LAS bf16_t* VT = (LAS bf16_t*)(sm + 70656);
    LAS bf16_t* PT = (LAS bf16_t*)(sm + 89088);
    LAS bf16_t* SL = (LAS bf16_t*)(sm + 98304);
    LAS float* DV = (LAS float*)(sm + 133120);
    LAS float* CX = (LAS float*)(sm + 133632);
    const int tid = c.tid, lane = c.lane, wid = c.wid, r32 = lane & 31, hi = lane >> 5;
    const int d = tid & 127, rq = tid >> 7;
    const float lb = c.LB()[(dir * DEPTH + layer) * 512 + h * 128 + d];
    bf16_t* OUT = dir ? c.OB() : c.OF();
    const bf16_t* PR = c.PROJ();
    const int fcol = dir ? C_HB : C_HF;
    __syncthreads();
    { const unsigned zu = (unsigned)(c.bid >> 30); const u32x4 z4 = (u32x4){zu, zu, zu, zu};
      for (int i = tid; i < 34816 / 16; i += 512) ((LAS u32x4*)SL)[i] = z4;
      for (int i = tid; i < 9216 / 16; i += 512) ((LAS u32x4*)PT)[i] = z4; }
    f32x16 Sacc[2];
    const float zz = (float)(c.bid >> 30);
#pragma unroll
    for (int r = 0; r < 16; ++r) { Sacc[0][r] = zz; Sacc[1][r] = zz; }
    unsigned short xq[16], xf[16], xv[16];
    auto load_chunk = [&](int ci) {
        const int ch = dir ? 64 - ci : ci; int base, n; chunk_rows(b, ch, base, n);
#pragma unroll
        for (int m = 0; m < 16; ++m) { const int i = 16 * rq + m; const int r = dir ? n - 1 - i : i;
            if (i < n) { const bf16_t* p = PR + (size_t)(base + r) * PROJW + h * 128 + d; xq[m] = p[C_HQ]; xf[m] = p[fcol]; xv[m] = p[C_HI]; }
            else { xq[m] = 0; xf[m] = 0x7f7f; xv[m] = 0; } }
    };
    load_chunk(0);
    for (int ci = 0; ci < 65; ++ci) {
        const int ch = dir ? 64 - ci : ci; int base, n; chunk_rows(b, ch, base, n);
        float cl[16], kk[16], qq[16];
        { float run = 0.f;
#pragma unroll
          for (int m = 0; m < 16; ++m) { const float x = bf2f(xf[m]), q = bf2f(xq[m]);
              const float e = __expf(-x), ec = fminf(e, 1.0686474581524463e13f);
              float f = (1.0f + lb * ec) * __builtin_amdgcn_rcpf(1.0f + e); f = fminf(f, 1.0f);
              run += fmaxf(__logf(f), -200.0f); cl[m] = run; kk[m] = 1.0f - f; qq[m] = q * __builtin_amdgcn_rcpf(1.0f + __expf(-q)); }
          CX[rq * 128 + d] = run; }
        __syncthreads();
        { const float c0 = CX[d], c1 = CX[128 + d], c2 = CX[256 + d], c3 = CX[384 + d];
          const float tot0 = c0 + c1, tot1 = c2 + c3;
          const float off = (rq == 1) ? c0 : (rq == 3 ? c2 : 0.f);
          const int I = rq >> 1;
          if (rq == 0) DV[d] = __expf(tot0 + tot1);
          unsigned kp[8], vp[8];
#pragma unroll
          for (int m = 0; m < 16; ++m) { const int i = 16 * rq + m; const float cb = off + cl[m];
              const float E = __expf(fmaxf(cb, -80.f)), rE = __builtin_amdgcn_rcpf(E);
              QT[i * PQ + d] = f2bf(qq[m] * E);
              float khat;
              if (I == 0) { R0[i * PQ + d] = f2bf(kk[m] * rE); R1[i * PQ + d] = f2bf(kk[m] * __expf(tot0 - cb)); khat = kk[m] * __expf(tot0 + tot1 - cb); }
              else { R1[i * PQ + d] = f2bf(kk[m] * rE); QH[(i - 32) * PQ + d] = f2bf(qq[m] * __expf(tot0 + cb)); khat = kk[m] * __expf(tot1 - cb); }
              if (m & 1) { kp[m >> 1] |= ((unsigned)f2bf(khat)) << 16; vp[m >> 1] |= ((unsigned)xv[m]) << 16; } else { kp[m >> 1] = f2bf(khat); vp[m >> 1] = xv[m]; } }
          *(LAS u32x4*)(KT + d * PJ + 16 * rq) = (u32x4){kp[0], kp[1], kp[2], kp[3]}; *(LAS u32x4*)(KT + d * PJ + 16 * rq + 8) = (u32x4){kp[4], kp[5], kp[6], kp[7]};
          *(LAS u32x4*)(VT + d * PJ + 16 * rq) = (u32x4){vp[0], vp[1], vp[2], vp[3]}; *(LAS u32x4*)(VT + d * PJ + 16 * rq + 8) = (u32x4){vp[4], vp[5], vp[6], vp[7]}; }
        if (ci + 1 < 65) load_chunk(ci + 1);
        __syncthreads();
        if (wid < 3) {
            const LAS bf16_t* Rb = (wid == 0) ? R0 : (wid == 1 ? R1 : R1 + 32 * PQ);
            const int i0 = wid == 0 ? 0 : 32, j0 = wid == 2 ? 32 : 0;
            f32x16 acc;
#pragma unroll
            for (int r = 0; r < 16; ++r) acc[r] = zz;
#pragma unroll
            for (int d0 = 0; d0 < 8; ++d0) { const bf16x8 a = *(const LAS bf16x8*)(Rb + r32 * PQ + 16 * d0 + 8 * hi); const bf16x8 bq = *(const LAS bf16x8*)(QT + (i0 + r32) * PQ + 16 * d0 + 8 * hi);
                acc = __builtin_amdgcn_mfma_f32_32x32x16_bf16(a, bq, acc, 0, 0, 0); }
#pragma unroll
            for (int q4 = 0; q4 < 4; ++q4) { float v[4];
#pragma unroll
                for (int t = 0; t < 4; ++t) { const int jrel = 8 * q4 + 4 * hi + t; v[t] = (wid == 1 || jrel <= r32) ? acc[4 * q4 + t] : 0.f; }
                u32x2 w; w.x = cvt_pk_bf16(v[0], v[1]); w.y = cvt_pk_bf16(v[2], v[3]);
                *(LAS u32x2*)(PT + (i0 + r32) * PJ + j0 + 8 * q4 + 4 * hi) = w; }
        }
        { const int dq = wid & 3, eh = wid >> 2;
#pragma unroll
          for (int q4 = 0; q4 < 4; ++q4) { const f32x4 dv = *(const LAS f32x4*)(DV + 32 * dq + 8 * q4 + 4 * hi);
#pragma unroll
              for (int t = 0; t < 4; ++t) { Sacc[0][4 * q4 + t] *= dv[t]; Sacc[1][4 * q4 + t] *= dv[t]; } }
#pragma unroll
          for (int js = 0; js < 4; ++js) { const bf16x8 a = *(const LAS bf16x8*)(KT + (32 * dq + r32) * PJ + 16 * js + 8 * hi);
#pragma unroll
              for (int eb = 0; eb < 2; ++eb) { const bf16x8 bv = *(const LAS bf16x8*)(VT + (64 * eh + 32 * eb + r32) * PJ + 16 * js + 8 * hi);
                  Sacc[eb] = __builtin_amdgcn_mfma_f32_32x32x16_bf16(a, bv, Sacc[eb], 0, 0, 0); } } }
        __syncthreads();
        { const int ih = wid & 1, eq = wid >> 1, i0 = 32 * ih, e0 = 32 * eq;
          f32x16 acc;
#pragma unroll
          for (int r = 0; r < 16; ++r) acc[r] = zz;
#pragma unroll
          for (int js = 0; js < 4; ++js) if (js < 2 || ih) { const bf16x8 a = *(const LAS bf16x8*)(PT + (i0 + r32) * PJ + 16 * js + 8 * hi); const bf16x8 bv = *(const LAS bf16x8*)(VT + (e0 + r32) * PJ + 16 * js + 8 * hi);
              acc = __builtin_amdgcn_mfma_f32_32x32x16_bf16(a, bv, acc, 0, 0, 0); }
          const LAS bf16_t* qh = ih ? QH : QT;
#pragma unroll
          for (int ds = 0; ds < 8; ++ds) { const bf16x8 a = *(const LAS bf16x8*)(qh + r32 * PQ + 16 * ds + 8 * hi); const bf16x8 bs = *(const LAS bf16x8*)(SL + (e0 + r32) * PQ + 16 * ds + 8 * hi);
              acc = __builtin_amdgcn_mfma_f32_32x32x16_bf16(a, bs, acc, 0, 0, 0); }
#pragma unroll
          for (int r = 0; r < 16; ++r) OT[(i0 + crow16(r, hi)) * PQ + e0 + r32] = f2bf(acc[r]); }
        __syncthreads();
        { const int dq = wid & 3, eh = wid >> 2;
#pragma unroll
          for (int eb = 0; eb < 2; ++eb)
#pragma unroll
              for (int q4 = 0; q4 < 4; ++q4) { u32x2 w; w.x = cvt_pk_bf16(Sacc[eb][4 * q4], Sacc[eb][4 * q4 + 1]); w.y = cvt_pk_bf16(Sacc[eb][4 * q4 + 2], Sacc[eb][4 * q4 + 3]);
                  *(LAS u32x2*)(SL + (64 * eh + 32 * eb + r32) * PQ + 32 * dq + 8 * q4 + 4 * hi) = w; } }
#pragma unroll
        for (int k = 0; k < 2; ++k) { const int idx = tid + 512 * k, i = idx >> 4, c16 = idx & 15; const int r = dir ? n - 1 - i : i;
            if (i < n) *(u32x4*)(OUT + (size_t)(base + r) * 512 + h * 128 + c16 * 8) = *(const LAS u32x4*)(OT + i * PQ + c16 * 8); }
    }
    __syncthreads();
}

__device__ __forceinline__ bf16x8 pack8(float a0, float a1, float a2, float a3, float a4, float a5, float a6, float a7) {
    u32x4 w; w.x = cvt_pk_bf16(a0, a1); w.y = cvt_pk_bf16(a2, a3); w.z = cvt_pk_bf16(a4, a5); w.w = cvt_pk_bf16(a6, a7); return __builtin_bit_cast(bf16x8, w);
}
__device__ __forceinline__ bf16x8 ld8perm(const LAS bf16_t* p) {
    const u32x2 a = *(const LAS u32x2*)p, b = *(const LAS u32x2*)(p + 8); u32x4 w; w.x = a.x; w.y = a.y; w.z = b.x; w.w = b.y; return __builtin_bit_cast(bf16x8, w);
}
__device__ void ssd_chunk_item(const Ctx& c, int layer, int b, int g, int dir) {
    constexpr int PJ = 72, PO = 264;
    LAS char* sm = c.smem;
    LAS bf16_t* TB = (LAS bf16_t*)(sm);
    LAS bf16_t* TC = (LAS bf16_t*)(sm + 9216);
    LAS bf16_t* TX = (LAS bf16_t*)(sm + 27648);
    LAS bf16_t* OT = (LAS bf16_t*)(sm + 64512);
    LAS float* CUM = (LAS float*)(sm + 98304);
    LAS float* DTV = CUM + 256;
    LAS float* WV = CUM + 512;
    LAS float* ECV = CUM + 768;
    LAS float* DVv = CUM + 1024;
    const int tid = c.tid, lane = c.lane, wid = c.wid, r32 = lane & 31, hi = lane >> 5;
    const int hh = wid >> 1, ph = wid & 1;
    bf16_t* OUT = dir ? c.YB() : c.YF();
    const bf16_t* XB = c.XBC();
    const float* DTP = c.DT();
    const int xcp = tid & 127, xq4 = tid >> 7;
    const int prow = tid >> 3, ppc = tid & 7;
    const int sh = (tid >> 6) & 3, si = tid & 63;
    const float dtb = c.a->in[I_DTB][(layer * 2 + dir) * 8 + 4 * g + sh];
    const float Ah = -__expf(c.a->in[I_ALOG][(layer * 2 + dir) * 8 + 4 * g + sh]);
    __syncthreads();
    f32x16 Sacc[2];
    const float zz = (float)(c.bid >> 30);
#pragma unroll
    for (int r = 0; r < 16; ++r) { Sacc[0][r] = zz; Sacc[1][r] = zz; }
    unsigned xr[16]; u32x4 pb, pc; float dtr;
#define SSD_LOAD(ci_) do { const int ch_ = dir ? 64 - (ci_) : (ci_); int base_, n_; chunk_rows(b, ch_, base_, n_); \
        _Pragma("unroll") for (int m = 0; m < 16; ++m) { const int i = 16 * xq4 + m, r = dir ? n_ - 1 - i : i; xr[m] = (i < n_) ? *(const unsigned*)(XB + (size_t)(base_ + r) * 768 + 256 * g + 2 * xcp) : 0u; } \
        { const int i = prow, r = dir ? n_ - 1 - i : i; const unsigned zu_ = (unsigned)(c.bid >> 30); const u32x4 z = (u32x4){zu_, zu_, zu_, zu_}; \
          pb = (i < n_) ? *(const u32x4*)(XB + (size_t)(base_ + r) * 768 + 512 + 64 * g + 8 * ppc) : z; pc = (i < n_) ? *(const u32x4*)(XB + (size_t)(base_ + r) * 768 + 640 + 64 * g + 8 * ppc) : z; } \
        { const int i = si, r = dir ? n_ - 1 - i : i; dtr = (tid < 256 && i < n_) ? DTP[(size_t)(base_ + r) * 16 + dir * 8 + 4 * g + sh] : -1e30f; } } while (0)
    SSD_LOAD(0);
    for (int ci = 0; ci < 65; ++ci) {
        const int ch = dir ? 64 - ci : ci; int base, n; chunk_rows(b, ch, base, n);
        { unsigned lo[8], hi2[8];
#pragma unroll
          for (int q = 0; q < 8; ++q) { lo[q] = (xr[2 * q] & 0xffffu) | (xr[2 * q + 1] << 16); hi2[q] = (xr[2 * q] >> 16) | (xr[2 * q + 1] & 0xffff0000u); }
          LAS bf16_t* x0 = TX + (2 * xcp) * PJ + 16 * xq4;
          *(LAS u32x4*)(x0) = (u32x4){lo[0], lo[1], lo[2], lo[3]}; *(LAS u32x4*)(x0 + 8) = (u32x4){lo[4], lo[5], lo[6], lo[7]};
          *(LAS u32x4*)(x0 + PJ) = (u32x4){hi2[0], hi2[1], hi2[2], hi2[3]}; *(LAS u32x4*)(x0 + PJ + 8) = (u32x4){hi2[4], hi2[5], hi2[6], hi2[7]}; }
        *(LAS u32x4*)(TB + prow * PJ + 8 * ppc) = pb; *(LAS u32x4*)(TC + prow * PJ + 8 * ppc) = pc;
        if (tid < 256) {
            const float xd = dtr + dtb;
            const float dt = (dtr < -1e29f) ? 0.f : (xd > 20.f ? xd : log1pf(__expf(xd)));
            float cum = dt * Ah;
#pragma unroll
            for (int o = 1; o < 64; o <<= 1) { const float t = __shfl_up(cum, o); if (lane >= o) cum += t; }
            const float tot = __shfl(cum, 63);
            CUM[sh * 64 + si] = cum; DTV[sh * 64 + si] = dt; WV[sh * 64 + si] = dt * __expf(tot - cum); ECV[sh * 64 + si] = __expf(cum);
            if (si == 0) DVv[sh] = __expf(tot);
        }
        if (ci + 1 < 65) SSD_LOAD(ci + 1);
        __syncthreads();
        {
            const LAS float* cumh = CUM + hh * 64; const LAS float* dth = DTV + hh * 64; const LAS float* wh = WV + hh * 64; const LAS float* ech = ECV + hh * 64;
            bf16x8 sf[2][2];
#pragma unroll
            for (int nb = 0; nb < 2; ++nb)
#pragma unroll
                for (int s2 = 0; s2 < 2; ++s2) sf[nb][s2] = pack8(Sacc[nb][8 * s2], Sacc[nb][8 * s2 + 1], Sacc[nb][8 * s2 + 2], Sacc[nb][8 * s2 + 3], Sacc[nb][8 * s2 + 4], Sacc[nb][8 * s2 + 5], Sacc[nb][8 * s2 + 6], Sacc[nb][8 * s2 + 7]);
            const LAS bf16_t* xT = TX + (hh * 64 + 32 * ph + r32) * PJ;
#pragma unroll
            for (int ib = 0; ib < 2; ++ib) {
                f32x16 acc;
#pragma unroll
                for (int r = 0; r < 16; ++r) acc[r] = zz;
#pragma unroll
                for (int nb = 0; nb < 2; ++nb)
#pragma unroll
                    for (int s2 = 0; s2 < 2; ++s2) { const bf16x8 a = ld8perm(TC + (32 * ib + r32) * PJ + 32 * nb + 16 * s2 + 4 * hi);
                        acc = __builtin_amdgcn_mfma_f32_32x32x16_bf16(a, sf[nb][s2], acc, 0, 0, 0); }
#pragma unroll
                for (int q4 = 0; q4 < 4; ++q4) { const f32x4 ec = *(const LAS f32x4*)(ech + 32 * ib + 8 * q4 + 4 * hi);
#pragma unroll
                    for (int t = 0; t < 4; ++t) acc[4 * q4 + t] *= ec[t]; }
                const float ci_ = cumh[32 * ib + r32];
#pragma unroll
                for (int jb = 0; jb <= ib; ++jb) {
                    f32x16 gacc;
#pragma unroll
                    for (int r = 0; r < 16; ++r) gacc[r] = zz;
#pragma unroll
                    for (int ns = 0; ns < 4; ++ns) { const bf16x8 a = *(const LAS bf16x8*)(TB + (32 * jb + r32) * PJ + 16 * ns + 8 * hi); const bf16x8 bq = *(const LAS bf16x8*)(TC + (32 * ib + r32) * PJ + 16 * ns + 8 * hi);
                        gacc = __builtin_amdgcn_mfma_f32_32x32x16_bf16(a, bq, gacc, 0, 0, 0); }
#pragma unroll
                    for (int q4 = 0; q4 < 4; ++q4) { const f32x4 cj = *(const LAS f32x4*)(cumh + 32 * jb + 8 * q4 + 4 * hi); const f32x4 dj = *(const LAS f32x4*)(dth + 32 * jb + 8 * q4 + 4 * hi);
#pragma unroll
                        for (int t = 0; t < 4; ++t) { const int jrel = 8 * q4 + 4 * hi + t; const bool keep = (jb < ib) || (jrel <= r32);
                            gacc[4 * q4 + t] = keep ? gacc[4 * q4 + t] * dj[t] * __expf(fminf(ci_ - cj[t], 0.f)) : 0.f; } }
#pragma unroll
                    for (int s2 = 0; s2 < 2; ++s2) { const bf16x8 pfr = pack8(gacc[8 * s2], gacc[8 * s2 + 1], gacc[8 * s2 + 2], gacc[8 * s2 + 3], gacc[8 * s2 + 4], gacc[8 * s2 + 5], gacc[8 * s2 + 6], gacc[8 * s2 + 7]);
                        const bf16x8 xb = ld8perm(xT + 32 * jb + 16 * s2 + 4 * hi);
                        acc = __builtin_amdgcn_mfma_f32_32x32x16_bf16(pfr, xb, acc, 0, 0, 0); }
                }
#pragma unroll
                for (int r = 0; r < 16; ++r) OT[(32 * ib + crow16(r, hi)) * PO + hh * 64 + 32 * ph + r32] = f2bf(acc[r]);
            }
            const float Dh = DVv[hh];
#pragma unroll
            for (int r = 0; r < 16; ++r) { Sacc[0][r] *= Dh; Sacc[1][r] *= Dh; }
#pragma unroll
            for (int js = 0; js < 4; ++js) { const u32x4 xw = *(const LAS u32x4*)(xT + 16 * js + 8 * hi); const f32x4 w0 = *(const LAS f32x4*)(wh + 16 * js + 8 * hi), w1 = *(const LAS f32x4*)(wh + 16 * js + 8 * hi + 4);
                const bf16x8 xb = pack8(bflo(xw.x) * w0[0], bfhi(xw.x) * w0[1], bflo(xw.y) * w0[2], bfhi(xw.y) * w0[3], bflo(xw.z) * w1[0], bfhi(xw.z) * w1[1], bflo(xw.w) * w1[2], bfhi(xw.w) * w1[3]);
#pragma unroll
                for (int nb = 0; nb < 2; ++nb) { const LAS bf16_t* bp = TB + (16 * js + 8 * hi) * PJ + 32 * nb + r32; bf16x8 a;
#pragma unroll
                    for (int t = 0; t < 8; ++t) a[t] = (short)bp[t * PJ];
                    Sacc[nb] = __builtin_amdgcn_mfma_f32_32x32x16_bf16(a, xb, Sacc[nb], 0, 0, 0); } }
        }
        __syncthreads();
#pragma unroll
        for (int k = 0; k < 4; ++k) { const int idx = tid + 512 * k, i = idx >> 5, c16 = idx & 31; const int r = dir ? n - 1 - i : i;
            if (i < n) *(u32x4*)(OUT + (size_t)(base + r) * 512 + 256 * g + c16 * 8) = *(const LAS u32x4*)(OT + i * PO + c16 * 8); }
    }
#undef SSD_LOAD
    __syncthreads();
}

__device__ void phase_mixers(const Ctx& c0, int layer) {
    constexpr int N_H = 64, N_S = 32, N_A = NB * 2 * 65;
#ifndef MIX_SITES
#define MIX_SITES 7
#endif
    if (MIX_SITES & 1) { const Ctx c = fresh(c0); for (int it = c.bid; it < N_H; it += c.G) hgrn_chunk_item(c, layer, it >> 3, (it >> 1) & 3, it & 1); }
    if (MIX_SITES & 2) { const Ctx c = fresh(c0); for (int it = (c.bid + c.G - N_H % c.G) % c.G; it < N_S; it += c.G) ssd_chunk_item(c, layer, it >> 2, (it >> 1) & 1, it & 1); }
    if (MIX_SITES & 4) { const Ctx c = fresh(c0); for (int u = (c.bid + c.G - (N_H + N_S) % c.G) % c.G; u < N_A; u += c.G) { const int b = u / 130, rem = u % 130; att::attn_unit<8>(b, rem / 65, rem % 65, c.PROJ(), c.ATT(), (char*)c.smem, c.wid, c.lane); } }
}

__device__ void phase_mix(const Ctx& c0, int layer) {
    const Ctx c = fresh(c0);
    const int lane = c.lane;
    const float* anw = c.a->in[I_ANW] + layer * 512; const float* hnw = c.a->in[I_HNW] + layer * 512; const float* snw = c.a->in[I_SNW] + layer * 512;
    const float dsk = c.a->in[I_DSKIP][layer * 8 + (lane >> 3)];
    auto ld8 = [](const bf16_t* p, float (&x)[8]) { const u32x4 w = *(const u32x4*)p; x[0] = bflo(w.x); x[1] = bfhi(w.x); x[2] = bflo(w.y); x[3] = bfhi(w.y); x[4] = bflo(w.z); x[5] = bfhi(w.z); x[6] = bflo(w.w); x[7] = bfhi(w.w); };
    auto st8 = [](bf16_t* p, const float (&x)[8]) { u32x4 w; w.x = cvt_pk_bf16(x[0], x[1]); w.y = cvt_pk_bf16(x[2], x[3]); w.z = cvt_pk_bf16(x[4], x[5]); w.w = cvt_pk_bf16(x[6], x[7]); *(u32x4*)p = w; };
    for (int row = c.bid * 8 + c.wid; row < ROWS; row += c.G * 8) {
        const bf16_t* prow = c.PROJ() + (size_t)row * PROJW;
        bf16_t* mrow = c.MIX() + (size_t)row * MIXW;
        float x[8], y[8], z[8];
        { ld8(c.ATT() + (size_t)row * 512 + 8 * lane, x); float ss = 0.f;
#pragma unroll
          for (int j = 0; j < 8; ++j) ss += x[j] * x[j];
          ss = wave_sum(ss); const float rstd = rsqrtf(ss * (1.0f / 512.0f) + EPS);
#pragma unroll
          for (int j = 0; j < 8; ++j) x[j] = x[j] * rstd * anw[8 * lane + j];
          st8(mrow + 8 * lane, x); }
        { ld8(c.OF() + (size_t)row * 512 + 8 * lane, x); ld8(c.OB() + (size_t)row * 512 + 8 * lane, y); ld8(prow + C_HG + 8 * lane, z); float ss = 0.f;
#pragma unroll
          for (int j = 0; j < 8; ++j) { x[j] += y[j]; ss += x[j] * x[j]; }
          ss += __shfl_xor(ss, 1); ss += __shfl_xor(ss, 2); ss += __shfl_xor(ss, 4); ss += __shfl_xor(ss, 8);
          const float rstd = rsqrtf(ss * (1.0f / 128.0f) + EPS);
#pragma unroll
          for (int j = 0; j < 8; ++j) x[j] = x[j] * rstd * hnw[8 * lane + j] * silu_f(z[j]);
          st8(mrow + 512 + 8 * lane, x); }
        { ld8(c.YF() + (size_t)row * 512 + 8 * lane, x); ld8(c.YB() + (size_t)row * 512 + 8 * lane, y); ld8(prow + C_SZ + 8 * lane, z); float xs[8]; ld8(c.XBC() + (size_t)row * 768 + 8 * lane, xs); float ss = 0.f;
#pragma unroll
          for (int j = 0; j < 8; ++j) { x[j] = (x[j] + y[j] + dsk * xs[j]) * silu_f(z[j]); ss += x[j] * x[j]; }
          ss = wave_sum(ss); const float rstd = rsqrtf(ss * (1.0f / 512.0f) + EPS);
#pragma unroll
          for (int j = 0; j < 8; ++j) x[j] = x[j] * rstd * snw[8 * lane + j];
          st8(mrow + 1024 + 8 * lane, x); }
    }
}

__device__ void phase_topk(const Ctx& c0) {
    const Ctx c = fresh(c0);
    LAS float* V = (LAS float*)c.smem;
    const int tid = c.tid;
    for (int it = c.bid; it < NB * NEXP; it += c.G) {
        const int b = it >> 4, e = it & 15;
        __syncthreads();
        for (int i = tid; i < LTOK; i += 512) V[i] = c.AFFT()[(size_t)it * LTOK + i];
        __syncthreads();
        float a[9]; int cnt[9];
#pragma unroll
        for (int k = 0; k < 9; ++k) { const int i = tid + 512 * k; a[k] = i < LTOK ? V[i] : -1.f; cnt[k] = 0; }
        for (int j4 = 0; j4 < LTOK / 4; ++j4) { const f32x4 v = *(const LAS f32x4*)(V + 4 * j4);
#pragma unroll
            for (int q = 0; q < 4; ++q) { const float aj = v[q]; const int j = 4 * j4 + q;
#pragma unroll
                for (int k = 0; k < 9; ++k) cnt[k] += (aj > a[k]) || (aj == a[k] && j < tid + 512 * k); } }
#pragma unroll
        for (int k = 0; k < 9; ++k) { const int i = tid + 512 * k;
            if (i < LTOK) { const int row = row_of(b, i);
                if (cnt[k] < CAP) { const int mrow = e * EROWS + b * CAP + cnt[k]; c.RIDX()[mrow] = row; c.GATE()[mrow] = a[k]; c.SEL()[row * 16 + e] = mrow; }
                else c.SEL()[row * 16 + e] = -1; } }
    }
}

__device__ void phase_final(const Ctx& c0) {
    const Ctx c = fresh(c0);
    const int lane = c.lane;
    for (int row = c.bid * 8 + c.wid; row < ROWS_REAL; row += c.G * 8) {
        f32x4 v[4];
#pragma unroll
        for (int i = 0; i < 4; ++i) v[i] = *(const f32x4*)(c.H() + (size_t)row * DM + 4 * lane + 256 * i);
        const int s = lane < 16 ? c.SEL()[row * 16 + lane] : -1;
        for (int e = 0; e < 16; ++e) { const int se = __shfl(s, e);
            if (se >= 0) {
#pragma unroll
                for (int i = 0; i < 4; ++i) { const u32x2 w = *(const u32x2*)(c.Y() + (size_t)se * DM + 4 * lane + 256 * i);
                    v[i][0] += bflo(w.x); v[i][1] += bfhi(w.x); v[i][2] += bflo(w.y); v[i][3] += bfhi(w.y); } } }
#pragma unroll
        for (int i = 0; i < 4; ++i) *(f32x4*)(c.a->out + (size_t)row * DM + 4 * lane + 256 * i) = v[i];
    }
}

constexpr int NPH_LAYER = 10, NPH = 1 + DEPTH * NPH_LAYER + 1;
__global__ void __launch_bounds__(512, 2) mega(Args args) {
    extern __shared__ __attribute__((aligned(16))) unsigned char lds[];
    Ctx c;
    c.a = &args; c.ws = args.ws; c.smem = (LAS char*)lds; c.tid = threadIdx.x; c.lane = c.tid & 63; c.wid = __builtin_amdgcn_readfirstlane(c.tid >> 6); c.G = gridDim.x; c.bid = blockIdx.x;
    unsigned char* ws = args.ws;
    LAS unsigned char* l3 = (LAS unsigned char*)lds;
    volatile LAS unsigned* MISC = (volatile LAS unsigned*)(l3 + LDS_MISC);
    if (c.tid < 4) MISC[c.tid] = 0u;
    __syncthreads();
    const int lo = args.ph_lo, hi = args.ph_hi;
    XcdBarrier bar; bar.bar = (unsigned*)(ws + WS_CTL) + 4096; bar.x = 0; bar.st = MISC;
    if (hi - lo > 1) bar = xcd_barrier_post((unsigned*)(ws + WS_CTL) + 4096, MISC);
#define IN(k) (lo <= (k) && (k) < hi)
#define SEAM(k) do { if (IN(k) && IN((k) + 1)) xcd_barrier(bar, c.wid); } while (0)
    if ((PH_MASK & 1) && IN(0)) { phase_tables(c); }
    SEAM(0);
    for (int layer_ = 0; layer_ < DEPTH; ++layer_) {
        int layer = layer_; asm volatile("" : "+s"(layer));
        const int p0 = 1 + layer_ * NPH_LAYER;
        if ((PH_MASK & (2 << 0)) && IN(p0 + 0)) { phase_norm<false>(c, layer); convert_weights(c, layer, (LAS float*)(c.smem + 65536)); }
        SEAM(p0 + 0);
        if ((PH_MASK & (2 << 1)) && IN(p0 + 1)) { pg::SchedDense S{ROWS_PAD / 256, PROJW / 256, (ROWS_PAD / 256) * (PROJW / 256), og(c.G), og(c.bid), (const char*)c.WIN()}; pg::EpiProj E{c.PROJ(), PROJW};
            pg::gemm_phase(l3, c.wid, (const char*)c.U(), DM, S, E); }
        SEAM(p0 + 1);
        if ((PH_MASK & (2 << 2)) && IN(p0 + 2)) { phase_prep(c, layer); }
        SEAM(p0 + 2);
        if ((PH_MASK & (2 << 3)) && IN(p0 + 3)) { phase_mixers(c, layer); }
        SEAM(p0 + 3);
        if ((PH_MASK & (2 << 4)) && IN(p0 + 4)) { phase_mix(c, layer); }
        SEAM(p0 + 4);
        if ((PH_MASK & (2 << 5)) && IN(p0 + 5)) { pg::SchedDense S{ROWS_PAD / 256, DM / 256, (ROWS_PAD / 256) * (DM / 256), og(c.G), og(c.bid), (const char*)c.WOUT()}; pg::EpiResid E{c.H(), DM};
            pg::gemm_phase(l3, c.wid, (const char*)c.MIX(), MIXW, S, E); }
        SEAM(p0 + 5);
        if ((PH_MASK & (2 << 6)) && IN(p0 + 6)) { phase_norm<true>(c, layer); }
        SEAM(p0 + 6);
        if ((PH_MASK & (2 << 7)) && IN(p0 + 7)) { phase_topk(c); }
        SEAM(p0 + 7);
        if ((PH_MASK & (2 << 8)) && IN(p0 + 8)) { pg::SchedMoE1 S{og(c.G), og(c.bid), c.RIDX(), (const char*)c.WGU()}; pg::EpiGateUp E{c.ACT()};
            pg::gemm_phase(l3, c.wid, (const char*)c.U(), DM, S, E); }
        SEAM(p0 + 8);
        if ((PH_MASK & (2 << 9)) && IN(p0 + 9)) { pg::SchedMoE2 S{og(c.G), og(c.bid), (const char*)c.WD()}; pg::EpiDown E{c.Y(), c.GATE()};
            pg::gemm_phase(l3, c.wid, (const char*)c.ACT(), FF, S, E); }
        SEAM(p0 + 9);
    }
    if ((PH_MASK & (2 << 10)) && IN(NPH - 1)) { phase_final(c); }
#undef IN
#undef SEAM
}

extern "C" void kernel_launch(void* const* d_in, const int* in_sizes, int n_in, void* d_out, int out_size, void* d_ws, size_t ws_size, hipStream_t stream) {
    static int grid = 0;
    if (grid == 0) {
        if (n_in != 21 || out_size != ROWS_REAL * DM || ws_size < WS_END) { fprintf(stderr, "kernel_launch: unexpected problem (n_in %d, out %d, ws %zu)\n", n_in, out_size, ws_size); grid = -1; return; }
        int dev = 0, cus = 0, per_cu = 0;
        if (hipGetDevice(&dev) != hipSuccess || hipDeviceGetAttribute(&cus, hipDeviceAttributeMultiprocessorCount, dev) != hipSuccess) { grid = -1; return; }
        if (hipFuncSetAttribute((const void*)mega, hipFuncAttributeMaxDynamicSharedMemorySize, LDS_BYTES) != hipSuccess) { fprintf(stderr, "kernel_launch: hipFuncSetAttribute failed\n"); grid = -1; return; }
        if (hipOccupancyMaxActiveBlocksPerMultiprocessor(&per_cu, (const void*)mega, 512, LDS_BYTES) != hipSuccess || per_cu < 1) fprintf(stderr, "kernel_launch: occupancy query says %d\n", per_cu);
        (void)hipGetLastError();
        grid = cus;
    }
    if (grid < 0) return;
    (void)hipMemsetAsync((char*)d_ws + WS_CTL, 0, CTL_BYTES, stream);
    Args a{};
    for (int i = 0; i < 21; ++i) a.in[i] = (const float*)d_in[i];
    a.out = (float*)d_out; a.ws = (unsigned char*)d_ws;
#if LAUNCH_PER_PHASE
    for (int ph = 0; ph < NPH; ++ph) { a.ph_lo = ph; a.ph_hi = ph + 1; hipLaunchKernelGGL(mega, dim3(grid), dim3(512), LDS_BYTES, stream, a); }
#else
    a.ph_lo = 0; a.ph_hi = NPH; hipLaunchKernelGGL(mega, dim3(grid), dim3(512), LDS_BYTES, stream, a);
#endif
}
```

```cpp
#include <hip/hip_runtime.h>
#include <cstdio>
#include <cstdint>

#define LAS __attribute__((address_space(3)))
typedef unsigned short bf16_t;
typedef short bf16x8 __attribute__((ext_vector_type(8)));
typedef float f32x4 __attribute__((ext_vector_type(4)));
typedef float f32x2 __attribute__((ext_vector_type(2)));
typedef unsigned u32x4 __attribute__((ext_vector_type(4)));
typedef unsigned u32x2 __attribute__((ext_vector_type(2)));

#ifndef PH_MASK
#define PH_MASK 0xFFFFF
#endif
#ifndef SMALL_REP
#define SMALL_REP 1
#endif
#ifndef PROBE_PH
#define PROBE_PH -1
#endif
#define REP(k) for (int rep_ = 0; rep_ < ((PROBE_PH == (k)) ? 2 : 1); ++rep_)
#define DLY(k, body) do { if (PROBE_PH == (k)) { const unsigned long long t0_ = __builtin_amdgcn_s_memrealtime(); body; __syncthreads(); const unsigned long long t1_ = __builtin_amdgcn_s_memrealtime(); while (__builtin_amdgcn_s_memrealtime() - t1_ < t1_ - t0_) __builtin_amdgcn_s_sleep(8); } else { body; } } while (0)
#ifndef LAUNCH_PER_PHASE
#define LAUNCH_PER_PHASE 0
#endif

constexpr int DM = 1024, NB = 8, SEQ = 4096, DEPTH = 4, NMETA = 16, LTOK = SEQ + NMETA;
constexpr int ROWS_REAL = NB * SEQ, ROWS = NB * LTOK, ROWS_PAD = 33024;
constexpr int INW = 4624, PROJW = 4608;
constexpr int C_AQ = 0, C_AK = 512, C_AV = 640, C_HQ = 768, C_HF = 1280, C_HB = 1792, C_HI = 2304, C_HG = 2816, C_SZ = 3328, C_XBC = 3840, C_DT = 4608;
constexpr int MIXW = 1536, NEXP = 16, FF = 2048, CAP = 514, EROWS = 4352, MOE_ROWS = NEXP * EROWS;
constexpr float EPS = 1e-6f;
constexpr float QSCALE = 0.125f * 1.4426950408889634f;

constexpr size_t MiB = 1u << 20;
constexpr size_t WS_CTL = 0, CTL_BYTES = 1 * MiB;
constexpr size_t WS_ROPE = 1 * MiB;
constexpr size_t WS_LB = WS_ROPE + 2u * 4096 * 32 * 4;
constexpr size_t WS_H = 3 * MiB;
constexpr size_t WS_U = 133 * MiB;
constexpr size_t WS_DT = 198 * MiB;
constexpr size_t WS_AFFT = 201 * MiB;
constexpr size_t WS_SEL = 204 * MiB;
constexpr size_t WS_RIDX = 207 * MiB;
constexpr size_t WS_GATE = 208 * MiB;
constexpr size_t WS_IDT = 208 * MiB + 512 * 1024;
constexpr size_t WS_XBC = 209 * MiB;
constexpr size_t WS_ATT = 258 * MiB;
constexpr size_t WS_OF = 291 * MiB, WS_OB = 324 * MiB, WS_YF = 357 * MiB, WS_YB = 390 * MiB;
constexpr size_t WS_MIX = 423 * MiB;
constexpr size_t WS_PROJ = 520 * MiB;
constexpr size_t WS_ACT = WS_PROJ;
constexpr size_t WS_Y = 811 * MiB;
constexpr size_t WS_WIN = 947 * MiB;
constexpr size_t WS_WOUT = 956 * MiB;
constexpr size_t WS_WGU = 959 * MiB;
constexpr size_t WS_WSTRIDE = 109 * MiB;
constexpr size_t WS_WGU_UNUSED_ = 0;
constexpr size_t WS_WD = 1023 * MiB;
constexpr size_t WS_END = 1166 * MiB;

constexpr int LDS_BYTES = 147456;
constexpr int LDS_MISC = 145408;

typedef __bf16 bf16x2_t __attribute__((ext_vector_type(2)));
__device__ __forceinline__ unsigned cvt_pk_bf16(float lo, float hi) { f32x2 v = {lo, hi}; bf16x2_t b = __builtin_convertvector(v, bf16x2_t); return __builtin_bit_cast(unsigned, b); }
__device__ __forceinline__ unsigned pk4_fp8(float a, float b, float c, float d) { int w = __builtin_amdgcn_cvt_pk_fp8_f32(a, b, 0, false); w = __builtin_amdgcn_cvt_pk_fp8_f32(c, d, w, true); return (unsigned)w; }
__device__ __forceinline__ bf16_t f2bf(float f) { return (bf16_t)(cvt_pk_bf16(f, 0.f) & 0xffffu); }
__device__ __forceinline__ float bf2f(bf16_t b) { return __uint_as_float(((unsigned)b) << 16); }
__device__ __forceinline__ float bflo(unsigned w) { return __uint_as_float(w << 16); }
__device__ __forceinline__ float bfhi(unsigned w) { return __uint_as_float(w & 0xffff0000u); }
__device__ __forceinline__ float shx(float v, int m, int lane) { return __int_as_float(__builtin_amdgcn_ds_bpermute((lane ^ m) << 2, __float_as_int(v))); }
__device__ __forceinline__ int shl_i(int v, int src) { return __builtin_amdgcn_ds_bpermute(src << 2, v); }
__device__ __forceinline__ float shl_f(float v, int src) { return __int_as_float(__builtin_amdgcn_ds_bpermute(src << 2, __float_as_int(v))); }
__device__ __forceinline__ float shup_f(float v, int o, int lane) { return __int_as_float(__builtin_amdgcn_ds_bpermute((lane >= o ? lane - o : lane) << 2, __float_as_int(v))); }
__device__ __forceinline__ unsigned shup_u(unsigned v, int o, int lane) { return (unsigned)__builtin_amdgcn_ds_bpermute((lane >= o ? lane - o : lane) << 2, (int)v); }
__device__ __forceinline__ float wave_sum(float v, int lane) {
#pragma unroll
    for (int o = 1; o < 64; o <<= 1) v += shx(v, o, lane);
    return v;
}
__device__ __forceinline__ void lds_barrier() { asm volatile("s_waitcnt lgkmcnt(0)\n\ts_barrier" ::: "memory"); }
__device__ __forceinline__ float silu_f(float x) { return x * __builtin_amdgcn_rcpf(1.0f + __expf(-x)); }
__device__ __forceinline__ float fgate_f(float x, float lb) { const float e = __expf(-x), ec = fminf(e, 1.0686474581524463e13f); return fminf((1.0f + lb * ec) * __builtin_amdgcn_rcpf(1.0f + e), 1.0f); }
__device__ __forceinline__ int row_of(int b, int t) { return t < NMETA ? ROWS_REAL + b * NMETA + t : b * SEQ + (t - NMETA); }

#define XB_TMO      128
#define XB_XCNT(j)  (256  + 64 * (j))
#define XB_XSUB(j)  (1280 + 64 * (j))
#define XB_XGEN(j)  (2304 + 64 * (j))
#define XB_TOP      3328
#define XB_TOPGEN   3392
#define XCD_BAR_WORDS 3456
#define XB_SPIN_CAP (1u << 18)
__device__ __forceinline__ unsigned xb_ld(unsigned* p)              { return __hip_atomic_load(p, __ATOMIC_RELAXED, __HIP_MEMORY_SCOPE_AGENT); }
__device__ __forceinline__ unsigned xb_add(unsigned* p, unsigned v) { return __hip_atomic_fetch_add(p, v, __ATOMIC_RELAXED, __HIP_MEMORY_SCOPE_AGENT); }
__device__ __forceinline__ unsigned xb_xcc_id() { return (unsigned)__builtin_amdgcn_s_getreg((3 << 11) | 20) & 0xFu; }
#define XB_SPIN(cond, bar) do { unsigned _sp = 0; while (cond) { __builtin_amdgcn_s_sleep(1); \
    if ((++_sp & 255u) == 0u) { if (xb_ld(&(bar)[XB_TMO])) break; if (_sp > XB_SPIN_CAP) { atomicAdd(&(bar)[XB_TMO], 1u); break; } } } } while (0)
struct XcdBarrier { unsigned* bar; unsigned x; volatile LAS unsigned* st; };
__device__ __forceinline__ XcdBarrier xcd_barrier_post(unsigned* bar, volatile LAS unsigned* st) {
    XcdBarrier b; b.bar = bar; b.x = xb_xcc_id(); b.st = st;
    if (threadIdx.x == 0) (void)xb_add(&bar[XB_XCNT(b.x)], 1u);
    return b;
}
__device__ __forceinline__ void xcd_barrier_complete(unsigned* bar, unsigned x, unsigned& nloc, unsigned& nx) {
    const unsigned G = gridDim.x * gridDim.y * gridDim.z;
    unsigned sum, cnt, mine, sp = 0u;
    for (;;) {
        sum = 0u; cnt = 0u; mine = 0u;
#pragma unroll
        for (unsigned j = 0; j < 16; ++j) { const unsigned c = xb_ld(&bar[XB_XCNT(j)]); sum += c; cnt += (c > 0u) ? 1u : 0u; mine = (j == x) ? c : mine; }
        if (sum == G) break;
        __builtin_amdgcn_s_sleep(1);
        if ((++sp & 255u) == 0u) { if (xb_ld(&bar[XB_TMO])) break; if (sp > XB_SPIN_CAP) { atomicAdd(&bar[XB_TMO], 1u); break; } }
    }
    nloc = mine > 0u ? mine : 1u; nx = cnt > 0u ? cnt : 1u;
}
__device__ __forceinline__ void xcd_barrier(const XcdBarrier& b, const int wid) {
    asm volatile("s_waitcnt vmcnt(0)" ::: "memory");
    __syncthreads();
    unsigned zb_ = 0u; asm volatile("" : "+s"(zb_));
    if (wid == 0 && __builtin_amdgcn_mbcnt_hi(~0u, __builtin_amdgcn_mbcnt_lo(~0u, zb_)) == 0u) {
        unsigned* bar = b.bar;
        __builtin_amdgcn_s_waitcnt(0);
        unsigned nloc = b.st[0], nx = b.st[1];
        if (nloc == 0u) { xcd_barrier_complete(bar, b.x, nloc, nx); b.st[0] = nloc; b.st[1] = nx; }
        const unsigned old = xb_add(&bar[XB_XSUB(b.x)], 1u);
        const unsigned gen = old / nloc;
        if (old + 1u == (gen + 1u) * nloc) {
            __builtin_amdgcn_fence(__ATOMIC_RELEASE, "agent");
            asm volatile("s_waitcnt vmcnt(0)" ::: "memory");
            const unsigned og = xb_add(&bar[XB_TOP], 1u);
            const unsigned tg = og / nx;
            if (og + 1u == (tg + 1u) * nx) xb_add(&bar[XB_TOPGEN], 1u);
            else XB_SPIN(xb_ld(&bar[XB_TOPGEN]) == tg, bar);
            __builtin_amdgcn_fence(__ATOMIC_ACQUIRE, "agent");
            xb_add(&bar[XB_XGEN(b.x)], 1u);
            asm volatile("s_waitcnt vmcnt(0)" ::: "memory");
        } else {
            XB_SPIN(xb_ld(&bar[XB_XGEN(b.x)]) == gen, bar);
            __builtin_amdgcn_fence(__ATOMIC_ACQUIRE, "agent");
            asm volatile("s_waitcnt vmcnt(0)" ::: "memory");
        }
    }
    __syncthreads();
}

namespace pg {
typedef int v4i_t __attribute__((ext_vector_type(4)));
typedef int v8i_t __attribute__((ext_vector_type(8)));
constexpr int BM = 256, BK = 64, HALF = 128, HTB = HALF * BK * 2, STAGE_BYTES = 8 * HTB;
__device__ __forceinline__ int lds_byte(int r, int c) { const int st = (r >> 4) * 2 + (c >> 5), rr = r & 15, cc = c & 31, ob = rr * 64 + cc * 2; return st * 1024 + (ob ^ (((ob >> 9) & 1) << 5)); }
__device__ __forceinline__ void stage_rc(int b, int& R, int& C) { const int st = b / 1024, sb = b % 1024, swz = sb ^ (((sb >> 9) & 1) << 5); R = (st >> 1) * 16 + swz / 64; C = (st & 1) * 32 + (swz % 64) / 2; }
__device__ __forceinline__ int perm32(int rho) { const int n = rho >> 4, i = rho & 15; return 8 * (i >> 2) + 4 * n + (i & 3); }
struct Unit { int pm, pn, e; };

template <class Epi, class Sched>
__device__ __forceinline__ void gemm_phase(LAS unsigned char* lds, const int wid_in, const char* Abase, const int K  , const Sched& S, const Epi& E) {
    int wid = wid_in; asm volatile("" : "+s"(wid));
    unsigned z_ = 0u; asm volatile("" : "+s"(z_));
    const int lane = (int)__builtin_amdgcn_mbcnt_hi(~0u, __builtin_amdgcn_mbcnt_lo(~0u, z_)), tid = wid * 64 + lane;
    const int wr = wid >> 2, wc = wid & 3, fr = lane & 15, fq = lane >> 4;
    const int nt = K / 128;
    constexpr bool F8 = Sched::F8;
    constexpr bool GA = Sched::GATHER;
    unsigned voffA[2], voffB[2];
#pragma unroll
    for (int i = 0; i < 2; ++i) { int R, C; stage_rc(tid * 16 + i * 8192, R, C); const int Rb = Epi::PERM ? ((R & ~31) + perm32(R & 31)) : R; voffA[i] = (unsigned)(R * K + C * 2); voffB[i] = (unsigned)(Rb * K + C * 2); }
    const size_t kstep = (size_t)(BK * 2);
    const size_t hstep = (size_t)HALF * K;
    const unsigned ldsw = (unsigned)wid * 1024u;
    const int aoff = lds_byte(wr * 64 + fr, fq * 8), boff = lds_byte(wc * 32 + fr, fq * 8);
#define PG_SA(b, h) (((b) * 2 + (h)) * HTB)
#define PG_SB(b, h) ((4 + (b) * 2 + (h)) * HTB)
#define PG_STAGE(bufoff, gbase, voff) do { _Pragma("unroll") for (int _i = 0; _i < 2; ++_i) \
        __builtin_amdgcn_global_load_lds((const unsigned*)((const char*)(gbase) + (voff)[_i]), (LAS unsigned*)(lds + (bufoff) + ldsw + _i * 8192), 16, 0, 0); } while (0)
#define PG_STAGE_A(bufoff, ab, av, h, koff) do { if (GA) { const u32x2 o2_ = *(const LAS u32x2*)(aol + 2 * (h)); unsigned ov_[2] = {o2_.x, o2_.y}; PG_STAGE(bufoff, Abase + (koff), ov_); } else { PG_STAGE(bufoff, (ab) + (h) * hstep + (koff), voffA); } } while (0)
#define PG_LDA(dst, b, h) do { _Pragma("unroll") for (int m = 0; m < 4; ++m) _Pragma("unroll") for (int k = 0; k < 2; ++k) dst[m][k] = *(const LAS bf16x8*)(lds + PG_SA(b, h) + aoff + m * 2048 + k * 1024); } while (0)
#define PG_LDB(dst, b, h) do { _Pragma("unroll") for (int n = 0; n < 2; ++n) _Pragma("unroll") for (int k = 0; k < 2; ++k) dst[n][k] = *(const LAS bf16x8*)(lds + PG_SB(b, h) + boff + n * 2048 + k * 1024); } while (0)
#define PG_CAT8(lo, hi) __builtin_shufflevector(__builtin_bit_cast(v4i_t, lo), __builtin_bit_cast(v4i_t, hi), 0, 1, 2, 3, 4, 5, 6, 7)
#define PG_MMA(ai, bj, At, Bt) do { __builtin_amdgcn_s_setprio(1); _Pragma("unroll") for (int m = 0; m < 4; ++m) _Pragma("unroll") for (int n = 0; n < 2; ++n) { \
        if (F8) acc[ai][bj][m][n] = __builtin_amdgcn_mfma_scale_f32_16x16x128_f8f6f4(PG_CAT8(Bt[n][0], Bt[n][1]), PG_CAT8(At[m][0], At[m][1]), acc[ai][bj][m][n], 0, 0, 0, 122, 0, 127); \
        else { _Pragma("unroll") for (int k = 0; k < 2; ++k) acc[ai][bj][m][n] = __builtin_amdgcn_mfma_f32_16x16x32_bf16(Bt[n][k], At[m][k], acc[ai][bj][m][n], 0, 0, 0); } } __builtin_amdgcn_s_setprio(0); } while (0)
#define PG_WAIT_V(n) asm volatile("s_waitcnt vmcnt(" #n ")" ::: "memory")
#define PG_WAIT_L(n) asm volatile("s_waitcnt lgkmcnt(" #n ")" ::: "memory")
#define PG_BAR __builtin_amdgcn_s_barrier()
#define PG_SCHED __builtin_amdgcn_sched_barrier(0)
    Unit cur, nxt; int ui = 0;
    if (!S.next(0, cur)) return;
    LAS int* rtab = (LAS int*)(lds + STAGE_BYTES);
    LAS unsigned* aol = (LAS unsigned*)(lds + STAGE_BYTES + 2048) + tid * 4;
#define PG_AO_FROM_TABLE(tb) do { u32x4 o_; { int R_, C_; stage_rc(tid * 16, R_, C_); o_.x = (unsigned)(rtab[(tb) * 256 + R_] * K + C_ * 2); o_.z = (unsigned)(rtab[(tb) * 256 + 128 + R_] * K + C_ * 2); } \
        { int R_, C_; stage_rc(tid * 16 + 8192, R_, C_); o_.y = (unsigned)(rtab[(tb) * 256 + R_] * K + C_ * 2); o_.w = (unsigned)(rtab[(tb) * 256 + 128 + R_] * K + C_ * 2); } *(LAS u32x4*)aol = o_; } while (0)
    if (GA) { if (tid < 256) rtab[tid] = S.arow(cur, tid); __syncthreads(); PG_AO_FROM_TABLE(0); }
    const char* cA = GA ? Abase : Abase + S.aunit(cur, K);
    const char* cB = S.bptr(cur, K);
    f32x4 acc[2][2][4][2];
#pragma unroll
    for (int a = 0; a < 2; ++a)
#pragma unroll
        for (int b = 0; b < 2; ++b)
#pragma unroll
            for (int m = 0; m < 4; ++m)
#pragma unroll
                for (int n = 0; n < 2; ++n) acc[a][b][m][n] = (f32x4){0.f, 0.f, 0.f, 0.f};
    bf16x8 At[4][2], B0[2][2], B1[2][2];
    PG_STAGE(PG_SB(0, 0), cB, voffB); PG_STAGE(PG_SB(0, 1), cB + hstep, voffB); PG_STAGE_A(PG_SA(0, 0), cA, 0, 0, 0); PG_STAGE_A(PG_SA(0, 1), cA, 0, 1, 0);
    if (wr == 1) PG_BAR;
    PG_WAIT_V(2); PG_BAR;
    PG_STAGE(PG_SB(1, 0), cB + kstep, voffB); PG_STAGE_A(PG_SA(1, 0), cA, 0, 0, kstep); PG_STAGE(PG_SB(1, 1), cB + hstep + kstep, voffB);
    PG_WAIT_V(6); PG_BAR;
    for (;;) {
        const bool has_next = S.next(ui + 1, nxt);
        const char* nA = cA; const char* nB = cB;
        if (has_next) { if (GA) { if (wid < 4) __builtin_amdgcn_global_load_lds((const unsigned*)S.arowp(nxt, tid), (LAS unsigned*)(rtab + ((ui + 1) & 1) * 256 + wid * 64), 4, 0, 0); }
            else nA = Abase + S.aunit(nxt, K); nB = S.bptr(nxt, K); }
        for (int t = 0; t < nt; t += 2) {
            const bool last = (t == nt - 2);
            const size_t k1 = (size_t)(t + 1) * kstep, k2 = last ? 0 : (size_t)(t + 2) * kstep, k3 = k2 + kstep;
            const char* a2 = last ? nA : cA; const char* b2 = last ? nB : cB;
            PG_LDB(B0, 0, 0); PG_LDB(B1, 0, 1); PG_SCHED; PG_LDA(At, 0, 0); PG_STAGE_A(PG_SA(1, 1), cA, 0, 1, k1);
            if (GA && last && has_next) { PG_AO_FROM_TABLE((ui + 1) & 1); }
            PG_WAIT_V(8); PG_WAIT_L(0); PG_BAR; PG_MMA(0, 0, At, B0); PG_MMA(0, 1, At, B1); PG_BAR; PG_SCHED;
            PG_LDA(At, 0, 1); PG_STAGE(PG_SB(0, 0), b2 + k2, voffB); PG_STAGE(PG_SB(0, 1), b2 + hstep + k2, voffB); PG_STAGE_A(PG_SA(0, 0), a2, 0, 0, k2);
            PG_WAIT_V(8); PG_WAIT_L(0); PG_BAR; PG_MMA(1, 0, At, B0); PG_MMA(1, 1, At, B1); PG_BAR; PG_SCHED;
            PG_LDB(B0, 1, 0); PG_LDB(B1, 1, 1); PG_SCHED; PG_LDA(At, 1, 0); PG_STAGE_A(PG_SA(0, 1), a2, 0, 1, k2);
            PG_WAIT_V(8); PG_WAIT_L(0); PG_BAR; PG_MMA(0, 0, At, B0); PG_MMA(0, 1, At, B1); PG_BAR; PG_SCHED;
            PG_LDA(At, 1, 1); PG_STAGE(PG_SB(1, 0), b2 + k3, voffB); PG_STAGE(PG_SB(1, 1), b2 + hstep + k3, voffB); PG_STAGE_A(PG_SA(1, 0), a2, 0, 0, k3);
            PG_WAIT_V(8); PG_WAIT_L(0); PG_BAR; PG_MMA(1, 0, At, B0); PG_MMA(1, 1, At, B1); PG_BAR; PG_SCHED;
        }
        if (wr == 0) PG_BAR;
        E(acc, cur, wr, wc, fr, fq);
        if (!has_next) break;
#pragma unroll
        for (int a = 0; a < 2; ++a)
#pragma unroll
            for (int b = 0; b < 2; ++b)
#pragma unroll
                for (int m = 0; m < 4; ++m)
#pragma unroll
                    for (int n = 0; n < 2; ++n) acc[a][b][m][n] = (f32x4){0.f, 0.f, 0.f, 0.f};
        cur = nxt; cA = nA; cB = nB; ++ui;
        if (wr == 1) PG_BAR;
    }
    PG_WAIT_V(0);
    PG_BAR;
#undef PG_SA
#undef PG_SB
#undef PG_STAGE
#undef PG_STAGE_A
#undef PG_AO_FROM_TABLE
#undef PG_LDA
#undef PG_LDB
#undef PG_MMA
#undef PG_CAT8
#undef PG_WAIT_V
#undef PG_WAIT_L
#undef PG_BAR
#undef PG_SCHED
}

struct SchedDense {
    static constexpr bool GATHER = false, F8 = false;
    int nM, nN, nwg, G, c; const char* Bt;
    __device__ __forceinline__ bool next(int i, Unit& u) const {
        const long L = (long)i * G + c; if (L >= nwg) return false;
        int wgid = (int)L; { const int q = nwg / 8, r = nwg % 8, xcd = wgid % 8, off = wgid / 8; wgid = (xcd < r ? xcd * (q + 1) : r * (q + 1) + (xcd - r) * q) + off; }
        const int nig = 8 * nN, gid = wgid / nig, fm = gid * 8, gsz = (nM - fm) < 8 ? (nM - fm) : 8;
        u.pm = fm + ((wgid % nig) % gsz); u.pn = (wgid % nig) / gsz; u.e = 0; return true;
    }
    __device__ __forceinline__ int arow(const Unit&, int) const { return 0; }
    __device__ __forceinline__ const int* arowp(const Unit&, int) const { return nullptr; }
    __device__ __forceinline__ size_t aunit(const Unit& u, int K) const { return (size_t)u.pm * 256 * K; }
    __device__ __forceinline__ const char* bptr(const Unit& u, int K) const { return Bt + (size_t)u.pn * 256 * K; }
};
struct SchedMoE1 {
    static constexpr bool GATHER = true, F8 = true;
    int G, c; const int* ridx; const char* Bt;
    __device__ __forceinline__ bool next(int i, Unit& u) const {
        if (G % 8 == 0) {
            const int x = c & 7, q = (c >> 3) + (G >> 3) * i; if (q >= NEXP * 32) return false;
            u.e = q >> 5; const int r = q & 31; u.pm = r >> 1; u.pn = 2 * x + (r & 1); return true; }
        const int L = i * G + c; if (L >= NEXP * 16 * 16) return false;
        u.e = L >> 8; const int rem = L & 255; u.pm = rem & 15; u.pn = rem >> 4; return true;
    }
    __device__ __forceinline__ int arow(const Unit& u, int r) const { return ridx[u.e * EROWS + u.pm * 256 + r]; }
    __device__ __forceinline__ const int* arowp(const Unit& u, int r) const { return ridx + u.e * EROWS + u.pm * 256 + r; }
    __device__ __forceinline__ size_t aunit(const Unit&, int) const { return 0; }
    __device__ __forceinline__ const char* bptr(const Unit& u, int K) const { return Bt + ((size_t)u.e * 4096 + (size_t)u.pn * 256) * K; }
};
struct SchedMoE2 {
    static constexpr bool GATHER = true, F8 = true;
    int G, c; const int* idt; const char* Bt;
    __device__ __forceinline__ bool next(int i, Unit& u) const {
        if (G % 8 == 0) {
            const int x = c & 7, q = (c >> 3) + (G >> 3) * i; if (q >= 128) return false;
            u.e = 2 * x + (q >> 6); const int r = q & 63; u.pm = r >> 2; u.pn = r & 3; return true; }
        const int L = i * G + c; if (L >= NEXP * 16 * 4) return false;
        u.e = L >> 6; const int rem = L & 63; u.pm = rem & 15; u.pn = rem >> 4; return true;
    }
    __device__ __forceinline__ int arow(const Unit& u, int r) const { return u.e * EROWS + u.pm * 256 + r; }
    __device__ __forceinline__ const int* arowp(const Unit& u, int r) const { return idt + u.e * EROWS + u.pm * 256 + r; }
    __device__ __forceinline__ size_t aunit(const Unit&, int) const { return 0; }
    __device__ __forceinline__ const char* bptr(const Unit& u, int K) const { return Bt + ((size_t)u.e * 1024 + (size_t)u.pn * 256) * K; }
};

struct EpiProj {
    static constexpr bool PERM = true;
    bf16_t* O; int ldc; const float* lbf; const float* lbb;
    __device__ __forceinline__ void operator()(const f32x4 (&acc)[2][2][4][2], const Unit& u, int wr, int wc, int fr, int fq) const {
        const int row0 = u.pm * BM + wr * 64 + fr, col0 = u.pn * BM + wc * 32 + 8 * fq;
        const int mode = (u.pn == 3 || u.pn == 4) ? 1 : ((u.pn >= 5 && u.pn <= 8) ? 2 : 0);
#pragma unroll
        for (int bj = 0; bj < 2; ++bj) {
            float lb[8];
            if (mode == 2) { const float* lp = (u.pn <= 6 ? lbf + (u.pn - 5) * 256 : lbb + (u.pn - 7) * 256) + wc * 32 + 8 * fq + bj * HALF; const f32x4 a = *(const f32x4*)lp, b = *(const f32x4*)(lp + 4);
#pragma unroll
                for (int j = 0; j < 4; ++j) { lb[j] = a[j]; lb[4 + j] = b[j]; } }
#pragma unroll
            for (int ai = 0; ai < 2; ++ai)
#pragma unroll
                for (int m = 0; m < 4; ++m) { bf16_t* rowp = O + (size_t)(row0 + ai * HALF + m * 16) * ldc + col0; float v[8];
#pragma unroll
                    for (int j = 0; j < 4; ++j) { v[j] = acc[ai][bj][m][0][j]; v[4 + j] = acc[ai][bj][m][1][j]; }
                    if (mode == 1) {
#pragma unroll
                        for (int j = 0; j < 8; ++j) v[j] = silu_f(v[j]); }
                    else if (mode == 2) {
#pragma unroll
                        for (int j = 0; j < 8; ++j) v[j] = fgate_f(v[j], lb[j]); }
                    u32x4 w; w.x = cvt_pk_bf16(v[0], v[1]); w.y = cvt_pk_bf16(v[2], v[3]); w.z = cvt_pk_bf16(v[4], v[5]); w.w = cvt_pk_bf16(v[6], v[7]);
                    *(u32x4*)(rowp + bj * HALF) = w; } }
    }
};
struct EpiResid {
    static constexpr bool PERM = true;
    bf16_t* H; int ldc;
    __device__ __forceinline__ void operator()(const f32x4 (&acc)[2][2][4][2], const Unit& u, int wr, int wc, int fr, int fq) const {
        const int row0 = u.pm * BM + wr * 64 + fr, col0 = u.pn * BM + wc * 32 + 8 * fq;
#pragma unroll
        for (int ai = 0; ai < 2; ++ai)
#pragma unroll
            for (int m = 0; m < 4; ++m) { bf16_t* rowp = H + (size_t)(row0 + ai * HALF + m * 16) * ldc + col0;
#pragma unroll
                for (int bj = 0; bj < 2; ++bj) { u32x4* p = (u32x4*)(rowp + bj * HALF); const u32x4 w = *p; const f32x4 v0 = acc[ai][bj][m][0], v1 = acc[ai][bj][m][1];
                    u32x4 o; o.x = cvt_pk_bf16(bflo(w.x) + v0[0], bfhi(w.x) + v0[1]); o.y = cvt_pk_bf16(bflo(w.y) + v0[2], bfhi(w.y) + v0[3]); o.z = cvt_pk_bf16(bflo(w.z) + v1[0], bfhi(w.z) + v1[1]); o.w = cvt_pk_bf16(bflo(w.w) + v1[2], bfhi(w.w) + v1[3]);
                    *p = o; } }
    }
};
struct EpiGateUp {
    static constexpr bool PERM = true;
    unsigned char* ACT;
    __device__ __forceinline__ void operator()(const f32x4 (&acc)[2][2][4][2], const Unit& u, int wr, int wc, int fr, int fq) const {
        const int row0 = u.e * EROWS + u.pm * BM + wr * 64 + fr, col0 = u.pn * 128 + wc * 32 + 8 * fq;
#pragma unroll
        for (int ai = 0; ai < 2; ++ai)
#pragma unroll
            for (int m = 0; m < 4; ++m) { unsigned char* p = ACT + (size_t)(row0 + ai * HALF + m * 16) * FF + col0;
                float r[8];
#pragma unroll
                for (int n = 0; n < 2; ++n)
#pragma unroll
                    for (int j = 0; j < 4; ++j) r[n * 4 + j] = silu_f(acc[ai][0][m][n][j]) * acc[ai][1][m][n][j];
                u32x2 w; w.x = pk4_fp8(r[0], r[1], r[2], r[3]); w.y = pk4_fp8(r[4], r[5], r[6], r[7]);
                *(u32x2*)p = w; }
    }
};
struct EpiDown {
    static constexpr bool PERM = true;
    unsigned char* Y; const float* gate;
    __device__ __forceinline__ void operator()(const f32x4 (&acc)[2][2][4][2], const Unit& u, int wr, int wc, int fr, int fq) const {
        const int row0 = u.e * EROWS + u.pm * BM + wr * 64 + fr, col0 = u.pn * BM + wc * 32 + 8 * fq;
#pragma unroll
        for (int ai = 0; ai < 2; ++ai)
#pragma unroll
            for (int m = 0; m < 4; ++m) { const unsigned row = (unsigned)(row0 + ai * HALF + m * 16); const float g = 16.0f * *(const float*)((const char*)gate + row * 4u); const unsigned off = row * (unsigned)DM + (unsigned)col0;
#pragma unroll
                for (int bj = 0; bj < 2; ++bj) { const f32x4 v0 = acc[ai][bj][m][0] * g, v1 = acc[ai][bj][m][1] * g;
                    u32x2 w; w.x = pk4_fp8(v0[0], v0[1], v0[2], v0[3]); w.y = pk4_fp8(v1[0], v1[1], v1[2], v1[3]);
                    *(u32x2*)(Y + off + bj * HALF) = w; } }
    }
};
}

template <int NACC>
__device__ __forceinline__ void small_gemm16(const bf16_t* arow, const bf16_t* const (&brow)[NACC], const int K, f32x4 (&acc)[NACC], const int lane) {
    const bf16_t* ap = arow + 32 * (lane >> 4);
    const bf16_t* bp[NACC];
#pragma unroll
    for (int n = 0; n < NACC; ++n) { bp[n] = brow[n] + 32 * (lane >> 4); acc[n] = (f32x4){0.f, 0.f, 0.f, 0.f}; }
    bf16x8 a0[4], b0[NACC][4], a1[4], b1[NACC][4];
#define SG_LOAD(A_, B_, k0_) do { _Pragma("unroll") for (int s2 = 0; s2 < 4; ++s2) { A_[s2] = *(const bf16x8*)(ap + (k0_) + 8 * s2); \
        _Pragma("unroll") for (int n = 0; n < NACC; ++n) B_[n][s2] = *(const bf16x8*)(bp[n] + (k0_) + 8 * s2); } } while (0)
#define SG_MMA(A_, B_) do { _Pragma("unroll") for (int s2 = 0; s2 < 4; ++s2) _Pragma("unroll") for (int n = 0; n < NACC; ++n) acc[n] = __builtin_amdgcn_mfma_f32_16x16x32_bf16(B_[n][s2], A_[s2], acc[n], 0, 0, 0); } while (0)
    SG_LOAD(a0, b0, 0);
    for (int k0 = 0; k0 < K; k0 += 256) {
        const bool two = k0 + 128 < K;
        if (two) SG_LOAD(a1, b1, k0 + 128);
        SG_MMA(a0, b0);
        if (two) { if (k0 + 256 < K) SG_LOAD(a0, b0, k0 + 256); SG_MMA(a1, b1); }
    }
#undef SG_LOAD
#undef SG_MMA
}

__device__ __forceinline__ void small_gemm16_2r(const bf16_t* arow0, const bf16_t* arow1, const bf16_t* brow, const int K, f32x4 (&acc)[2], const int lane) {
    const bf16_t* ap0 = arow0 + 32 * (lane >> 4); const bf16_t* ap1 = arow1 + 32 * (lane >> 4); const bf16_t* bp = brow + 32 * (lane >> 4);
    acc[0] = (f32x4){0.f, 0.f, 0.f, 0.f}; acc[1] = (f32x4){0.f, 0.f, 0.f, 0.f};
    bf16x8 a0[2][4], b0[4], a1[2][4], b1[4];
#define SG_LOAD(A_, B_, k0_) do { _Pragma("unroll") for (int s2 = 0; s2 < 4; ++s2) { A_[0][s2] = *(const bf16x8*)(ap0 + (k0_) + 8 * s2); A_[1][s2] = *(const bf16x8*)(ap1 + (k0_) + 8 * s2); B_[s2] = *(const bf16x8*)(bp + (k0_) + 8 * s2); } } while (0)
#define SG_MMA(A_, B_) do { _Pragma("unroll") for (int s2 = 0; s2 < 4; ++s2) { acc[0] = __builtin_amdgcn_mfma_f32_16x16x32_bf16(B_[s2], A_[0][s2], acc[0], 0, 0, 0); acc[1] = __builtin_amdgcn_mfma_f32_16x16x32_bf16(B_[s2], A_[1][s2], acc[1], 0, 0, 0); } } while (0)
    SG_LOAD(a0, b0, 0);
    for (int k0 = 0; k0 < K; k0 += 256) {
        const bool two = k0 + 128 < K;
        if (two) SG_LOAD(a1, b1, k0 + 128);
        SG_MMA(a0, b0);
        if (two) { if (k0 + 256 < K) SG_LOAD(a0, b0, k0 + 256); SG_MMA(a1, b1); }
    }
#undef SG_LOAD
#undef SG_MMA
}

template <int NACC>
__device__ __forceinline__ void small_gemm16_f8(const unsigned char* arow, const unsigned char* const (&brow)[NACC], const int K, f32x4 (&acc)[NACC], const int lane) {
    typedef long long2_t __attribute__((ext_vector_type(2)));
    const unsigned char* ap = arow + 32 * (lane >> 4);
    const unsigned char* bp[NACC];
#pragma unroll
    for (int n = 0; n < NACC; ++n) { bp[n] = brow[n] + 32 * (lane >> 4); acc[n] = (f32x4){0.f, 0.f, 0.f, 0.f}; }
    long2_t a0[2], b0[NACC][2], a1[2], b1[NACC][2];
#define SG_LOAD(A_, B_, k0_) do { _Pragma("unroll") for (int s2 = 0; s2 < 2; ++s2) { A_[s2] = *(const long2_t*)(ap + (k0_) + 16 * s2); \
        _Pragma("unroll") for (int n = 0; n < NACC; ++n) B_[n][s2] = *(const long2_t*)(bp[n] + (k0_) + 16 * s2); } } while (0)
#define SG_MMA(A_, B_) do { _Pragma("unroll") for (int s2 = 0; s2 < 2; ++s2) _Pragma("unroll") for (int h = 0; h < 2; ++h) _Pragma("unroll") for (int n = 0; n < NACC; ++n) \
        acc[n] = __builtin_amdgcn_mfma_f32_16x16x32_fp8_fp8(B_[n][s2][h], A_[s2][h], acc[n], 0, 0, 0); } while (0)
    SG_LOAD(a0, b0, 0);
    for (int k0 = 0; k0 < K; k0 += 256) {
        const bool two = k0 + 128 < K;
        if (two) SG_LOAD(a1, b1, k0 + 128);
        SG_MMA(a0, b0);
        if (two) { if (k0 + 256 < K) SG_LOAD(a0, b0, k0 + 256); SG_MMA(a1, b1); }
    }
#undef SG_LOAD
#undef SG_MMA
}

template <int NROW, int NACC, int K, int PF>
__device__ __forceinline__ void small_gemm16_bt(const bf16_t* const (&arow)[NROW], const bf16_t* const (&brow)[NACC], f32x4 (&acc)[NROW][NACC], const int lane) {
    constexpr int NSW = K / 128, NPRE = PF < NSW ? PF : NSW;
    const int ko = 32 * (lane >> 4);
    bf16x8 A[PF][NROW][4], B[PF][NACC][4];
#pragma unroll
    for (int r = 0; r < NROW; ++r)
#pragma unroll
        for (int n = 0; n < NACC; ++n) acc[r][n] = (f32x4){0.f, 0.f, 0.f, 0.f};
#define SG_LOAD(buf_, s_) do { _Pragma("unroll") for (int s2 = 0; s2 < 4; ++s2) { \
        _Pragma("unroll") for (int r = 0; r < NROW; ++r) A[buf_][r][s2] = *(const bf16x8*)(arow[r] + ko + (s_) * 128 + 8 * s2); \
        _Pragma("unroll") for (int n = 0; n < NACC; ++n) B[buf_][n][s2] = *(const bf16x8*)(brow[n] + ko + (s_) * 128 + 8 * s2); } } while (0)
#pragma unroll
    for (int s = 0; s < NPRE; ++s) SG_LOAD(s, s);
#pragma unroll
    for (int s = 0; s < NSW; ++s) {
#pragma unroll
        for (int s2 = 0; s2 < 4; ++s2)
#pragma unroll
            for (int r = 0; r < NROW; ++r)
#pragma unroll
                for (int n = 0; n < NACC; ++n) acc[r][n] = __builtin_amdgcn_mfma_f32_16x16x32_bf16(B[s % PF][n][s2], A[s % PF][r][s2], acc[r][n], 0, 0, 0);
        if (s + PF < NSW) SG_LOAD(s % PF, s + PF);
    }
#undef SG_LOAD
}
template <int NACC, int K, int PF>
__device__ __forceinline__ void small_gemm16_f8t(const unsigned char* arow, const unsigned char* const (&brow)[NACC], f32x4 (&acc)[NACC], const int lane) {
    typedef long long2_t __attribute__((ext_vector_type(2)));
    constexpr int NSW = K / 128, NPRE = PF < NSW ? PF : NSW;
    const int ko = 32 * (lane >> 4);
    long2_t A[PF][2], B[PF][NACC][2];
#pragma unroll
    for (int n = 0; n < NACC; ++n) acc[n] = (f32x4){0.f, 0.f, 0.f, 0.f};
#define SG_LOAD(buf_, s_) do { _Pragma("unroll") for (int s2 = 0; s2 < 2; ++s2) { A[buf_][s2] = *(const long2_t*)(arow + ko + (s_) * 128 + 16 * s2); \
        _Pragma("unroll") for (int n = 0; n < NACC; ++n) B[buf_][n][s2] = *(const long2_t*)(brow[n] + ko + (s_) * 128 + 16 * s2); } } while (0)
#pragma unroll
    for (int s = 0; s < NPRE; ++s) SG_LOAD(s, s);
#pragma unroll
    for (int s = 0; s < NSW; ++s) {
#pragma unroll
        for (int s2 = 0; s2 < 2; ++s2)
#pragma unroll
            for (int h = 0; h < 2; ++h)
#pragma unroll
                for (int n = 0; n < NACC; ++n) acc[n] = __builtin_amdgcn_mfma_f32_16x16x32_fp8_fp8(B[s % PF][n][s2][h], A[s % PF][s2][h], acc[n], 0, 0, 0);
        if (s + PF < NSW) SG_LOAD(s % PF, s + PF);
    }
#undef SG_LOAD
}

struct Args { const float* in[21]; float* out; unsigned char* ws; int ph_lo, ph_hi; };
enum { I_X = 0, I_META, I_NORM1, I_WIN, I_QNW, I_KNW, I_ANW, I_HLB, I_HNW, I_CONVW, I_CONVB, I_DTB, I_ALOG, I_DSKIP, I_SNW, I_WOUT, I_NORM2, I_ROUTER, I_WGATE, I_WUP, I_WDOWN };

struct Ctx {
    const Args* a; unsigned char* ws; LAS char* smem; int tid, lane, wid, G, bid, wbuf;
#define CTX_PTR(name, type, off) __device__ __forceinline__ type* name() const { return (type*)(ws + (off)); }
    CTX_PTR(H, bf16_t, WS_H) CTX_PTR(U, bf16_t, WS_U) CTX_PTR(DT, float, WS_DT) CTX_PTR(AFFT, float, WS_AFFT) CTX_PTR(SEL, int, WS_SEL) CTX_PTR(RIDX, int, WS_RIDX) CTX_PTR(GATE, float, WS_GATE) CTX_PTR(IDT, int, WS_IDT)
    CTX_PTR(XBC, bf16_t, WS_XBC) CTX_PTR(ATT, bf16_t, WS_ATT) CTX_PTR(OF, bf16_t, WS_OF) CTX_PTR(OB, bf16_t, WS_OB) CTX_PTR(YF, bf16_t, WS_YF) CTX_PTR(YB, bf16_t, WS_YB)
    CTX_PTR(MIX, bf16_t, WS_MIX) CTX_PTR(PROJ, bf16_t, WS_PROJ) CTX_PTR(ACT, unsigned char, WS_ACT) CTX_PTR(U8, unsigned char, WS_U) CTX_PTR(Y, unsigned char, WS_Y)
    CTX_PTR(WIN, bf16_t, WS_WIN + (size_t)wbuf * WS_WSTRIDE) CTX_PTR(WOUT, bf16_t, WS_WOUT + (size_t)wbuf * WS_WSTRIDE) CTX_PTR(WGU, unsigned char, WS_WGU + (size_t)wbuf * WS_WSTRIDE) CTX_PTR(WD, unsigned char, WS_WD + (size_t)wbuf * WS_WSTRIDE) CTX_PTR(ROPE, float, WS_ROPE) CTX_PTR(LB, float, WS_LB)
#undef CTX_PTR
};

__device__ __forceinline__ int og(int v) { v = __builtin_amdgcn_readfirstlane(v); asm volatile("" : "+s"(v)); return v; }
__device__ __forceinline__ Ctx fresh(const Ctx& c0) {
    Ctx c = c0; int w_ = __builtin_amdgcn_readfirstlane(c0.wid), g_ = __builtin_amdgcn_readfirstlane(c0.G), b_ = __builtin_amdgcn_readfirstlane(c0.bid); unsigned z_ = 0u; asm volatile("" : "+s"(w_), "+s"(g_), "+s"(b_), "+s"(z_)); c.wid = w_; c.G = g_; c.bid = b_;
    c.lane = (int)__builtin_amdgcn_mbcnt_hi(~0u, __builtin_amdgcn_mbcnt_lo(~0u, z_)); c.tid = w_ * 64 + c.lane;
    const unsigned long long wv_ = (unsigned long long)c0.ws; unsigned wl_ = __builtin_amdgcn_readfirstlane((unsigned)wv_), wh_ = __builtin_amdgcn_readfirstlane((unsigned)(wv_ >> 32)); asm volatile("" : "+s"(wl_), "+s"(wh_));
    c.ws = (unsigned char*)(((unsigned long long)wh_ << 32) | wl_); return c;
}
__device__ __forceinline__ void phase_tables(const Ctx& c0) {
    const Ctx c = fresh(c0);
    const int gt = c.bid * 512 + c.tid, gs = c.G * 512;
    for (int idx = gt; idx < 4096 * 32; idx += gs) {
        const int tok = idx >> 5, i = idx & 31;
        const float pos = (float)((i < 16) ? (tok >> 6) : (tok & 63));
        const float inv = powf(10000.0f, -(float)(i & 15) / 16.0f);
        const float ang = pos * inv;
        c.ROPE()[idx] = cosf(ang); c.ROPE()[4096 * 32 + idx] = sinf(ang);
    }
    for (int idx = gt; idx < 2 * 512; idx += gs) {
        const int dir = idx >> 9, d = idx & 511;
        const float* lbp = c.a->in[I_HLB] + (size_t)dir * DEPTH * 512 + d;
        float v[DEPTH], mx = -INFINITY;
        for (int l = 0; l < DEPTH; ++l) { v[l] = lbp[l * 512]; mx = fmaxf(mx, v[l]); }
        float s = 0.f; for (int l = 0; l < DEPTH; ++l) { v[l] = expf(v[l] - mx); s += v[l]; }
        float cum = 0.f;
        for (int l = 0; l < DEPTH; ++l) { const float p = v[l] / s; cum += p; const float lb = fminf(fmaxf(cum - v[0] / s, 0.f), 1.f); c.LB()[(dir * DEPTH + l) * 512 + d] = lb; }
    }
    for (int idx = gt; idx < MOE_ROWS; idx += gs) c.IDT()[idx] = idx;
    for (int idx = gt; idx < NEXP * (EROWS - NB * CAP); idx += gs) { const int e = idx / (EROWS - NB * CAP), r = idx % (EROWS - NB * CAP); c.RIDX()[e * EROWS + NB * CAP + r] = 0; }
}

__device__ __forceinline__ void convert_tile(const Ctx& c, const float* src, int ld_src, int k0, int n0, bf16_t* dst, int ld_dst, int nrow0, LAS float* T) {
    const int tid = c.tid;
    __syncthreads();
#pragma unroll
    for (int i = 0; i < 2; ++i) { const int k = (tid >> 4) + 32 * i, n4 = (tid & 15) * 4; const f32x4 v = *(const f32x4*)(src + (size_t)(k0 + k) * ld_src + n0 + n4);
        T[k * 65 + n4 + 0] = v[0]; T[k * 65 + n4 + 1] = v[1]; T[k * 65 + n4 + 2] = v[2]; T[k * 65 + n4 + 3] = v[3]; }
    __syncthreads();
    { const int n = tid >> 3, k8 = (tid & 7) * 8; float r[8];
#pragma unroll
      for (int j = 0; j < 8; ++j) r[j] = T[(k8 + j) * 65 + n];
      u32x4 w; w.x = cvt_pk_bf16(r[0], r[1]); w.y = cvt_pk_bf16(r[2], r[3]); w.z = cvt_pk_bf16(r[4], r[5]); w.w = cvt_pk_bf16(r[6], r[7]);
      *(u32x4*)(dst + (size_t)(nrow0 + n) * ld_dst + k0 + k8) = w; }
}
__device__ __forceinline__ void convert_tile_f8(const Ctx& c, const float* src, int ld_src, int k0, int n0, unsigned char* dst, int ld_dst, int nrow0, LAS float* T) {
    const int tid = c.tid;
    __syncthreads();
#pragma unroll
    for (int i = 0; i < 2; ++i) { const int k = (tid >> 4) + 32 * i, n4 = (tid & 15) * 4; const f32x4 v = *(const f32x4*)(src + (size_t)(k0 + k) * ld_src + n0 + n4);
        T[k * 65 + n4 + 0] = v[0]; T[k * 65 + n4 + 1] = v[1]; T[k * 65 + n4 + 2] = v[2]; T[k * 65 + n4 + 3] = v[3]; }
    __syncthreads();
    { const int n = tid >> 3, k8 = (tid & 7) * 8; float r[8];
#pragma unroll
      for (int j = 0; j < 8; ++j) r[j] = 32.0f * T[(k8 + j) * 65 + n];
      u32x2 w; w.x = pk4_fp8(r[0], r[1], r[2], r[3]); w.y = pk4_fp8(r[4], r[5], r[6], r[7]);
      *(u32x2*)(dst + (size_t)(nrow0 + n) * ld_dst + k0 + k8) = w; }
}
struct CvtTile { const float* src; int ld_src, k0, n0; unsigned char* dst; int ld_dst, nrow0; bool f8; };
__device__ __forceinline__ CvtTile cvt_tile_desc(const Ctx& c, int layer, int t) {
    constexpr int T_IN = 16 * 72, T_OUT = 24 * 16, T_G = 16 * 16 * 32;
    CvtTile d;
    if (t < T_IN) { const int kt = t % 16, ntl = t / 16; d.src = c.a->in[I_WIN] + (size_t)layer * DM * INW; d.ld_src = INW; d.k0 = kt * 64; d.n0 = ntl * 64; d.dst = (unsigned char*)c.WIN(); d.ld_dst = DM; d.nrow0 = ntl * 64; d.f8 = false; }
    else if (t < T_IN + T_OUT) { const int u = t - T_IN, kt = u % 24, ntl = u / 24; d.src = c.a->in[I_WOUT] + (size_t)layer * MIXW * DM; d.ld_src = DM; d.k0 = kt * 64; d.n0 = ntl * 64; d.dst = (unsigned char*)c.WOUT(); d.ld_dst = MIXW; d.nrow0 = ntl * 64; d.f8 = false; }
    else if (t < T_IN + T_OUT + 2 * T_G) { int u = t - T_IN - T_OUT; const int which = u / T_G; u %= T_G; const int e = u / 512, r = u % 512, kt = r % 16, ntl = r / 16;
        const int f0 = ntl * 64, pn = f0 >> 7, j0 = f0 & 127;
        d.src = c.a->in[which ? I_WUP : I_WGATE] + ((size_t)layer * NEXP + e) * DM * FF; d.ld_src = FF; d.k0 = kt * 64; d.n0 = f0; d.dst = c.WGU() + (size_t)e * 4096 * DM; d.ld_dst = DM; d.nrow0 = pn * 256 + which * 128 + j0; d.f8 = true; }
    else { const int u = t - T_IN - T_OUT - 2 * T_G; const int e = u / 512, r = u % 512, kt = r % 32, ntl = r / 32;
        d.src = c.a->in[I_WDOWN] + ((size_t)layer * NEXP + e) * FF * DM; d.ld_src = DM; d.k0 = kt * 64; d.n0 = ntl * 64; d.dst = c.WD() + (size_t)e * DM * FF; d.ld_dst = FF; d.nrow0 = ntl * 64; d.f8 = true; }
    return d;
}
constexpr int CVT_TILES = 16 * 72 + 24 * 16 + 2 * 16 * 16 * 32 + 16 * 32 * 16, CVT_GROUPS = CVT_TILES / 4;
__device__ __forceinline__ void convert_pull(const Ctx& c0, int layer, LAS float* T) {
    const Ctx c = fresh(c0);
    unsigned* ctr = (unsigned*)(c.ws + WS_CTL) + 36864 + 64 * layer;
    volatile LAS unsigned* qw = (volatile LAS unsigned*)(c.smem + LDS_MISC + 96);
    const int tid = c.tid;
    for (;;) {
        __syncthreads();
        if (tid == 0) qw[0] = __hip_atomic_fetch_add(ctr, 1u, __ATOMIC_RELAXED, __HIP_MEMORY_SCOPE_AGENT);
        __syncthreads();
        const int gid = __builtin_amdgcn_readfirstlane((int)qw[0]);
        if (gid >= CVT_GROUPS) break;
        f32x4 v[4][2];
#pragma unroll
        for (int q = 0; q < 4; ++q) { const CvtTile d = cvt_tile_desc(c, layer, 4 * gid + q);
#pragma unroll
            for (int i = 0; i < 2; ++i) { const int k = (tid >> 4) + 32 * i, n4 = (tid & 15) * 4; v[q][i] = *(const f32x4*)(d.src + (size_t)(d.k0 + k) * d.ld_src + d.n0 + n4); } }
#pragma unroll
        for (int q = 0; q < 4; ++q) { LAS float* Tq = T + q * (64 * 65);
#pragma unroll
            for (int i = 0; i < 2; ++i) { const int k = (tid >> 4) + 32 * i, n4 = (tid & 15) * 4;
                Tq[k * 65 + n4 + 0] = v[q][i][0]; Tq[k * 65 + n4 + 1] = v[q][i][1]; Tq[k * 65 + n4 + 2] = v[q][i][2]; Tq[k * 65 + n4 + 3] = v[q][i][3]; } }
        __syncthreads();
#pragma unroll
        for (int q = 0; q < 4; ++q) { const CvtTile d = cvt_tile_desc(c, layer, 4 * gid + q); LAS float* Tq = T + q * (64 * 65);
            const int n = tid >> 3, k8 = (tid & 7) * 8; float r[8];
#pragma unroll
            for (int j = 0; j < 8; ++j) r[j] = Tq[(k8 + j) * 65 + n];
            if (d.f8) { u32x2 w; w.x = pk4_fp8(32.0f * r[0], 32.0f * r[1], 32.0f * r[2], 32.0f * r[3]); w.y = pk4_fp8(32.0f * r[4], 32.0f * r[5], 32.0f * r[6], 32.0f * r[7]);
                *(u32x2*)(d.dst + (size_t)(d.nrow0 + n) * d.ld_dst + d.k0 + k8) = w; }
            else { u32x4 w; w.x = cvt_pk_bf16(r[0], r[1]); w.y = cvt_pk_bf16(r[2], r[3]); w.z = cvt_pk_bf16(r[4], r[5]); w.w = cvt_pk_bf16(r[6], r[7]);
                *(u32x4*)((bf16_t*)d.dst + (size_t)(d.nrow0 + n) * d.ld_dst + d.k0 + k8) = w; } }
    }
}

template <bool ROUTER>
__device__ __forceinline__ void phase_norm(const Ctx& c0, int layer) {
    const Ctx c = fresh(c0);
    LAS float* W16 = (LAS float*)c.smem;
    if (ROUTER) { const float* src = c.a->in[I_ROUTER] + (size_t)layer * DM * NEXP; for (int i = c.tid; i < DM * 16; i += 512) W16[(i & 15) * DM + (i >> 4)] = src[i]; }
    else { const float* src = c.a->in[I_WIN] + (size_t)layer * DM * INW + C_DT; for (int i = c.tid; i < DM * 16; i += 512) W16[(i & 15) * DM + (i >> 4)] = src[(size_t)(i >> 4) * INW + (i & 15)]; }
    __syncthreads();
    const float* wn = c.a->in[ROUTER ? I_NORM2 : I_NORM1] + (size_t)layer * DM;
    const int lane = c.lane;
    f32x4 wv[4];
#pragma unroll
    for (int i = 0; i < 4; ++i) wv[i] = *(const f32x4*)(wn + 4 * lane + 256 * i);
    constexpr int NR = 4;
    static_assert(NR == 4, "the combine's hit masks are written out for 4 rows");
    for (int r0 = (c.bid * 8 + c.wid) * NR; r0 < ROWS; r0 += c.G * 8 * NR) {
        f32x4 v[NR][4];
#pragma unroll
        for (int q = 0; q < NR; ++q) { const int row = r0 + q;
            if (!ROUTER && layer == 0) { const float* src = row < ROWS_REAL ? c.a->in[I_X] + (size_t)row * DM : c.a->in[I_META] + (size_t)((row - ROWS_REAL) & 15) * DM;
#pragma unroll
                for (int i = 0; i < 4; ++i) v[q][i] = *(const f32x4*)(src + 4 * lane + 256 * i); }
            else {
#pragma unroll
                for (int i = 0; i < 4; ++i) { const u32x2 w = *(const u32x2*)(c.H() + (size_t)row * DM + 4 * lane + 256 * i); v[q][i] = (f32x4){bflo(w.x), bfhi(w.x), bflo(w.y), bfhi(w.y)}; } } }
        if (!ROUTER && layer > 0) {
            int sv[NR]; unsigned hm[NR];
#pragma unroll
            for (int q = 0; q < NR; ++q) sv[q] = lane < 16 ? c.SEL()[(r0 + q) * 16 + lane] : -1;
#pragma unroll
            for (int q = 0; q < NR; ++q) hm[q] = (unsigned)__builtin_amdgcn_ballot_w64(sv[q] >= 0);
            while ((hm[0] | hm[1] | hm[2] | hm[3]) != 0u) {
                int wd[NR][2][4]; bool has[NR][2];
#pragma unroll
                for (int q = 0; q < NR; ++q)
#pragma unroll
                    for (int j = 0; j < 2; ++j) { has[q][j] = hm[q] != 0u; const int e = has[q][j] ? __builtin_ctz(hm[q]) : 0; hm[q] &= hm[q] - 1u;
                        const int se = has[q][j] ? __builtin_amdgcn_readlane(sv[q], e) : 0;
                        const unsigned char* yp = c.Y() + (size_t)se * DM + 4 * lane;
#pragma unroll
                        for (int i = 0; i < 4; ++i) wd[q][j][i] = *(const int*)(yp + 256 * i); }
#pragma unroll
                for (int q = 0; q < NR; ++q)
#pragma unroll
                    for (int j = 0; j < 2; ++j) if (has[q][j]) {
#pragma unroll
                        for (int i = 0; i < 4; ++i) { const int w = wd[q][j][i]; const f32x2 lo = __builtin_amdgcn_cvt_pk_f32_fp8(w, false), hi_ = __builtin_amdgcn_cvt_pk_f32_fp8(w, true);
                            v[q][i][0] += lo[0] * 0.0625f; v[q][i][1] += lo[1] * 0.0625f; v[q][i][2] += hi_[0] * 0.0625f; v[q][i][3] += hi_[1] * 0.0625f; } }
            }
        }
        float rstd[NR];
#pragma unroll
        for (int q = 0; q < NR; ++q) {
            if (!ROUTER) {
#pragma unroll
                for (int i = 0; i < 4; ++i) { u32x2 w; w.x = cvt_pk_bf16(v[q][i][0], v[q][i][1]); w.y = cvt_pk_bf16(v[q][i][2], v[q][i][3]); *(u32x2*)(c.H() + (size_t)(r0 + q) * DM + 4 * lane + 256 * i) = w;
                    v[q][i] = (f32x4){bflo(w.x), bfhi(w.x), bflo(w.y), bfhi(w.y)}; } }
            float ss = 0.f;
#pragma unroll
            for (int i = 0; i < 4; ++i) ss += v[q][i][0] * v[q][i][0] + v[q][i][1] * v[q][i][1] + v[q][i][2] * v[q][i][2] + v[q][i][3] * v[q][i][3];
            rstd[q] = rsqrtf(wave_sum(ss, lane) * (1.0f / DM) + EPS); }
        float acc[NR][16];
#pragma unroll
        for (int q = 0; q < NR; ++q)
#pragma unroll
            for (int j = 0; j < 16; ++j) acc[q][j] = 0.f;
#pragma unroll
        for (int i = 0; i < 4; ++i) { f32x4 un[NR];
#pragma unroll
            for (int q = 0; q < NR; ++q) { un[q] = v[q][i] * rstd[q] * wv[i];
                if (ROUTER) *(unsigned*)(c.U8() + (size_t)(r0 + q) * DM + 4 * lane + 256 * i) = pk4_fp8(un[q][0], un[q][1], un[q][2], un[q][3]);
                else { u32x2 pk; pk.x = cvt_pk_bf16(un[q][0], un[q][1]); pk.y = cvt_pk_bf16(un[q][2], un[q][3]); *(u32x2*)(c.U() + (size_t)(r0 + q) * DM + 4 * lane + 256 * i) = pk; } }
#pragma unroll
            for (int j = 0; j < 16; ++j) { const f32x4 ww = *(const LAS f32x4*)(W16 + j * DM + 4 * lane + 256 * i);
#pragma unroll
                for (int q = 0; q < NR; ++q) acc[q][j] += un[q][0] * ww[0] + un[q][1] * ww[1] + un[q][2] * ww[2] + un[q][3] * ww[3]; } }
        float red[NR];
#pragma unroll
        for (int q = 0; q < NR; ++q) {
            float r8[8], r4[4], r2[2];
            { const bool up = (lane & 32) != 0;
#pragma unroll
              for (int j = 0; j < 8; ++j) { const float keep = up ? acc[q][8 + j] : acc[q][j], send = up ? acc[q][j] : acc[q][8 + j]; r8[j] = keep + shx(send, 32, lane); } }
            { const bool up = (lane & 16) != 0;
#pragma unroll
              for (int j = 0; j < 4; ++j) { const float keep = up ? r8[4 + j] : r8[j], send = up ? r8[j] : r8[4 + j]; r4[j] = keep + shx(send, 16, lane); } }
            { const bool up = (lane & 8) != 0;
#pragma unroll
              for (int j = 0; j < 2; ++j) { const float keep = up ? r4[2 + j] : r4[j], send = up ? r4[j] : r4[2 + j]; r2[j] = keep + shx(send, 8, lane); } }
            { const bool up = (lane & 4) != 0; const float keep = up ? r2[1] : r2[0], send = up ? r2[0] : r2[1]; float x = keep + shx(send, 4, lane); x += shx(x, 2, lane); x += shx(x, 1, lane); red[q] = x; }
        }
        const int oidx = ((lane >> 5) & 1) * 8 + ((lane >> 4) & 1) * 4 + ((lane >> 3) & 1) * 2 + ((lane >> 2) & 1);
        if (!ROUTER) {
#pragma unroll
            for (int q = 0; q < NR; ++q) if ((lane & 3) == 0) c.DT()[(r0 + q) * 16 + oidx] = red[q]; }
        else {
            float pr[NR];
#pragma unroll
            for (int q = 0; q < NR; ++q) {
                float mx = red[q];
#pragma unroll
                for (int o = 4; o < 64; o <<= 1) mx = fmaxf(mx, shx(mx, o, lane));
                const float ex = __expf(red[q] - mx); float s_ = ex;
#pragma unroll
                for (int o = 4; o < 64; o <<= 1) s_ += shx(s_, o, lane);
                pr[q] = ex / s_; }
            int b, t; if (r0 < ROWS_REAL) { b = r0 >> 12; t = (r0 & 4095) + NMETA; } else { b = (r0 - ROWS_REAL) >> 4; t = (r0 - ROWS_REAL) & 15; }
            static_assert(NR == 4, "vector AFFT store");
            if ((lane & 3) == 0) *(f32x4*)(c.AFFT() + (size_t)(b * 16 + oidx) * LTOK + t) = (f32x4){pr[0], pr[1], pr[2], pr[3]};
        }
    }
}

__device__ __forceinline__ void phase_prep(const Ctx& c0, int layer) {
    const Ctx c = fresh(c0);
    const int lane = c.lane;
    {
        const float* qw = c.a->in[I_QNW] + layer * 64; const float* kw = c.a->in[I_KNW] + layer * 64;
        const int d0 = 8 * (lane & 7);
        float qn[8], kn[8];
#pragma unroll
        for (int j = 0; j < 8; ++j) { qn[j] = qw[d0 + j]; kn[j] = kw[d0 + j]; }
        for (int rb = (c.bid * 8 + c.wid) * 4; rb < ROWS; rb += c.G * 32) {
            u32x4 wq[4], wk[4]; f32x4 cs[4][2], sn[4][2]; bool rot[4];
#pragma unroll
            for (int j = 0; j < 4; ++j) { const int row = rb + j; bf16_t* prow = c.PROJ() + (size_t)row * PROJW;
                wq[j] = *(const u32x4*)(prow + C_AQ + 8 * lane); wk[j] = lane < 16 ? *(const u32x4*)(prow + C_AK + 8 * lane) : (u32x4){0u, 0u, 0u, 0u};
                rot[j] = row < ROWS_REAL; const int tok = rot[j] ? (row & 4095) : 0;
                const float* cp = c.ROPE() + (size_t)tok * 32 + (d0 & 31); const float* sp = cp + 4096 * 32;
                cs[j][0] = *(const f32x4*)cp; cs[j][1] = *(const f32x4*)(cp + 4); sn[j][0] = *(const f32x4*)sp; sn[j][1] = *(const f32x4*)(sp + 4); }
#pragma unroll
            for (int j = 0; j < 4; ++j) { bf16_t* prow = c.PROJ() + (size_t)(rb + j) * PROJW;
#pragma unroll
                for (int pass = 0; pass < 2; ++pass) { const u32x4 w = pass ? wk[j] : wq[j];
                    float x[8] = {bflo(w.x), bfhi(w.x), bflo(w.y), bfhi(w.y), bflo(w.z), bfhi(w.z), bflo(w.w), bfhi(w.w)};
                    float ss = 0.f;
#pragma unroll
                    for (int q = 0; q < 8; ++q) ss += x[q] * x[q];
                    ss += shx(ss, 1, lane); ss += shx(ss, 2, lane); ss += shx(ss, 4, lane);
                    const float rstd = rsqrtf(ss * (1.0f / 64.0f) + EPS) ;
                    float xn[8], xp[8], o[8];
#pragma unroll
                    for (int q = 0; q < 8; ++q) xn[q] = x[q] * rstd * (pass ? kn[q] : qn[q]);
#pragma unroll
                    for (int q = 0; q < 8; ++q) xp[q] = shx(xn[q], 4, lane);
#pragma unroll
                    for (int q = 0; q < 8; ++q) { const float cc = rot[j] ? cs[j][q >> 2][q & 3] : 1.0f, s_ = rot[j] ? sn[j][q >> 2][q & 3] : 0.0f;
                        o[q] = (d0 < 32) ? (xn[q] * cc - xp[q] * s_) : (xp[q] * s_ + xn[q] * cc); }
                    const float sc = pass ? 1.0f : QSCALE;
                    u32x4 wo; wo.x = cvt_pk_bf16(o[0] * sc, o[1] * sc); wo.y = cvt_pk_bf16(o[2] * sc, o[3] * sc); wo.z = cvt_pk_bf16(o[4] * sc, o[5] * sc); wo.w = cvt_pk_bf16(o[6] * sc, o[7] * sc);
                    if (pass == 0) *(u32x4*)(prow + C_AQ + 8 * lane) = wo; else if (lane < 16) *(u32x4*)(prow + C_AK + 8 * lane) = wo; } }
        }
    }
    {
        const float* cw = c.a->in[I_CONVW] + (size_t)layer * 768 * 7; const float* cb = c.a->in[I_CONVB] + (size_t)layer * 768;
        auto conv_pass = [&](const u32x2 (&win)[22], int b, int t0, int ch) {
            f32x4 wv[7]; const f32x4 bs = *(const f32x4*)(cb + ch);
#pragma unroll
            for (int q = 0; q < 7; ++q) wv[q] = *(const f32x4*)(cw + ch * 7 + 4 * q);
#pragma unroll
            for (int r = 0; r < 16; ++r) { float a0 = bs[0], a1 = bs[1], a2 = bs[2], a3 = bs[3];
#pragma unroll
                for (int tp = 0; tp < 7; ++tp) { const u32x2 x = win[r + tp];
                    a0 += wv[(0 * 7 + tp) >> 2][(0 * 7 + tp) & 3] * bflo(x.x); a1 += wv[(1 * 7 + tp) >> 2][(1 * 7 + tp) & 3] * bfhi(x.x); a2 += wv[(2 * 7 + tp) >> 2][(2 * 7 + tp) & 3] * bflo(x.y); a3 += wv[(3 * 7 + tp) >> 2][(3 * 7 + tp) & 3] * bfhi(x.y); }
                u32x2 o; o.x = cvt_pk_bf16(silu_f(a0), silu_f(a1)); o.y = cvt_pk_bf16(silu_f(a2), silu_f(a3));
                *(u32x2*)(c.XBC() + (size_t)row_of(b, t0 + r) * 768 + ch) = o; } };
        for (int task = c.bid * 8 + c.wid; task < NB * 256; task += c.G * 8) {
            const int b = task >> 8, t0 = NMETA + 16 * (task & 255);
            u32x2 win[3][22];
#pragma unroll
            for (int i = 0; i < 3; ++i)
#pragma unroll
                for (int r = 0; r < 22; ++r) { const int tt = t0 - 3 + r;
                    win[i][r] = (tt < LTOK) ? *(const u32x2*)(c.PROJ() + (size_t)row_of(b, tt) * PROJW + C_XBC + 4 * lane + 256 * i) : (u32x2){0u, 0u}; }
#pragma unroll
            for (int i = 0; i < 3; ++i) conv_pass(win[i], b, t0, 4 * lane + 256 * i);
        }
        for (int task = c.G * 8 - 1 - (c.bid * 8 + c.wid); task < NB * 3; task += c.G * 8) {
            const int b = task / 3, i = task % 3;
            u32x2 win[22];
#pragma unroll
            for (int r = 0; r < 22; ++r) { const int tt = r - 3;
                win[r] = (tt >= 0) ? *(const u32x2*)(c.PROJ() + (size_t)row_of(b, tt) * PROJW + C_XBC + 4 * lane + 256 * i) : (u32x2){0u, 0u}; }
            conv_pass(win, b, 0, 4 * lane + 256 * i);
        }
    }
}

namespace att {
using bf16=unsigned short;
using bf16x8=__attribute__((ext_vector_type(8)))short;
using s16x4=__attribute__((ext_vector_type(4)))short;
using f32x16=__attribute__((ext_vector_type(16)))float;
using u32x4=__attribute__((ext_vector_type(4)))unsigned;
constexpr int NW=8,QBLK=32,KVBLK=64,NT=65;
__device__ __forceinline__ int crow(int r,int hi){return (r&3)+8*(r>>2)+4*hi;}
#define SBAR() __builtin_amdgcn_sched_barrier(0)
__device__ __forceinline__ void tmask(f32x16&p0,f32x16&p1){
  const float NEG=-INFINITY;
  #pragma unroll
  for(int r=0;r<16;++r){ if(r>=8)p0[r]=NEG; p1[r]=NEG; }
}

constexpr int NSLOT=3, SLOTB=8192;
constexpr int LDS_K=0, LDS_V=NSLOT*SLOTB, LDS_WS=2*NSLOT*SLOTB, LDS_OST=LDS_WS+NW*64*4, LDS_BYTES=LDS_OST+NW*4096;
constexpr float C2=0.125f*1.4426950408889634f;
__device__ __forceinline__ void glds16(const void*sbase,unsigned voff,unsigned lds_dst){unsigned keep;
  asm volatile("s_mov_b32 %0, m0\n\ts_mov_b32 m0, %3\n\ts_nop 0\n\tglobal_load_lds_dwordx4 %1, %2\n\ts_mov_b32 m0, %0":"=&s"(keep):"v"(voff),"s"(sbase),"s"(lds_dst):"memory");}
__device__ __forceinline__ float max3f(float a,float b,float c){float r;asm("v_max3_f32 %0, %1, %2, %3":"=v"(r):"v"(a),"v"(b),"v"(c));return r;}
__device__ __forceinline__ float max2f(float a,float b){float r;asm("v_max_f32_e32 %0, %1, %2":"=v"(r):"v"(a),"v"(b));return r;}
__device__ __forceinline__ float fadd_s(float a,float b){float r;asm("v_add_f32_e32 %0, %1, %2":"=v"(r):"v"(a),"v"(b));return r;}
__device__ __forceinline__ float fsub_s(float a,float b){float r;asm("v_sub_f32_e32 %0, %1, %2":"=v"(r):"v"(a),"v"(b));return r;}
typedef float f32x2_t __attribute__((ext_vector_type(2))); typedef __bf16 bf16x2_t __attribute__((ext_vector_type(2)));
__device__ __forceinline__ unsigned cvtpk_s(float lo,float hi){f32x2_t v={lo,hi};bf16x2_t b=__builtin_convertvector(v,bf16x2_t);return __builtin_bit_cast(unsigned,b);}
#define WAIT_BAR(N) asm volatile("s_waitcnt vmcnt(" #N ") lgkmcnt(0)\n\ts_barrier":::"memory")

__device__ __forceinline__ void qkt(f32x16&p0,f32x16&p1,const char*Kslot,const bf16x8*qr,const f32x16&negm,int r32,int hi){
  const char*kb=Kslot+hi*1024+r32*16;
  #pragma unroll
  for(int d0=0;d0<4;++d0){
    const bf16x8 b0=*reinterpret_cast<const bf16x8*>(kb+d0*2048);
    const bf16x8 b1=*reinterpret_cast<const bf16x8*>(kb+d0*2048+512);
    if(d0==0){p0=__builtin_amdgcn_mfma_f32_32x32x16_bf16(b0,qr[0],negm,0,0,0);p1=__builtin_amdgcn_mfma_f32_32x32x16_bf16(b1,qr[0],negm,0,0,0);}
    else{p0=__builtin_amdgcn_mfma_f32_32x32x16_bf16(b0,qr[d0],p0,0,0,0);p1=__builtin_amdgcn_mfma_f32_32x32x16_bf16(b1,qr[d0],p1,0,0,0);}}
}
typedef __attribute__((address_space(3))) const char* lds_cptr;
typedef short v4i16_t __attribute__((ext_vector_type(4)));
__device__ __forceinline__ void kload8(bf16x8*kf,lds_cptr kp){
  kf[0]=*(const __attribute__((address_space(3))) bf16x8*)(kp);      kf[1]=*(const __attribute__((address_space(3))) bf16x8*)(kp+512);
  kf[2]=*(const __attribute__((address_space(3))) bf16x8*)(kp+2048); kf[3]=*(const __attribute__((address_space(3))) bf16x8*)(kp+2560);
  kf[4]=*(const __attribute__((address_space(3))) bf16x8*)(kp+4096); kf[5]=*(const __attribute__((address_space(3))) bf16x8*)(kp+4608);
  kf[6]=*(const __attribute__((address_space(3))) bf16x8*)(kp+6144); kf[7]=*(const __attribute__((address_space(3))) bf16x8*)(kp+6656);
}
__device__ __forceinline__ void kload2(bf16x8*kf,lds_cptr kp,int j){ kf[2*j]=*(const __attribute__((address_space(3))) bf16x8*)(kp+j*2048); kf[2*j+1]=*(const __attribute__((address_space(3))) bf16x8*)(kp+j*2048+512); }
__device__ __forceinline__ s16x4 vtr(lds_cptr p){ return __builtin_bit_cast(s16x4,__builtin_amdgcn_ds_read_tr16_b64_v4i16((__attribute__((address_space(3))) v4i16_t*)p)); }
__device__ __forceinline__ float rowmax(const f32x16&p0,const f32x16&p1){
  float a=max3f(p0[0],p0[1],p1[0]),b=max3f(p0[2],p0[3],p1[1]);a=max3f(a,p1[2],p1[3]);
  #pragma unroll
  for(int r=4;r<16;r+=4){a=max3f(a,p0[r],p0[r+1]);b=max3f(b,p0[r+2],p0[r+3]);a=max3f(a,p1[r],p1[r+1]);b=max3f(b,p1[r+2],p1[r+3]);}
  const float m=max2f(a,b);
  auto rr=__builtin_amdgcn_permlane32_swap(__float_as_uint(m),__float_as_uint(m),false,false);
  return max2f(__uint_as_float(rr[0]),__uint_as_float(rr[1]));
}
__device__ __forceinline__ void pv(f32x16*o,int vb,bf16x8 pa0,bf16x8 pa1,bf16x8 pa2,bf16x8 pa3){
  #pragma unroll
  for(int d0=0;d0<2;++d0){s16x4 lo[4],hi[4];
    #pragma unroll
    for(int ks=0;ks<4;++ks){
      asm volatile("ds_read_b64_tr_b16 %0,%1 offset:%c2":"=&v"(lo[ks]):"v"(vb),"i"(d0*4096+ks*1024):"memory");
      asm volatile("ds_read_b64_tr_b16 %0,%1 offset:%c2":"=&v"(hi[ks]):"v"(vb),"i"(d0*4096+ks*1024+512):"memory");}
    asm volatile("s_waitcnt lgkmcnt(0)":::"memory");SBAR();
    #define PK(k) (bf16x8){lo[k][0],lo[k][1],lo[k][2],lo[k][3],hi[k][0],hi[k][1],hi[k][2],hi[k][3]}
    o[d0]=__builtin_amdgcn_mfma_f32_32x32x16_bf16(pa0,PK(0),o[d0],0,0,0);
    o[d0]=__builtin_amdgcn_mfma_f32_32x32x16_bf16(pa1,PK(1),o[d0],0,0,0);
    o[d0]=__builtin_amdgcn_mfma_f32_32x32x16_bf16(pa2,PK(2),o[d0],0,0,0);
    o[d0]=__builtin_amdgcn_mfma_f32_32x32x16_bf16(pa3,PK(3),o[d0],0,0,0);
    #undef PK
  }
}

#ifndef ATTN_STORE16
#define ATTN_STORE16(p,v) (*(u32x4*)(p)=(v))
#endif
template<int THRL> __device__ __forceinline__ void attn_unit(int b,int g,int qb,const bf16*P,bf16*O,char*shm,int wid,int lane){
  constexpr int DM=PROJW;
  const int r32=lane&31,hi=lane>>5;
  const bool meta=(qb==64);
  const int head=4*g+(wid>>1);
  const long qrow0=meta?(long)(ROWS_REAL+b*NMETA):(long)b*SEQ+qb*64+(wid&1)*32;
  const long rowbase=(long)b*SEQ; const long metaoff=((long)(ROWS_REAL+b*NMETA)-rowbase)*DM;
  const bf16*Qw=P+qrow0*DM+C_AQ+head*64;
  const bf16*Kh=P+rowbase*DM+C_AK+g*64,*Vh=P+rowbase*DM+C_AV+g*64;
  const unsigned lds0=(unsigned)(uintptr_t)shm;
  float*wsf=(float*)(shm+LDS_WS)+wid*64;
  const unsigned ksrc=(unsigned)(lane*DM+wid*8)*2u;
  const unsigned vsrc=(unsigned)((16*(wid&3)+(lane>>2))*DM+(wid>>2)*32+(lane&3)*8)*2u;
  const unsigned kdst=lds0+LDS_K+wid*1024, vdst=lds0+LDS_V+wid*1024;
  #define TOFF(t) (((t)<NT-1)?(long)(t)*KVBLK*DM:metaoff)
  #define DMA_K(t,slot) glds16(Kh+TOFF(t),ksrc,(unsigned)__builtin_amdgcn_readfirstlane(kdst+(slot)))
  #define DMA_V(t,slot) glds16(Vh+TOFF(t),vsrc,(unsigned)__builtin_amdgcn_readfirstlane(vdst+(slot)))
  const int vb0=(int)(lds0+LDS_V)+((lane>>4)&1)*32+(lane&3)*8+(4*hi+((lane&15)>>2))*64;
  const char*Kbase=shm+LDS_K; bf16x8 kf[8];
  const lds_cptr shm3=(lds_cptr)shm; const lds_cptr kp0=shm3+LDS_K+hi*1024+r32*16; const lds_cptr vp0=shm3+LDS_V+((lane>>4)&1)*32+(lane&3)*8+(4*hi+((lane&15)>>2))*64;
  DMA_K(0,0);DMA_V(0,0);DMA_K(1,SLOTB);
  bf16x8 qr[4];
  #pragma unroll
  for(int d0=0;d0<4;++d0)qr[d0]=*reinterpret_cast<const bf16x8*>(&Qw[(long)(meta?(r32&15):r32)*DM+d0*16+hi*8]);
  float mhat=0.f,l_reg=0.f;f32x16 o[2];f32x16 negm; { const float zz=(float)(qb>>30);
    _Pragma("unroll") for(int r=0;r<16;++r){o[0][r]=zz;o[1][r]=zz;negm[r]=zz;} } asm volatile("":"+v"(negm));
  #define CMASK(P0,P1,t) do{}while(0)
  bool resc=false;
  #define START(P0,P1) do{ const float rm=rowmax(P0,P1); resc=false; \
    { const float dl=rm; mhat=fadd_s(mhat,dl); \
      _Pragma("unroll") for(int r=0;r<16;++r){P0[r]=fsub_s(P0[r],dl);P1[r]=fsub_s(P1[r],dl);} \
      _Pragma("unroll") for(int r=0;r<16;++r)negm[r]=-mhat; asm volatile("":"+v"(negm)); } \
    _Pragma("unroll") for(int r=0;r<16;++r)P0[r]=__builtin_amdgcn_exp2f(P0[r]); }while(0)
  #define RESC() do{ if(resc){ asm volatile("s_waitcnt lgkmcnt(0)":::"memory"); \
      _Pragma("unroll") for(int d_=0;d_<2;++d_) _Pragma("unroll") for(int r=0;r<16;++r)o[d_][r]*=wsf[crow(r,hi)]; } }while(0)
  f32x16 pA0,pA1,pB0,pB1;
  int sl_prev=0,sl_cur=0,sl_next=SLOTB;
  #define ROT() do{sl_prev=sl_cur;sl_cur=sl_next;sl_next=(sl_next==(NSLOT-1)*SLOTB)?0:sl_next+SLOTB;}while(0)
  DMA_K(2,2*SLOTB);
  WAIT_BAR(3);
  qkt(pA0,pA1,Kbase,qr,negm,r32,hi);asm volatile("s_nop 15\n\ts_nop 7":"+v"(pA0),"+v"(pA1));CMASK(pA0,pA1,0);
  START(pA0,pA1);
  _Pragma("unroll") for(int r=0;r<16;++r)pA1[r]=__builtin_amdgcn_exp2f(pA1[r]);
  WAIT_BAR(0);
  DMA_K(3,0);DMA_V(1,SLOTB);
  ROT();
  kload8(kf,kp0+sl_cur);
  WAIT_BAR(2);
  s16x4 vlo[8],vhi[8]; u32x4 pw0,pw1,pw2,pw3;
  #define PKW(P,B) cvtpk_s(P[B],P[B+1])
  #define PAF(k) __builtin_bit_cast(bf16x8,pw##k)
  #define VFR(i) (bf16x8){vlo[i][0],vlo[i][1],vlo[i][2],vlo[i][3],vhi[i][0],vhi[i][1],vhi[i][2],vhi[i][3]}
  #define PIN(x) asm volatile("":"+v"(x))
  #define MX3(a,b,c) __builtin_fmaxf(__builtin_fmaxf((a),(b)),(c))
  #define GAPA(MF,A0,A1,A2,A3,W0,W1,PW) do{ MF; sacc+=A0; sacc+=A1; sacc+=A2; sacc+=A3; PIN(sacc); W0; W1; PIN(PW); SBAR(); }while(0)
  #define EX(v) __builtin_amdgcn_exp2f(v)
  #define GAPB(MF,X,B) do{ MF; X[B]=EX(X[B]); X[B+1]=EX(X[B+1]); X[B+2]=EX(X[B+2]); X[B+3]=EX(X[B+3]); PIN(X); SBAR(); }while(0)
  #define VRD(i) do{ vlo[i]=vtr(vp_+(((i)>>2)*4096+((i)&3)*1024)); vhi[i]=vtr(vp_+(((i)>>2)*4096+((i)&3)*1024+512)); }while(0)
  #define KRD(G,j) do{ if(G){ kload2(kf,kp0+sl_next,j); SBAR(); } }while(0)
  #define STEP(C0,C1,P0,P1,t,GK,GV,GL) do{ SBAR(); \
    const lds_cptr vp_=vp0+sl_prev; \
    VRD(0); SBAR(); float sacc=(P0[0]+P0[1]); \
    GAPA(C0=__builtin_amdgcn_mfma_f32_32x32x16_bf16(kf[0],qr[0],negm,0,0,0), P0[2],P0[3],P0[4],P0[5],     pw0[0]=PKW(P0,0), pw0[1]=PKW(P0,2), pw0); \
    VRD(4); SBAR(); GAPA(C1=__builtin_amdgcn_mfma_f32_32x32x16_bf16(kf[1],qr[0],negm,0,0,0), P0[6],P0[7],P0[8],P0[9],     pw0[2]=PKW(P0,4), pw0[3]=PKW(P0,6), pw0); \
    VRD(1); SBAR(); GAPA(C0=__builtin_amdgcn_mfma_f32_32x32x16_bf16(kf[2],qr[1],C0,0,0,0),   P0[10],P0[11],P0[12],P0[13], pw1[0]=PKW(P0,8), pw1[1]=PKW(P0,10), pw1); \
    VRD(5); SBAR(); GAPA(C1=__builtin_amdgcn_mfma_f32_32x32x16_bf16(kf[3],qr[1],C1,0,0,0),   P0[14],P0[15],P1[0],P1[1],   pw1[2]=PKW(P0,12),pw1[3]=PKW(P0,14), pw1); \
    VRD(2); SBAR(); GAPA(C0=__builtin_amdgcn_mfma_f32_32x32x16_bf16(kf[4],qr[2],C0,0,0,0),   P1[2],P1[3],P1[4],P1[5],     pw2[0]=PKW(P1,0), pw2[1]=PKW(P1,2), pw2); \
    VRD(6); SBAR(); GAPA(C1=__builtin_amdgcn_mfma_f32_32x32x16_bf16(kf[5],qr[2],C1,0,0,0),   P1[6],P1[7],P1[8],P1[9],     pw2[2]=PKW(P1,4), pw2[3]=PKW(P1,6), pw2); \
    VRD(3); SBAR(); GAPA(C0=__builtin_amdgcn_mfma_f32_32x32x16_bf16(kf[6],qr[3],C0,0,0,0),   P1[10],P1[11],P1[12],P1[13], pw3[0]=PKW(P1,8), pw3[1]=PKW(P1,10), pw3); \
    VRD(7); SBAR(); GAPA(C1=__builtin_amdgcn_mfma_f32_32x32x16_bf16(kf[7],qr[3],C1,0,0,0),   P1[14],P1[15],0.f,0.f,       pw3[2]=PKW(P1,12),pw3[3]=PKW(P1,14), pw3); \
    l_reg+=sacc; \
    if(GK){DMA_K((t)+3,sl_cur);} if(GV){DMA_V((t)+1,sl_next);} \
    CMASK(C0,C1,t); \
    { float a=MX3(C0[0],C0[1],C1[0]),b=MX3(C0[2],C0[3],C1[1]); a=MX3(a,C1[2],C1[3]); \
      _Pragma("unroll") for(int r=4;r<16;r+=4){a=MX3(a,C0[r],C0[r+1]);b=MX3(b,C0[r+2],C0[r+3]);a=MX3(a,C1[r],C1[r+1]);b=MX3(b,C1[r+2],C1[r+3]);} \
      float rm=__builtin_fmaxf(a,b); { auto rr=__builtin_amdgcn_permlane32_swap(__float_as_uint(rm),__float_as_uint(rm),false,false); rm=__builtin_fmaxf(__uint_as_float(rr[0]),__uint_as_float(rr[1])); } \
      resc=false; \
      if(__builtin_expect(__any(rm>(float)THRL),0)){ const float dl=__builtin_fmaxf(rm,0.f); mhat+=dl; \
        _Pragma("unroll") for(int r=0;r<16;++r){C0[r]-=dl;C1[r]-=dl;} \
        _Pragma("unroll") for(int r=0;r<16;++r)negm[r]=-mhat; asm volatile("":"+v"(negm)); \
        const float f=__builtin_amdgcn_exp2f(-dl); l_reg*=f; if(hi==0)wsf[r32]=f; resc=true; } } \
    SBAR(); \
    GAPB(o[0]=__builtin_amdgcn_mfma_f32_32x32x16_bf16(PAF(0),VFR(0),o[0],0,0,0), C0,0); \
    GAPB(o[1]=__builtin_amdgcn_mfma_f32_32x32x16_bf16(PAF(0),VFR(4),o[1],0,0,0), C0,4); \
    KRD(GL,0); GAPB(o[0]=__builtin_amdgcn_mfma_f32_32x32x16_bf16(PAF(1),VFR(1),o[0],0,0,0), C0,8); \
    KRD(GL,1); GAPB(o[1]=__builtin_amdgcn_mfma_f32_32x32x16_bf16(PAF(1),VFR(5),o[1],0,0,0), C0,12); \
    KRD(GL,2); GAPB(o[0]=__builtin_amdgcn_mfma_f32_32x32x16_bf16(PAF(2),VFR(2),o[0],0,0,0), C1,0); \
    KRD(GL,3); GAPB(o[1]=__builtin_amdgcn_mfma_f32_32x32x16_bf16(PAF(2),VFR(6),o[1],0,0,0), C1,4); \
    GAPB(o[0]=__builtin_amdgcn_mfma_f32_32x32x16_bf16(PAF(3),VFR(3),o[0],0,0,0), C1,8); \
    GAPB(o[1]=__builtin_amdgcn_mfma_f32_32x32x16_bf16(PAF(3),VFR(7),o[1],0,0,0), C1,12); \
    }while(0)
  int t=1;
  for(;t+5<NT;t+=2){
    STEP(pB0,pB1,pA0,pA1,t,true,true,true);     WAIT_BAR(2); RESC(); ROT();
    STEP(pA0,pA1,pB0,pB1,t+1,true,true,true);   WAIT_BAR(2); RESC(); ROT();
  }
  #undef CMASK
  #define CMASK(P0,P1,t) do{ if((t)==NT-1)tmask(P0,P1); }while(0)
  #define ENDW(tt) do{ if((tt)+3<NT){WAIT_BAR(2);} else if((tt)+2<NT){WAIT_BAR(1);} else {WAIT_BAR(0);} }while(0)
  for(;t+2<NT;t+=2){
    STEP(pB0,pB1,pA0,pA1,t,(t+3<NT),(t+1<NT),(t+1<NT));       ENDW(t);   RESC(); ROT();
    STEP(pA0,pA1,pB0,pB1,t+1,(t+4<NT),(t+2<NT),(t+2<NT));     ENDW(t+1); RESC(); ROT();
  }
  STEP(pB0,pB1,pA0,pA1,NT-2,false,true,true); ENDW(NT-2); RESC(); ROT();
  STEP(pA0,pA1,pB0,pB1,NT-1,false,false,false); RESC();
  { float sacc=pA0[0]+pA0[1]; _Pragma("unroll") for(int r=2;r<16;++r)sacc+=pA0[r]; _Pragma("unroll") for(int r=0;r<16;++r)sacc+=pA1[r]; l_reg+=sacc;
    pw0=(u32x4){PKW(pA0,0),PKW(pA0,2),PKW(pA0,4),PKW(pA0,6)};pw1=(u32x4){PKW(pA0,8),PKW(pA0,10),PKW(pA0,12),PKW(pA0,14)};pw2=(u32x4){PKW(pA1,0),PKW(pA1,2),PKW(pA1,4),PKW(pA1,6)};pw3=(u32x4){PKW(pA1,8),PKW(pA1,10),PKW(pA1,12),PKW(pA1,14)};
    SBAR(); pv(o,vb0+sl_cur,PAF(0),PAF(1),PAF(2),PAF(3)); }
  #undef PKW
  #undef PAF
  #undef VFR
  #undef PIN
  #undef MX3
  #undef GAPA
  #undef GAPB
  #undef EX
  #undef VRD
  #undef KRD
  #undef STEP
  #undef ENDW
  {auto rr=__builtin_amdgcn_permlane32_swap(__float_as_uint(l_reg),__float_as_uint(l_reg),false,false);l_reg=__uint_as_float(rr[0])+__uint_as_float(rr[1]);}
  if(hi==0)wsf[32+r32]=l_reg;asm volatile("s_waitcnt lgkmcnt(0)":::"memory");
  float rli[16];
  #pragma unroll
  for(int r=0;r<16;++r)rli[r]=__builtin_amdgcn_rcpf(wsf[32+crow(r,hi)]);
  bf16*Ow=O+qrow0*512+head*64;
  { bf16*stg=(bf16*)(shm+LDS_OST)+wid*2048;
    #pragma unroll
    for(int r=0;r<16;++r){const int orow=crow(r,hi);
      #pragma unroll
      for(int d0=0;d0<2;++d0)stg[orow*64+d0*32+r32]=f2bf(o[d0][r]*rli[r]);}
    asm volatile("s_waitcnt lgkmcnt(0)":::"memory");
    #pragma unroll
    for(int i=0;i<4;++i){const int row=i*8+(lane>>3),ch=lane&7; const u32x4 v=*(const u32x4*)(stg+row*64+ch*8); if(!meta||((wid&1)==0&&row<NMETA)) ATTN_STORE16(Ow+(long)row*512+ch*8,v);} }
  asm volatile("s_waitcnt lgkmcnt(0)\n\ts_barrier":::"memory");
  #undef DMA_K
  #undef TOFF
  #undef DMA_V
  #undef CMASK
  #undef START
  #undef RESC
  #undef ROT
}
#undef SBAR
#undef WAIT_BAR
}

__device__ __forceinline__ void chunk_rows(int b, int ch, int& base, int& n) { if (ch == 0) { base = ROWS_REAL + b * NMETA; n = NMETA; } else { base = b * SEQ + (ch - 1) * 64; n = 64; } }

typedef float f32x16 __attribute__((ext_vector_type(16)));
__device__ __forceinline__ int crow16(int r, int hi) { return (r & 3) + 8 * (r >> 2) + 4 * hi; }
__device__ __forceinline__ void hgrn_chunk_item(const Ctx& c, int layer, int b, int h, int dir) {
    constexpr int PQ = 136, PJ = 72;
    LAS char* sm = c.smem;
    LAS bf16_t* QT = (LAS bf16_t*)(sm);
    LAS bf16_t* QH = (LAS bf16_t*)(sm + 17408);
    LAS bf16_t* R0 = (LAS bf16_t*)(sm + 26112);
    LAS bf16_t* R1 = (LAS bf16_t*)(sm + 34816);
    LAS bf16_t* OT = R1;
    LAS bf16_t* KT = (LAS bf16_t*)(sm + 52224);
    LAS bf16_t* VT = (LAS bf16_t*)(sm + 70656);
    LAS bf16_t* PT = (LAS bf16_t*)(sm + 89088);
    LAS bf16_t* SL = (LAS bf16_t*)(sm + 98304);
    LAS float* DV = (LAS float*)(sm + 133120);
    LAS float* CX = (LAS float*)(sm + 133632);
    const int tid = c.tid, lane = c.lane, wid = c.wid, r32 = lane & 31, hi = lane >> 5;
    const int d = tid & 127, rq = tid >> 7;
    const float lb = c.LB()[(dir * DEPTH + layer) * 512 + h * 128 + d];
    bf16_t* OUT = dir ? c.OB() : c.OF();
    const bf16_t* PR = c.PROJ();
    const int fcol = dir ? C_HB : C_HF;
    __syncthreads();
    { const unsigned zu = (unsigned)(c.bid >> 30); const u32x4 z4 = (u32x4){zu, zu, zu, zu};
      for (int i = tid; i < 34816 / 16; i += 512) ((LAS u32x4*)SL)[i] = z4;
      for (int i = tid; i < 9216 / 16; i += 512) ((LAS u32x4*)PT)[i] = z4; }
    f32x16 Sacc[2];
    const float zz = (float)(c.bid >> 30);
#pragma unroll
    for (int r = 0; r < 16; ++r) { Sacc[0][r] = zz; Sacc[1][r] = zz; }
    LAS bf16_t* RQ = (LAS bf16_t*)(sm); LAS bf16_t* RF = (LAS bf16_t*)(sm + 16384); LAS bf16_t* RV = (LAS bf16_t*)(sm + 52224);
    u32x4 pfq[2], pff[2], pfv[2];
    const unsigned zu_ = (unsigned)(c.bid >> 30);
#define HG_LOAD(ci_) do { const int ch_ = dir ? 64 - (ci_) : (ci_); int base_, n_; chunk_rows(b, ch_, base_, n_); \
        _Pragma("unroll") for (int k = 0; k < 2; ++k) { const int p_ = tid + 512 * k, i_ = p_ >> 4, c16_ = p_ & 15; const int r_ = dir ? n_ - 1 - i_ : i_; \
            if (i_ < n_) { const bf16_t* pp_ = PR + (size_t)(base_ + r_) * PROJW + h * 128 + 8 * c16_; pfq[k] = *(const u32x4*)(pp_ + C_HQ); pff[k] = *(const u32x4*)(pp_ + fcol); pfv[k] = *(const u32x4*)(pp_ + C_HI); } \
            else { pfq[k] = (u32x4){zu_, zu_, zu_, zu_}; pff[k] = (u32x4){0x3f803f80u + zu_, 0x3f803f80u + zu_, 0x3f803f80u + zu_, 0x3f803f80u + zu_}; pfv[k] = (u32x4){zu_, zu_, zu_, zu_}; } } } while (0)
    HG_LOAD(0);
    for (int ci = 0; ci < 65; ++ci) {
        const int ch = dir ? 64 - ci : ci; int base, n; chunk_rows(b, ch, base, n);
#pragma unroll
        for (int k = 0; k < 2; ++k) { const int p_ = tid + 512 * k, i_ = p_ >> 4, c16_ = p_ & 15;
            *(LAS u32x4*)(RQ + i_ * 128 + 8 * c16_) = pfq[k]; *(LAS u32x4*)(RF + i_ * 128 + 8 * c16_) = pff[k]; *(LAS u32x4*)(RV + i_ * 128 + 8 * c16_) = pfv[k]; }
        if (ci + 1 < 65) HG_LOAD(ci + 1);
        lds_barrier();
        unsigned short xq[16], xf[16], xv[16];
#pragma unroll
        for (int m = 0; m < 16; ++m) { xq[m] = RQ[(16 * rq + m) * 128 + d]; xf[m] = RF[(16 * rq + m) * 128 + d]; xv[m] = RV[(16 * rq + m) * 128 + d]; }
        float cl[16], kk[16], qq[16];
        { float run = 0.f;
#pragma unroll
          for (int m = 0; m < 16; ++m) { const float f = bf2f(xf[m]);
              run += fmaxf(__logf(f), -200.0f); cl[m] = run; kk[m] = 1.0f - f; qq[m] = bf2f(xq[m]); }
          CX[rq * 128 + d] = run; }
        lds_barrier();
        { const float c0 = CX[d], c1 = CX[128 + d], c2 = CX[256 + d], c3 = CX[384 + d];
          const float tot0 = c0 + c1, tot1 = c2 + c3;
          const float off = (rq == 1) ? c0 : (rq == 3 ? c2 : 0.f);
          const int I = rq >> 1;
          const float e0 = __expf(tot0), e1 = __expf(tot1);
          if (rq == 0) DV[d] = e0 * e1;
          unsigned kp[8], vp[8];
#pragma unroll
          for (int m = 0; m < 16; ++m) { const int i = 16 * rq + m; const float cb = off + cl[m];
              const float E = __expf(fmaxf(cb, -80.f)), rE = __builtin_amdgcn_rcpf(E), krE = kk[m] * rE;
              QT[i * PQ + d] = f2bf(qq[m] * E);
              float khat;
              if (I == 0) { R0[i * PQ + d] = f2bf(krE); R1[i * PQ + d] = f2bf(krE * e0); khat = krE * e0 * e1; }
              else { R1[i * PQ + d] = f2bf(krE); QH[(i - 32) * PQ + d] = f2bf(qq[m] * E * e0); khat = krE * e1; }
              if (m & 1) { kp[m >> 1] |= ((unsigned)f2bf(khat)) << 16; vp[m >> 1] |= ((unsigned)xv[m]) << 16; } else { kp[m >> 1] = f2bf(khat); vp[m >> 1] = xv[m]; } }
          *(LAS u32x4*)(KT + d * PJ + 16 * rq) = (u32x4){kp[0], kp[1], kp[2], kp[3]}; *(LAS u32x4*)(KT + d * PJ + 16 * rq + 8) = (u32x4){kp[4], kp[5], kp[6], kp[7]};
          *(LAS u32x4*)(VT + d * PJ + 16 * rq) = (u32x4){vp[0], vp[1], vp[2], vp[3]}; *(LAS u32x4*)(VT + d * PJ + 16 * rq + 8) = (u32x4){vp[4], vp[5], vp[6], vp[7]}; }
        lds_barrier();
        if (wid < 3) {
            const LAS bf16_t* Rb = (wid == 0) ? R0 : (wid == 1 ? R1 : R1 + 32 * PQ);
            const int i0 = wid == 0 ? 0 : 32, j0 = wid == 2 ? 32 : 0;
            f32x16 acc;
#pragma unroll
            for (int r = 0; r < 16; ++r) acc[r] = zz;
#pragma unroll
            for (int d0 = 0; d0 < 8; ++d0) { const bf16x8 a = *(const LAS bf16x8*)(Rb + r32 * PQ + 16 * d0 + 8 * hi); const bf16x8 bq = *(const LAS bf16x8*)(QT + (i0 + r32) * PQ + 16 * d0 + 8 * hi);
                acc = __builtin_amdgcn_mfma_f32_32x32x16_bf16(a, bq, acc, 0, 0, 0); }
#pragma unroll
            for (int q4 = 0; q4 < 4; ++q4) { float v[4];
#pragma unroll
                for (int t = 0; t < 4; ++t) { const int jrel = 8 * q4 + 4 * hi + t; v[t] = (wid == 1 || jrel <= r32) ? acc[4 * q4 + t] : 0.f; }
                u32x2 w; w.x = cvt_pk_bf16(v[0], v[1]); w.y = cvt_pk_bf16(v[2], v[3]);
                *(LAS u32x2*)(PT + (i0 + r32) * PJ + j0 + 8 * q4 + 4 * hi) = w; }
        }
        { const int dq = wid & 3, eh = wid >> 2;
#pragma unroll
          for (int q4 = 0; q4 < 4; ++q4) { const f32x4 dv = *(const LAS f32x4*)(DV + 32 * dq + 8 * q4 + 4 * hi);
#pragma unroll
              for (int t = 0; t < 4; ++t) { Sacc[0][4 * q4 + t] *= dv[t]; Sacc[1][4 * q4 + t] *= dv[t]; } }
#pragma unroll
          for (int js = 0; js < 4; ++js) { const bf16x8 a = *(const LAS bf16x8*)(KT + (32 * dq + r32) * PJ + 16 * js + 8 * hi);
#pragma unroll
              for (int eb = 0; eb < 2; ++eb) { const bf16x8 bv = *(const LAS bf16x8*)(VT + (64 * eh + 32 * eb + r32) * PJ + 16 * js + 8 * hi);
                  Sacc[eb] = __builtin_amdgcn_mfma_f32_32x32x16_bf16(a, bv, Sacc[eb], 0, 0, 0); } } }
        lds_barrier();
        { const int ih = wid & 1, eq = wid >> 1, i0 = 32 * ih, e0 = 32 * eq;
          f32x16 acc;
#pragma unroll
          for (int r = 0; r < 16; ++r) acc[r] = zz;
#pragma unroll
          for (int js = 0; js < 4; ++js) if (js < 2 || ih) { const bf16x8 a = *(const LAS bf16x8*)(PT + (i0 + r32) * PJ + 16 * js + 8 * hi); const bf16x8 bv = *(const LAS bf16x8*)(VT + (e0 + r32) * PJ + 16 * js + 8 * hi);
              acc = __builtin_amdgcn_mfma_f32_32x32x16_bf16(a, bv, acc, 0, 0, 0); }
          const LAS bf16_t* qh = ih ? QH : QT;
#pragma unroll
          for (int ds = 0; ds < 8; ++ds) { const bf16x8 a = *(const LAS bf16x8*)(qh + r32 * PQ + 16 * ds + 8 * hi); const bf16x8 bs = *(const LAS bf16x8*)(SL + (e0 + r32) * PQ + 16 * ds + 8 * hi);
              acc = __builtin_amdgcn_mfma_f32_32x32x16_bf16(a, bs, acc, 0, 0, 0); }
#pragma unroll
          for (int r = 0; r < 16; ++r) OT[(i0 + crow16(r, hi)) * PQ + e0 + r32] = f2bf(acc[r]); }
        lds_barrier();
        { const int dq = wid & 3, eh = wid >> 2;
#pragma unroll
          for (int eb = 0; eb < 2; ++eb)
#pragma unroll
              for (int q4 = 0; q4 < 4; ++q4) { u32x2 w; w.x = cvt_pk_bf16(Sacc[eb][4 * q4], Sacc[eb][4 * q4 + 1]); w.y = cvt_pk_bf16(Sacc[eb][4 * q4 + 2], Sacc[eb][4 * q4 + 3]);
                  *(LAS u32x2*)(SL + (64 * eh + 32 * eb + r32) * PQ + 32 * dq + 8 * q4 + 4 * hi) = w; } }
#pragma unroll
        for (int k = 0; k < 2; ++k) { const int idx = tid + 512 * k, i = idx >> 4, c16 = idx & 15; const int r = dir ? n - 1 - i : i;
            if (i < n) *(u32x4*)(OUT + (size_t)(base + r) * 512 + h * 128 + c16 * 8) = *(const LAS u32x4*)(OT + i * PQ + c16 * 8); }
    }
#undef HG_LOAD
    __syncthreads();
}

__device__ __forceinline__ bf16x8 pack8(float a0, float a1, float a2, float a3, float a4, float a5, float a6, float a7) {
    u32x4 w; w.x = cvt_pk_bf16(a0, a1); w.y = cvt_pk_bf16(a2, a3); w.z = cvt_pk_bf16(a4, a5); w.w = cvt_pk_bf16(a6, a7); return __builtin_bit_cast(bf16x8, w);
}
__device__ __forceinline__ bf16x8 ld8perm(const LAS bf16_t* p) {
    const u32x2 a = *(const LAS u32x2*)p, b = *(const LAS u32x2*)(p + 8); u32x4 w; w.x = a.x; w.y = a.y; w.z = b.x; w.w = b.y; return __builtin_bit_cast(bf16x8, w);
}
__device__ __forceinline__ void ssd_chunk_item(const Ctx& c, int layer, int b, int g, int dir) {
    constexpr int PJ = 72, PO = 264;
    LAS char* sm = c.smem;
    LAS bf16_t* TB = (LAS bf16_t*)(sm);
    LAS bf16_t* TC = (LAS bf16_t*)(sm + 9216);
    LAS bf16_t* TBT = (LAS bf16_t*)(sm + 18432);
    LAS bf16_t* TX = (LAS bf16_t*)(sm + 27648);
    LAS bf16_t* OT = (LAS bf16_t*)(sm + 64512);
    LAS float* CUM = (LAS float*)(sm + 98304);
    LAS float* DTV = CUM + 256;
    LAS float* WV = CUM + 512;
    LAS float* ECV = CUM + 768;
    LAS float* DVv = CUM + 1024;
    const int tid = c.tid, lane = c.lane, wid = c.wid, r32 = lane & 31, hi = lane >> 5;
    const int hh = wid >> 1, ph = wid & 1;
    bf16_t* OUT = dir ? c.YB() : c.YF();
    const bf16_t* XB = c.XBC();
    const float* DTP = c.DT();
    const int xcp = tid & 127, xq4 = tid >> 7;
    const int prow = tid >> 3, ppc = tid & 7;
    const int sh = (tid >> 6) & 3, si = tid & 63;
    const float dtb = c.a->in[I_DTB][(layer * 2 + dir) * 8 + 4 * g + sh];
    const float Ah = -__expf(c.a->in[I_ALOG][(layer * 2 + dir) * 8 + 4 * g + sh]);
    __syncthreads();
    f32x16 Sacc[2];
    const float zz = (float)(c.bid >> 30);
#pragma unroll
    for (int r = 0; r < 16; ++r) { Sacc[0][r] = zz; Sacc[1][r] = zz; }
    LAS bf16_t* RX = (LAS bf16_t*)(sm + 106496);
    u32x4 pfx[4], pb, pc; float dtr;
    const unsigned zu_ = (unsigned)(c.bid >> 30);
#define SSD_LOAD(ci_) do { const int ch_ = dir ? 64 - (ci_) : (ci_); int base_, n_; chunk_rows(b, ch_, base_, n_); const u32x4 z = (u32x4){zu_, zu_, zu_, zu_}; \
        _Pragma("unroll") for (int k = 0; k < 4; ++k) { const int p_ = tid + 512 * k, i = p_ >> 5, c_ = p_ & 31, r = dir ? n_ - 1 - i : i; pfx[k] = (i < n_) ? *(const u32x4*)(XB + (size_t)(base_ + r) * 768 + 256 * g + 8 * c_) : z; } \
        { const int i = prow, r = dir ? n_ - 1 - i : i; \
          pb = (i < n_) ? *(const u32x4*)(XB + (size_t)(base_ + r) * 768 + 512 + 64 * g + 8 * ppc) : z; pc = (i < n_) ? *(const u32x4*)(XB + (size_t)(base_ + r) * 768 + 640 + 64 * g + 8 * ppc) : z; } \
        { const int i = si, r = dir ? n_ - 1 - i : i; dtr = (tid < 256 && i < n_) ? DTP[(size_t)(base_ + r) * 16 + dir * 8 + 4 * g + sh] : -1e30f; } } while (0)
    SSD_LOAD(0);
    for (int ci = 0; ci < 65; ++ci) {
        const int ch = dir ? 64 - ci : ci; int base, n; chunk_rows(b, ch, base, n);
#pragma unroll
        for (int k = 0; k < 4; ++k) { const int p_ = tid + 512 * k; *(LAS u32x4*)(RX + (p_ >> 5) * 256 + 8 * (p_ & 31)) = pfx[k]; }
        *(LAS u32x4*)(TB + prow * PJ + 8 * ppc) = pb; *(LAS u32x4*)(TC + prow * PJ + 8 * ppc) = pc;
        const float dtc = dtr;
        if (ci + 1 < 65) SSD_LOAD(ci + 1);
        lds_barrier();
        { unsigned xr[16];
#pragma unroll
          for (int m = 0; m < 16; ++m) xr[m] = *(const LAS unsigned*)(RX + (16 * xq4 + m) * 256 + 2 * xcp);
          unsigned lo[8], hi2[8];
#pragma unroll
          for (int q = 0; q < 8; ++q) { lo[q] = (xr[2 * q] & 0xffffu) | (xr[2 * q + 1] << 16); hi2[q] = (xr[2 * q] >> 16) | (xr[2 * q + 1] & 0xffff0000u); }
          LAS bf16_t* x0 = TX + (2 * xcp) * PJ + 16 * xq4;
          *(LAS u32x4*)(x0) = (u32x4){lo[0], lo[1], lo[2], lo[3]}; *(LAS u32x4*)(x0 + 8) = (u32x4){lo[4], lo[5], lo[6], lo[7]};
          *(LAS u32x4*)(x0 + PJ) = (u32x4){hi2[0], hi2[1], hi2[2], hi2[3]}; *(LAS u32x4*)(x0 + PJ + 8) = (u32x4){hi2[4], hi2[5], hi2[6], hi2[7]}; }
        if (tid >= 256) { const int bn = tid & 63, brq = (tid >> 6) & 3; unsigned short bv[16];
#pragma unroll
            for (int m = 0; m < 16; ++m) bv[m] = TB[(16 * brq + m) * PJ + bn];
            u32x4 w0, w1; w0.x = bv[0] | ((unsigned)bv[1] << 16); w0.y = bv[2] | ((unsigned)bv[3] << 16); w0.z = bv[4] | ((unsigned)bv[5] << 16); w0.w = bv[6] | ((unsigned)bv[7] << 16);
            w1.x = bv[8] | ((unsigned)bv[9] << 16); w1.y = bv[10] | ((unsigned)bv[11] << 16); w1.z = bv[12] | ((unsigned)bv[13] << 16); w1.w = bv[14] | ((unsigned)bv[15] << 16);
            *(LAS u32x4*)(TBT + bn * PJ + 16 * brq) = w0; *(LAS u32x4*)(TBT + bn * PJ + 16 * brq + 8) = w1; }
        if (tid < 256) {
            const float xd = dtc + dtb;
            const float dt = (dtc < -1e29f) ? 0.f : (xd > 20.f ? xd : log1pf(__expf(xd)));
            float cum = dt * Ah;
#pragma unroll
            for (int o = 1; o < 64; o <<= 1) { const float t = shup_f(cum, o, lane); if (lane >= o) cum += t; }
            const float tot = shl_f(cum, 63);
            CUM[sh * 64 + si] = cum; DTV[sh * 64 + si] = dt; WV[sh * 64 + si] = dt * __expf(tot - cum); ECV[sh * 64 + si] = __expf(cum);
            if (si == 0) DVv[sh] = __expf(tot);
        }
        lds_barrier();
        {
            const LAS float* cumh = CUM + hh * 64; const LAS float* dth = DTV + hh * 64; const LAS float* wh = WV + hh * 64; const LAS float* ech = ECV + hh * 64;
            bf16x8 sf[2][2];
#pragma unroll
            for (int nb = 0; nb < 2; ++nb)
#pragma unroll
                for (int s2 = 0; s2 < 2; ++s2) sf[nb][s2] = pack8(Sacc[nb][8 * s2], Sacc[nb][8 * s2 + 1], Sacc[nb][8 * s2 + 2], Sacc[nb][8 * s2 + 3], Sacc[nb][8 * s2 + 4], Sacc[nb][8 * s2 + 5], Sacc[nb][8 * s2 + 6], Sacc[nb][8 * s2 + 7]);
            const LAS bf16_t* xT = TX + (hh * 64 + 32 * ph + r32) * PJ;
#pragma unroll
            for (int ib = 0; ib < 2; ++ib) {
                f32x16 acc;
#pragma unroll
                for (int r = 0; r < 16; ++r) acc[r] = zz;
#pragma unroll
                for (int nb = 0; nb < 2; ++nb)
#pragma unroll
                    for (int s2 = 0; s2 < 2; ++s2) { const bf16x8 cb_ = ld8perm(TC + (32 * ib + r32) * PJ + 32 * nb + 16 * s2 + 4 * hi);
                        acc = __builtin_amdgcn_mfma_f32_32x32x16_bf16(sf[nb][s2], cb_, acc, 0, 0, 0); }
                { const float eci = ech[32 * ib + r32];
#pragma unroll
                  for (int r = 0; r < 16; ++r) acc[r] *= eci; }
                const float ci_ = cumh[32 * ib + r32];
#pragma unroll
                for (int jb = 0; jb <= ib; ++jb) {
                    f32x16 gacc;
#pragma unroll
                    for (int r = 0; r < 16; ++r) gacc[r] = zz;
#pragma unroll
                    for (int ns = 0; ns < 4; ++ns) { const bf16x8 a = *(const LAS bf16x8*)(TB + (32 * jb + r32) * PJ + 16 * ns + 8 * hi); const bf16x8 bq = *(const LAS bf16x8*)(TC + (32 * ib + r32) * PJ + 16 * ns + 8 * hi);
                        gacc = __builtin_amdgcn_mfma_f32_32x32x16_bf16(a, bq, gacc, 0, 0, 0); }
#pragma unroll
                    for (int q4 = 0; q4 < 4; ++q4) { const f32x4 cj = *(const LAS f32x4*)(cumh + 32 * jb + 8 * q4 + 4 * hi); const f32x4 dj = *(const LAS f32x4*)(dth + 32 * jb + 8 * q4 + 4 * hi);
#pragma unroll
                        for (int t = 0; t < 4; ++t) { const int jrel = 8 * q4 + 4 * hi + t; const bool keep = (jb < ib) || (jrel <= r32);
                            gacc[4 * q4 + t] = keep ? gacc[4 * q4 + t] * dj[t] * __expf(fminf(ci_ - cj[t], 0.f)) : 0.f; } }
#pragma unroll
                    for (int s2 = 0; s2 < 2; ++s2) { const bf16x8 pfr = pack8(gacc[8 * s2], gacc[8 * s2 + 1], gacc[8 * s2 + 2], gacc[8 * s2 + 3], gacc[8 * s2 + 4], gacc[8 * s2 + 5], gacc[8 * s2 + 6], gacc[8 * s2 + 7]);
                        const bf16x8 xb = ld8perm(xT + 32 * jb + 16 * s2 + 4 * hi);
                        acc = __builtin_amdgcn_mfma_f32_32x32x16_bf16(xb, pfr, acc, 0, 0, 0); }
                }
#pragma unroll
                for (int q4 = 0; q4 < 4; ++q4) { u32x2 w; w.x = cvt_pk_bf16(acc[4 * q4], acc[4 * q4 + 1]); w.y = cvt_pk_bf16(acc[4 * q4 + 2], acc[4 * q4 + 3]);
                    *(LAS u32x2*)(OT + (32 * ib + r32) * PO + hh * 64 + 32 * ph + 8 * q4 + 4 * hi) = w; }
            }
            const float Dh = DVv[hh];
#pragma unroll
            for (int r = 0; r < 16; ++r) { Sacc[0][r] *= Dh; Sacc[1][r] *= Dh; }
#pragma unroll
            for (int js = 0; js < 4; ++js) { const u32x4 xw = *(const LAS u32x4*)(xT + 16 * js + 8 * hi); const f32x4 w0 = *(const LAS f32x4*)(wh + 16 * js + 8 * hi), w1 = *(const LAS f32x4*)(wh + 16 * js + 8 * hi + 4);
                const bf16x8 xb = pack8(bflo(xw.x) * w0[0], bfhi(xw.x) * w0[1], bflo(xw.y) * w0[2], bfhi(xw.y) * w0[3], bflo(xw.z) * w1[0], bfhi(xw.z) * w1[1], bflo(xw.w) * w1[2], bfhi(xw.w) * w1[3]);
#pragma unroll
                for (int nb = 0; nb < 2; ++nb) { const bf16x8 a = *(const LAS bf16x8*)(TBT + (32 * nb + r32) * PJ + 16 * js + 8 * hi);
                    Sacc[nb] = __builtin_amdgcn_mfma_f32_32x32x16_bf16(a, xb, Sacc[nb], 0, 0, 0); } }
        }
        lds_barrier();
#pragma unroll
        for (int k = 0; k < 4; ++k) { const int idx = tid + 512 * k, i = idx >> 5, c16 = idx & 31; const int r = dir ? n - 1 - i : i;
            if (i < n) *(u32x4*)(OUT + (size_t)(base + r) * 512 + 256 * g + c16 * 8) = *(const LAS u32x4*)(OT + i * PO + c16 * 8); }
    }
#undef SSD_LOAD
    __syncthreads();
}

__device__ __forceinline__ void phase_mixers(const Ctx& c0, int layer, const int sites = 15, const int qsel = 0) {
    constexpr int N_H = 64, N_S = 32, N_A = NB * 2 * 65;
#ifndef MIX_SITES
#define MIX_SITES 15
#endif
    if ((MIX_SITES & 1) && (sites & 1)) { const Ctx c = fresh(c0); for (int it = c.bid; it < N_H; it += c.G) hgrn_chunk_item(c, layer, it >> 3, (it >> 1) & 3, it & 1); }
    if ((MIX_SITES & 2) && (sites & 2)) { const Ctx c = fresh(c0); for (int it = (c.bid + c.G - N_H % c.G) % c.G; it < N_S; it += c.G) ssd_chunk_item(c, layer, it >> 2, (it >> 1) & 1, it & 1); }
    if ((MIX_SITES & 4) && (sites & 4)) { const Ctx c = fresh(c0);
        unsigned* qctr = (unsigned*)(c.ws + WS_CTL) + 32768 + 64 * layer + 1024 * qsel;
        volatile LAS unsigned* qw = (volatile LAS unsigned*)(c.smem + LDS_MISC + 64);
        for (;;) {
            if (c.tid == 0) qw[0] = __hip_atomic_fetch_add(qctr, 1u, __ATOMIC_RELAXED, __HIP_MEMORY_SCOPE_AGENT);
            __syncthreads();
            const int u = __builtin_amdgcn_readfirstlane((int)qw[0]);
            __syncthreads();
            if (u >= N_A) break;
            const int b = u / 130, rem = u % 130; att::attn_unit<8>(b, rem / 65, rem % 65, c.PROJ(), c.ATT(), (char*)c.smem, c.wid, c.lane); } }
    if ((MIX_SITES & 8) && (sites & 8) && layer + 1 < DEPTH) { Ctx cn = c0; cn.wbuf = c0.wbuf ^ 1; convert_pull(cn, layer + 1, (LAS float*)(c0.smem + 65536)); }
}

__device__ __forceinline__ void phase_mix(const Ctx& c0, int layer) {
    const Ctx c = fresh(c0);
    const int lane = c.lane;
    const float* anw = c.a->in[I_ANW] + layer * 512; const float* hnw = c.a->in[I_HNW] + layer * 512; const float* snw = c.a->in[I_SNW] + layer * 512;
    const float dsk = c.a->in[I_DSKIP][layer * 8 + (lane >> 3)];
    auto ld8 = [](const bf16_t* p, float (&x)[8]) { const u32x4 w = *(const u32x4*)p; x[0] = bflo(w.x); x[1] = bfhi(w.x); x[2] = bflo(w.y); x[3] = bfhi(w.y); x[4] = bflo(w.z); x[5] = bfhi(w.z); x[6] = bflo(w.w); x[7] = bfhi(w.w); };
    auto st8 = [](bf16_t* p, const float (&x)[8]) { u32x4 w; w.x = cvt_pk_bf16(x[0], x[1]); w.y = cvt_pk_bf16(x[2], x[3]); w.z = cvt_pk_bf16(x[4], x[5]); w.w = cvt_pk_bf16(x[6], x[7]); *(u32x4*)p = w; };
    for (int row = c.bid * 8 + c.wid; row < ROWS; row += c.G * 8) {
        const bf16_t* prow = c.PROJ() + (size_t)row * PROJW;
        bf16_t* mrow = c.MIX() + (size_t)row * MIXW;
        float x[8], y[8], z[8];
        { ld8(c.ATT() + (size_t)row * 512 + 8 * lane, x); float ss = 0.f;
#pragma unroll
          for (int j = 0; j < 8; ++j) ss += x[j] * x[j];
          ss = wave_sum(ss, lane); const float rstd = rsqrtf(ss * (1.0f / 512.0f) + EPS);
#pragma unroll
          for (int j = 0; j < 8; ++j) x[j] = x[j] * rstd * anw[8 * lane + j];
          st8(mrow + 8 * lane, x); }
        { ld8(c.OF() + (size_t)row * 512 + 8 * lane, x); ld8(c.OB() + (size_t)row * 512 + 8 * lane, y); ld8(prow + C_HG + 8 * lane, z); float ss = 0.f;
#pragma unroll
          for (int j = 0; j < 8; ++j) { x[j] += y[j]; ss += x[j] * x[j]; }
          ss += shx(ss, 1, lane); ss += shx(ss, 2, lane); ss += shx(ss, 4, lane); ss += shx(ss, 8, lane);
          const float rstd = rsqrtf(ss * (1.0f / 128.0f) + EPS);
#pragma unroll
          for (int j = 0; j < 8; ++j) x[j] = x[j] * rstd * hnw[8 * lane + j] * silu_f(z[j]);
          st8(mrow + 512 + 8 * lane, x); }
        { ld8(c.YF() + (size_t)row * 512 + 8 * lane, x); ld8(c.YB() + (size_t)row * 512 + 8 * lane, y); ld8(prow + C_SZ + 8 * lane, z); float xs[8]; ld8(c.XBC() + (size_t)row * 768 + 8 * lane, xs); float ss = 0.f;
#pragma unroll
          for (int j = 0; j < 8; ++j) { x[j] = (x[j] + y[j] + dsk * xs[j]) * silu_f(z[j]); ss += x[j] * x[j]; }
          ss = wave_sum(ss, lane); const float rstd = rsqrtf(ss * (1.0f / 512.0f) + EPS);
#pragma unroll
          for (int j = 0; j < 8; ++j) x[j] = x[j] * rstd * snw[8 * lane + j];
          st8(mrow + 1024 + 8 * lane, x); }
    }
}

__device__ __forceinline__ void phase_topk(const Ctx& c0) {
    const Ctx c = fresh(c0);
    LAS unsigned* HIST = (LAS unsigned*)c.smem;
    LAS unsigned* WOFF = HIST + 1024;
    LAS unsigned* RES = HIST + 1040;
    const int tid = c.tid, lane = c.lane, wid = c.wid;
    for (int it = c.bid; it < NB * NEXP; it += c.G) {
        const int b = it >> 4, e = it & 15;
        unsigned key[9];
#pragma unroll
        for (int k = 0; k < 9; ++k) { const int i = 9 * tid + k; key[k] = i < LTOK ? min(__float_as_uint(c.AFFT()[(size_t)it * LTOK + i]), 0x3fffffffu) : 0u; }
        unsigned prefix = 0u, need = CAP;
#pragma unroll
        for (int pass = 0; pass < 3; ++pass) {
            const int sh = 20 - 10 * pass;
            __syncthreads();
            HIST[tid] = 0u; HIST[tid + 512] = 0u;
            __syncthreads();
#pragma unroll
            for (int k = 0; k < 9; ++k) { const int i = 9 * tid + k; const bool cand = (i < LTOK) && (pass == 0 || (key[k] >> (sh + 10)) == prefix);
                if (cand) __hip_atomic_fetch_add(&HIST[(key[k] >> sh) & 1023u], 1u, __ATOMIC_RELAXED, __HIP_MEMORY_SCOPE_WORKGROUP); }
            __syncthreads();
            const unsigned h1 = HIST[1023 - 2 * tid], h0 = HIST[1022 - 2 * tid];
            const unsigned pair = h1 + h0; unsigned inc = pair;
#pragma unroll
            for (int o = 1; o < 64; o <<= 1) { const unsigned t = shup_u(inc, o, lane); if (lane >= o) inc += t; }
            if (lane == 63) WOFF[wid] = inc;
            __syncthreads();
            unsigned woff = 0u;
#pragma unroll
            for (int w = 0; w < 8; ++w) { const unsigned v = WOFF[w]; if (w < wid) woff += v; }
            const unsigned above1 = woff + inc - pair, suf1 = above1 + h1, suf0 = suf1 + h0;
            if (suf1 >= need && above1 < need) { RES[0] = (unsigned)(1023 - 2 * tid); RES[1] = need - above1; }
            if (suf0 >= need && suf1 < need) { RES[0] = (unsigned)(1022 - 2 * tid); RES[1] = need - suf1; }
            __syncthreads();
            prefix = (prefix << 10) | RES[0]; need = RES[1];
        }
        const unsigned T = prefix;
        unsigned ngt = 0u, neq = 0u;
#pragma unroll
        for (int k = 0; k < 9; ++k) { const int i = 9 * tid + k; if (i < LTOK) { ngt += key[k] > T; neq += key[k] == T; } }
        unsigned pk = ngt | (neq << 16), inc = pk;
#pragma unroll
        for (int o = 1; o < 64; o <<= 1) { const unsigned t = shup_u(inc, o, lane); if (lane >= o) inc += t; }
        __syncthreads();
        if (lane == 63) WOFF[wid] = inc;
        __syncthreads();
        unsigned woff = 0u, tot = 0u;
#pragma unroll
        for (int w = 0; w < 8; ++w) { const unsigned v = WOFF[w]; if (w < wid) woff += v; tot += v; }
        const unsigned ex = woff + inc - pk;
        unsigned gt_off = ex & 0xffffu, eq_off = ex >> 16; const unsigned gt_tot = tot & 0xffffu;
#pragma unroll
        for (int k = 0; k < 9; ++k) { const int i = 9 * tid + k;
            if (i < LTOK) { const int row = row_of(b, i); int slot = -1;
                if (key[k] > T) slot = (int)gt_off++;
                else if (key[k] == T) { if (eq_off < need) slot = (int)(gt_tot + eq_off); ++eq_off; }
                if (slot >= 0) { const int mrow = e * EROWS + b * CAP + slot; c.RIDX()[mrow] = row; c.GATE()[mrow] = __uint_as_float(key[k]); c.SEL()[row * 16 + e] = mrow; }
                else c.SEL()[row * 16 + e] = -1; } }
    }
}

__device__ __forceinline__ void phase_final(const Ctx& c0) {
    const Ctx c = fresh(c0);
    const int lane = c.lane;
    constexpr int NR = 4;
    for (int r0 = (c.bid * 8 + c.wid) * NR; r0 < ROWS_REAL; r0 += c.G * 8 * NR) {
        f32x4 v[NR][4]; int sv[NR]; unsigned hm[NR];
#pragma unroll
        for (int q = 0; q < NR; ++q) { sv[q] = lane < 16 ? c.SEL()[(r0 + q) * 16 + lane] : -1;
#pragma unroll
            for (int i = 0; i < 4; ++i) { const u32x2 w = *(const u32x2*)(c.H() + (size_t)(r0 + q) * DM + 4 * lane + 256 * i); v[q][i] = (f32x4){bflo(w.x), bfhi(w.x), bflo(w.y), bfhi(w.y)}; } }
#pragma unroll
        for (int q = 0; q < NR; ++q) hm[q] = (unsigned)__builtin_amdgcn_ballot_w64(sv[q] >= 0);
        while ((hm[0] | hm[1] | hm[2] | hm[3]) != 0u) {
            int wd[NR][2][4]; bool has[NR][2];
#pragma unroll
            for (int q = 0; q < NR; ++q)
#pragma unroll
                for (int j = 0; j < 2; ++j) { has[q][j] = hm[q] != 0u; const int e = has[q][j] ? __builtin_ctz(hm[q]) : 0; hm[q] &= hm[q] - 1u;
                    const int se = has[q][j] ? __builtin_amdgcn_readlane(sv[q], e) : 0;
                    const unsigned char* yp = c.Y() + (size_t)se * DM + 4 * lane;
#pragma unroll
                    for (int i = 0; i < 4; ++i) wd[q][j][i] = *(const int*)(yp + 256 * i); }
#pragma unroll
            for (int q = 0; q < NR; ++q)
#pragma unroll
                for (int j = 0; j < 2; ++j) if (has[q][j]) {
#pragma unroll
                    for (int i = 0; i < 4; ++i) { const int w = wd[q][j][i]; const f32x2 lo = __builtin_amdgcn_cvt_pk_f32_fp8(w, false), hi_ = __builtin_amdgcn_cvt_pk_f32_fp8(w, true);
                        v[q][i][0] += lo[0] * 0.0625f; v[q][i][1] += lo[1] * 0.0625f; v[q][i][2] += hi_[0] * 0.0625f; v[q][i][3] += hi_[1] * 0.0625f; } }
        }
#pragma unroll
        for (int q = 0; q < NR; ++q)
#pragma unroll
            for (int i = 0; i < 4; ++i) *(f32x4*)(c.a->out + (size_t)(r0 + q) * DM + 4 * lane + 256 * i) = v[q][i];
    }
}

struct SmallDeal { int xcd, nx, wslot, nw; };
__device__ __forceinline__ SmallDeal small_deal(const Ctx& c) { SmallDeal d; d.nx = 1; d.xcd = 0; d.wslot = c.bid; d.nw = c.G; return d; }
__device__ __forceinline__ void small_inproj(const Ctx& c0, int layer) {
    const Ctx c = fresh(c0); const int lane = c.lane, r = lane & 15, cq = lane >> 4; const SmallDeal d = small_deal(c); const int per = 288 / d.nx;
    for (int u = d.wslot * 8 + c.wid; u < 4 * per; u += d.nw * 8) { const int rp = u / per, n0 = 16 * (d.xcd * per + u % per); const int row0 = ROWS_REAL + 32 * rp + r;
        const bf16_t* const ar[2] = {c.U() + (size_t)row0 * DM, c.U() + (size_t)(row0 + 16) * DM}; const bf16_t* const br[1] = {c.WIN() + (size_t)(n0 + r) * DM};
        f32x4 acc2[2][1]; small_gemm16_bt<2, 1, DM, 4>(ar, br, acc2, lane);
        const int mode = (n0 >= C_HQ && n0 < C_HF) ? 1 : ((n0 >= C_HF && n0 < C_HI) ? 2 : 0);
        const int col = n0 + 4 * cq;
#pragma unroll
        for (int q = 0; q < 2; ++q) { float v[4] = {acc2[q][0][0], acc2[q][0][1], acc2[q][0][2], acc2[q][0][3]};
            if (mode == 1) {
#pragma unroll
                for (int j = 0; j < 4; ++j) v[j] = silu_f(v[j]); }
            else if (mode == 2) { const float* lp = c.LB() + ((col >= C_HB ? 1 : 0) * DEPTH + layer) * 512 + (col >= C_HB ? col - C_HB : col - C_HF);
#pragma unroll
                for (int j = 0; j < 4; ++j) v[j] = fgate_f(v[j], lp[j]); }
            u32x2 w; w.x = cvt_pk_bf16(v[0], v[1]); w.y = cvt_pk_bf16(v[2], v[3]); *(u32x2*)(c.PROJ() + (size_t)(row0 + 16 * q) * PROJW + col) = w; } }
}
__device__ __forceinline__ void small_outproj(const Ctx& c0) {
    const Ctx c = fresh(c0); const int lane = c.lane, r = lane & 15, cq = lane >> 4, gq = c.wid >> 2, kq = c.wid & 3; const SmallDeal d = small_deal(c); const int per = 64 / d.nx;
    LAS f32x4* RED = (LAS f32x4*)c.smem;
    for (int u0 = d.wslot * 2; u0 < 8 * per; u0 += d.nw * 2) { const int u = u0 + gq; const int rg = u / per, n0 = 16 * (d.xcd * per + u % per); const int row = ROWS_REAL + 16 * rg + r;
        const bf16_t* const ar[1] = {c.MIX() + (size_t)row * MIXW + kq * (MIXW / 4)}; const bf16_t* const br[1] = {c.WOUT() + (size_t)(n0 + r) * MIXW + kq * (MIXW / 4)};
        f32x4 acc1[1][1]; small_gemm16_bt<1, 1, MIXW / 4, 3>(ar, br, acc1, lane);
        __syncthreads();
        RED[c.wid * 64 + lane] = acc1[0][0];
        __syncthreads();
        if (kq == 0) { const f32x4 sum = RED[(4 * gq) * 64 + lane] + RED[(4 * gq + 1) * 64 + lane] + RED[(4 * gq + 2) * 64 + lane] + RED[(4 * gq + 3) * 64 + lane];
            u32x2* p = (u32x2*)(c.H() + (size_t)row * DM + n0 + 4 * cq); const u32x2 w = *p; u32x2 o; o.x = cvt_pk_bf16(bflo(w.x) + sum[0], bfhi(w.x) + sum[1]); o.y = cvt_pk_bf16(bflo(w.y) + sum[2], bfhi(w.y) + sum[3]); *p = o; } }
}
__device__ __forceinline__ void small_gateup(const Ctx& c0) {
    const Ctx c = fresh(c0); const int lane = c.lane, r = lane & 15, cq = lane >> 4; const SmallDeal d = small_deal(c); const int per = 128 / d.nx;
    for (int u = d.wslot * 8 + c.wid; u < NEXP * per; u += d.nw * 8) { const int e = u / per, fb = d.xcd * per + u % per, ff0 = 16 * fb, pn = ff0 >> 7, j0 = ff0 & 127; const int mrow = e * EROWS + 4096 + r;
        const unsigned char* wb = c.WGU() + ((size_t)e * 4096 + pn * 256 + j0 + r) * DM;
        const unsigned char* const br[2] = {wb, wb + (size_t)128 * DM};
        f32x4 acc[2]; small_gemm16_f8t<2, DM, 4>(c.U8() + (size_t)c.RIDX()[mrow] * DM, br, acc, lane);
        const float sc = 1.0f / 32.0f; float v[4];
#pragma unroll
        for (int j = 0; j < 4; ++j) v[j] = silu_f(acc[0][j] * sc) * (acc[1][j] * sc);
        *(unsigned*)(c.ACT() + (size_t)mrow * FF + ff0 + 4 * cq) = pk4_fp8(v[0], v[1], v[2], v[3]); }
}
__device__ __forceinline__ void small_down(const Ctx& c0) {
    const Ctx c = fresh(c0); const int lane = c.lane, r = lane & 15, cq = lane >> 4, gq = c.wid >> 1, kq = c.wid & 1; const SmallDeal d = small_deal(c); const int eper = NEXP / d.nx;
    LAS f32x4* RED = (LAS f32x4*)c.smem;
    for (int u0 = d.wslot * 4; u0 < eper * 64; u0 += d.nw * 4) { const int u = u0 + gq; const int e = d.xcd * eper + (u >> 6), n0 = 16 * (u & 63); const int mrow = e * EROWS + 4096 + r;
        const unsigned char* const br[1] = {c.WD() + ((size_t)e * DM + n0 + r) * FF + kq * (FF / 2)};
        f32x4 acc[1]; small_gemm16_f8t<1, FF / 2, 8>(c.ACT() + (size_t)mrow * FF + kq * (FF / 2), br, acc, lane);
        __syncthreads();
        RED[c.wid * 64 + lane] = acc[0];
        __syncthreads();
        if (kq == 0) { const f32x4 sum = RED[(2 * gq) * 64 + lane] + RED[(2 * gq + 1) * 64 + lane];
            const float g = c.GATE()[mrow] * (1.0f / 32.0f);
            *(unsigned*)(c.Y() + (size_t)mrow * DM + n0 + 4 * cq) = pk4_fp8(16.0f * sum[0] * g, 16.0f * sum[1] * g, 16.0f * sum[2] * g, 16.0f * sum[3] * g); } }
}

constexpr int NPH_LAYER = 10, NPH = 1 + DEPTH * NPH_LAYER + 1;
__global__ void __launch_bounds__(512, 2) mega(Args args) {
    extern __shared__ __attribute__((aligned(16))) unsigned char lds[];
    Ctx c;
    c.wbuf = 0;
    c.a = &args; c.ws = args.ws; c.smem = (LAS char*)lds; c.tid = threadIdx.x; c.lane = c.tid & 63; c.wid = __builtin_amdgcn_readfirstlane(c.tid >> 6); c.G = gridDim.x; c.bid = blockIdx.x;
    unsigned char* ws = args.ws;
    LAS unsigned char* l3 = (LAS unsigned char*)lds;
    volatile LAS unsigned* MISC = (volatile LAS unsigned*)(l3 + LDS_MISC);
    if (c.tid < 4) MISC[c.tid] = 0u;
    __syncthreads();
    const int lo = args.ph_lo, hi = args.ph_hi;
    XcdBarrier bar; bar.bar = (unsigned*)(ws + WS_CTL) + 4096; bar.x = 0; bar.st = MISC;
    if (hi - lo > 1) bar = xcd_barrier_post((unsigned*)(ws + WS_CTL) + 4096, MISC);
#define IN(k) (lo <= (k) && (k) < hi)
#define SEAM(k) do { if (IN(k) && IN((k) + 1)) xcd_barrier(bar, c.wid); } while (0)
    if ((PH_MASK & 1) && IN(0)) { phase_tables(c); }
    SEAM(0);
    for (int layer_ = 0; layer_ < DEPTH; ++layer_) {
        int layer = layer_; asm volatile("" : "+s"(layer)); c.wbuf = layer & 1;
        const int p0 = 1 + layer_ * NPH_LAYER;
        if ((PH_MASK & (2 << 0)) && IN(p0 + 0)) { DLY(10, phase_norm<false>(c, layer)); convert_pull(c, layer, (LAS float*)(c.smem + 65536)); }
        SEAM(p0 + 0);
        if ((PH_MASK & (2 << 1)) && IN(p0 + 1)) { pg::SchedDense S{ROWS_REAL / 256, PROJW / 256, (ROWS_REAL / 256) * (PROJW / 256), og(c.G), og(c.bid), (const char*)c.WIN()}; pg::EpiProj E{c.PROJ(), PROJW, c.LB() + (0 * DEPTH + layer) * 512, c.LB() + (1 * DEPTH + layer) * 512};
            REP(1) pg::gemm_phase(l3, c.wid, (const char*)c.U(), DM * 2, S, E); for (int sr_ = 0; sr_ < SMALL_REP; ++sr_) small_inproj(c, layer); }
        SEAM(p0 + 1);
        if ((PH_MASK & (2 << 2)) && IN(p0 + 2)) { DLY(2, phase_prep(c, layer)); }
        SEAM(p0 + 2);
        if ((PH_MASK & (2 << 3)) && IN(p0 + 3)) { const int nrep_ = (PROBE_PH >= 13 && PROBE_PH <= 15) ? 2 : 1; for (int rep_ = 0; rep_ < nrep_; ++rep_) { __syncthreads(); phase_mixers(c, layer, og(rep_ == 0 ? 15 : (PROBE_PH == 13 ? 4 : (PROBE_PH == 14 ? 1 : 2))), og(rep_)); } }
        SEAM(p0 + 3);
        if ((PH_MASK & (2 << 4)) && IN(p0 + 4)) { REP(4) phase_mix(c, layer); }
        SEAM(p0 + 4);
        if ((PH_MASK & (2 << 5)) && IN(p0 + 5)) { pg::SchedDense S{ROWS_REAL / 256, DM / 256, (ROWS_REAL / 256) * (DM / 256), og(c.G), og(c.bid), (const char*)c.WOUT()}; pg::EpiResid E{c.H(), DM};
            DLY(5, pg::gemm_phase(l3, c.wid, (const char*)c.MIX(), MIXW * 2, S, E)); small_outproj(c); }
        SEAM(p0 + 5);
        if ((PH_MASK & (2 << 6)) && IN(p0 + 6)) { REP(6) { __syncthreads(); phase_norm<true>(c, layer); } }
        SEAM(p0 + 6);
        if ((PH_MASK & (2 << 7)) && IN(p0 + 7)) { REP(7) phase_topk(c); }
        SEAM(p0 + 7);
        if ((PH_MASK & (2 << 8)) && IN(p0 + 8)) { pg::SchedMoE1 S{og(c.G), og(c.bid), c.RIDX(), (const char*)c.WGU()}; pg::EpiGateUp E{c.ACT()};
            REP(8) pg::gemm_phase(l3, c.wid, (const char*)c.U8(), DM, S, E); for (int sr_ = 0; sr_ < SMALL_REP; ++sr_) small_gateup(c); }
        SEAM(p0 + 8);
        if ((PH_MASK & (2 << 9)) && IN(p0 + 9)) { pg::SchedMoE2 S{og(c.G), og(c.bid), c.IDT(), (const char*)c.WD()}; pg::EpiDown E{c.Y(), c.GATE()};
            REP(9) pg::gemm_phase(l3, c.wid, (const char*)c.ACT(), FF, S, E); for (int sr_ = 0; sr_ < SMALL_REP; ++sr_) small_down(c); }
        SEAM(p0 + 9);
    }
    if ((PH_MASK & (2 << 10)) && IN(NPH - 1)) { DLY(11, phase_final(c)); }
#undef IN
#undef SEAM
}

extern "C" void kernel_launch(void* const* d_in, const int* in_sizes, int n_in, void* d_out, int out_size, void* d_ws, size_t ws_size, hipStream_t stream) {
    static int grid = 0;
    if (grid == 0) {
        if (n_in != 21 || out_size != ROWS_REAL * DM || ws_size < WS_END) { fprintf(stderr, "kernel_launch: unexpected problem (n_in %d, out %d, ws %zu)\n", n_in, out_size, ws_size); grid = -1; return; }
        int dev = 0, cus = 0, per_cu = 0;
        if (hipGetDevice(&dev) != hipSuccess || hipDeviceGetAttribute(&cus, hipDeviceAttributeMultiprocessorCount, dev) != hipSuccess) { grid = -1; return; }
        if (hipFuncSetAttribute((const void*)mega, hipFuncAttributeMaxDynamicSharedMemorySize, LDS_BYTES) != hipSuccess) { fprintf(stderr, "kernel_launch: hipFuncSetAttribute failed\n"); grid = -1; return; }
        if (hipOccupancyMaxActiveBlocksPerMultiprocessor(&per_cu, (const void*)mega, 512, LDS_BYTES) != hipSuccess || per_cu < 1) fprintf(stderr, "kernel_launch: occupancy query says %d\n", per_cu);
        (void)hipGetLastError();
        grid = cus;
    }
    if (grid < 0) return;
    (void)hipMemsetAsync((char*)d_ws + WS_CTL, 0, CTL_BYTES, stream);
    Args a{};
    for (int i = 0; i < 21; ++i) a.in[i] = (const float*)d_in[i];
    a.out = (float*)d_out; a.ws = (unsigned char*)d_ws;
#if LAUNCH_PER_PHASE
    for (int ph = 0; ph < NPH; ++ph) { a.ph_lo = ph; a.ph_hi = ph + 1; hipLaunchKernelGGL(mega, dim3(grid), dim3(512), LDS_BYTES, stream, a); }
#else
    a.ph_lo = 0; a.ph_hi = NPH; hipLaunchKernelGGL(mega, dim3(grid), dim3(512), LDS_BYTES, stream, a);
#endif
}
```

```cpp
#include <hip/hip_runtime.h>
#include <cstdio>
#include <cstdint>

#define LAS __attribute__((address_space(3)))
typedef unsigned short bf16_t;
typedef short bf16x8 __attribute__((ext_vector_type(8)));
typedef float f32x4 __attribute__((ext_vector_type(4)));
typedef float f32x2 __attribute__((ext_vector_type(2)));
typedef unsigned u32x4 __attribute__((ext_vector_type(4)));
typedef unsigned u32x2 __attribute__((ext_vector_type(2)));

#ifndef PH_MASK
#define PH_MASK 0xFFFFF
#endif
#ifndef SMALL_REP
#define SMALL_REP 1
#endif
#ifndef PROBE_PH
#define PROBE_PH -1
#endif
#define REP(k) for (int rep_ = 0; rep_ < ((PROBE_PH == (k)) ? 2 : 1); ++rep_)
#define DLY(k, body) do { if (PROBE_PH == (k)) { const unsigned long long t0_ = __builtin_amdgcn_s_memrealtime(); body; __syncthreads(); const unsigned long long t1_ = __builtin_amdgcn_s_memrealtime(); while (__builtin_amdgcn_s_memrealtime() - t1_ < t1_ - t0_) __builtin_amdgcn_s_sleep(8); } else { body; } } while (0)
#ifndef LAUNCH_PER_PHASE
#define LAUNCH_PER_PHASE 0
#endif

constexpr int DM = 1024, NB = 8, SEQ = 4096, DEPTH = 4, NMETA = 16, LTOK = SEQ + NMETA;
constexpr int ROWS_REAL = NB * SEQ, ROWS = NB * LTOK, ROWS_PAD = 33024;
constexpr int INW = 4624, PROJW = 4608;
constexpr int C_AQ = 0, C_AK = 512, C_AV = 640, C_HQ = 768, C_HF = 1280, C_HB = 1792, C_HI = 2304, C_HG = 2816, C_SZ = 3328, C_XBC = 3840, C_DT = 4608;
constexpr int MIXW = 1536, NEXP = 16, FF = 2048, CAP = 514, EROWS = 4352, MOE_ROWS = NEXP * EROWS;
constexpr float EPS = 1e-6f;
constexpr float QSCALE = 0.125f * 1.4426950408889634f;

constexpr size_t MiB = 1u << 20;
constexpr size_t WS_CTL = 0, CTL_BYTES = 1 * MiB;
constexpr size_t WS_ROPE = 1 * MiB;
constexpr size_t WS_LB = WS_ROPE + 2u * 4096 * 32 * 4;
constexpr size_t WS_H = 3 * MiB;
constexpr size_t WS_U = 133 * MiB;
constexpr size_t WS_DT = 198 * MiB;
constexpr size_t WS_AFFT = 201 * MiB;
constexpr size_t WS_SEL = 204 * MiB;
constexpr size_t WS_RIDX = 207 * MiB;
constexpr size_t WS_GATE = 208 * MiB;
constexpr size_t WS_IDT = 208 * MiB + 512 * 1024;
constexpr size_t WS_XBC = 209 * MiB;
constexpr size_t WS_ATT = 258 * MiB;
constexpr size_t WS_OF = 291 * MiB, WS_OB = 324 * MiB, WS_YF = 357 * MiB, WS_YB = 390 * MiB;
constexpr size_t WS_MIX = 423 * MiB;
constexpr size_t WS_PROJ = 520 * MiB;
constexpr size_t WS_ACT = WS_PROJ;
constexpr size_t WS_Y = 811 * MiB;
constexpr size_t WS_WIN = 947 * MiB;
constexpr size_t WS_WOUT = 956 * MiB;
constexpr size_t WS_WGU = 959 * MiB;
constexpr size_t WS_WSTRIDE = 109 * MiB;
constexpr size_t WS_WGU_UNUSED_ = 0;
constexpr size_t WS_WD = 1023 * MiB;
constexpr size_t WS_END = 1166 * MiB;

constexpr int LDS_BYTES = 147456;
constexpr int LDS_MISC = 145408;

typedef __bf16 bf16x2_t __attribute__((ext_vector_type(2)));
__device__ __forceinline__ unsigned cvt_pk_bf16(float lo, float hi) { f32x2 v = {lo, hi}; bf16x2_t b = __builtin_convertvector(v, bf16x2_t); return __builtin_bit_cast(unsigned, b); }
__device__ __forceinline__ unsigned pk4_fp8(float a, float b, float c, float d) { int w = __builtin_amdgcn_cvt_pk_fp8_f32(a, b, 0, false); w = __builtin_amdgcn_cvt_pk_fp8_f32(c, d, w, true); return (unsigned)w; }
__device__ __forceinline__ bf16_t f2bf(float f) { return (bf16_t)(cvt_pk_bf16(f, 0.f) & 0xffffu); }
__device__ __forceinline__ float bf2f(bf16_t b) { return __uint_as_float(((unsigned)b) << 16); }
__device__ __forceinline__ float bflo(unsigned w) { return __uint_as_float(w << 16); }
__device__ __forceinline__ float bfhi(unsigned w) { return __uint_as_float(w & 0xffff0000u); }
__device__ __forceinline__ float shx(float v, int m, int lane) { return __int_as_float(__builtin_amdgcn_ds_bpermute((lane ^ m) << 2, __float_as_int(v))); }
__device__ __forceinline__ int shl_i(int v, int src) { return __builtin_amdgcn_ds_bpermute(src << 2, v); }
__device__ __forceinline__ float shl_f(float v, int src) { return __int_as_float(__builtin_amdgcn_ds_bpermute(src << 2, __float_as_int(v))); }
__device__ __forceinline__ float shup_f(float v, int o, int lane) { return __int_as_float(__builtin_amdgcn_ds_bpermute((lane >= o ? lane - o : lane) << 2, __float_as_int(v))); }
__device__ __forceinline__ unsigned shup_u(unsigned v, int o, int lane) { return (unsigned)__builtin_amdgcn_ds_bpermute((lane >= o ? lane - o : lane) << 2, (int)v); }
__device__ __forceinline__ float wave_sum(float v, int lane) {
#pragma unroll
    for (int o = 1; o < 64; o <<= 1) v += shx(v, o, lane);
    return v;
}
__device__ __forceinline__ void lds_barrier() { asm volatile("s_waitcnt lgkmcnt(0)\n\ts_barrier" ::: "memory"); }
__device__ __forceinline__ float silu_f(float x) { return x * __builtin_amdgcn_rcpf(1.0f + __expf(-x)); }
__device__ __forceinline__ float fgate_f(float x, float lb) { const float e = __expf(-x), ec = fminf(e, 1.0686474581524463e13f); return fminf((1.0f + lb * ec) * __builtin_amdgcn_rcpf(1.0f + e), 1.0f); }
__device__ __forceinline__ int row_of(int b, int t) { return t < NMETA ? ROWS_REAL + b * NMETA + t : b * SEQ + (t - NMETA); }

#define XB_TMO      128
#define XB_XCNT(j)  (256  + 64 * (j))
#define XB_XSUB(j)  (1280 + 64 * (j))
#define XB_XGEN(j)  (2304 + 64 * (j))
#define XB_TOP      3328
#define XB_TOPGEN   3392
#define XCD_BAR_WORDS 3456
#define XB_SPIN_CAP (1u << 18)
__device__ __forceinline__ unsigned xb_ld(unsigned* p)              { return __hip_atomic_load(p, __ATOMIC_RELAXED, __HIP_MEMORY_SCOPE_AGENT); }
__device__ __forceinline__ unsigned xb_add(unsigned* p, unsigned v) { return __hip_atomic_fetch_add(p, v, __ATOMIC_RELAXED, __HIP_MEMORY_SCOPE_AGENT); }
__device__ __forceinline__ unsigned xb_xcc_id() { return (unsigned)__builtin_amdgcn_s_getreg((3 << 11) | 20) & 0xFu; }
#define XB_SPIN(cond, bar) do { unsigned _sp = 0; while (cond) { __builtin_amdgcn_s_sleep(1); \
    if ((++_sp & 255u) == 0u) { if (xb_ld(&(bar)[XB_TMO])) break; if (_sp > XB_SPIN_CAP) { atomicAdd(&(bar)[XB_TMO], 1u); break; } } } } while (0)
struct XcdBarrier { unsigned* bar; unsigned x; volatile LAS unsigned* st; };
__device__ __forceinline__ XcdBarrier xcd_barrier_post(unsigned* bar, volatile LAS unsigned* st) {
    XcdBarrier b; b.bar = bar; b.x = xb_xcc_id(); b.st = st;
    if (threadIdx.x == 0) (void)xb_add(&bar[XB_XCNT(b.x)], 1u);
    return b;
}
__device__ __forceinline__ void xcd_barrier_complete(unsigned* bar, unsigned x, unsigned& nloc, unsigned& nx) {
    const unsigned G = gridDim.x * gridDim.y * gridDim.z;
    unsigned sum, cnt, mine, sp = 0u;
    for (;;) {
        sum = 0u; cnt = 0u; mine = 0u;
#pragma unroll
        for (unsigned j = 0; j < 16; ++j) { const unsigned c = xb_ld(&bar[XB_XCNT(j)]); sum += c; cnt += (c > 0u) ? 1u : 0u; mine = (j == x) ? c : mine; }
        if (sum == G) break;
        __builtin_amdgcn_s_sleep(1);
        if ((++sp & 255u) == 0u) { if (xb_ld(&bar[XB_TMO])) break; if (sp > XB_SPIN_CAP) { atomicAdd(&bar[XB_TMO], 1u); break; } }
    }
    nloc = mine > 0u ? mine : 1u; nx = cnt > 0u ? cnt : 1u;
}
__device__ __forceinline__ void xcd_barrier(const XcdBarrier& b, const int wid) {
    asm volatile("s_waitcnt vmcnt(0)" ::: "memory");
    __syncthreads();
    unsigned zb_ = 0u; asm volatile("" : "+s"(zb_));
    if (wid == 0 && __builtin_amdgcn_mbcnt_hi(~0u, __builtin_amdgcn_mbcnt_lo(~0u, zb_)) == 0u) {
        unsigned* bar = b.bar;
        __builtin_amdgcn_s_waitcnt(0);
        unsigned nloc = b.st[0], nx = b.st[1];
        if (nloc == 0u) { xcd_barrier_complete(bar, b.x, nloc, nx); b.st[0] = nloc; b.st[1] = nx; }
        const unsigned old = xb_add(&bar[XB_XSUB(b.x)], 1u);
        const unsigned gen = old / nloc;
        if (old + 1u == (gen + 1u) * nloc) {
            __builtin_amdgcn_fence(__ATOMIC_RELEASE, "agent");
            asm volatile("s_waitcnt vmcnt(0)" ::: "memory");
            const unsigned og = xb_add(&bar[XB_TOP], 1u);
            const unsigned tg = og / nx;
            if (og + 1u == (tg + 1u) * nx) xb_add(&bar[XB_TOPGEN], 1u);
            else XB_SPIN(xb_ld(&bar[XB_TOPGEN]) == tg, bar);
            __builtin_amdgcn_fence(__ATOMIC_ACQUIRE, "agent");
            xb_add(&bar[XB_XGEN(b.x)], 1u);
            asm volatile("s_waitcnt vmcnt(0)" ::: "memory");
        } else {
            XB_SPIN(xb_ld(&bar[XB_XGEN(b.x)]) == gen, bar);
            __builtin_amdgcn_fence(__ATOMIC_ACQUIRE, "agent");
            asm volatile("s_waitcnt vmcnt(0)" ::: "memory");
        }
    }
    __syncthreads();
}

namespace pg {
typedef int v4i_t __attribute__((ext_vector_type(4)));
typedef int v8i_t __attribute__((ext_vector_type(8)));
constexpr int BM = 256, BK = 64, HALF = 128, HTB = HALF * BK * 2, STAGE_BYTES = 8 * HTB;
__device__ __forceinline__ int lds_byte(int r, int c) { const int st = (r >> 4) * 2 + (c >> 5), rr = r & 15, cc = c & 31, ob = rr * 64 + cc * 2; return st * 1024 + (ob ^ (((ob >> 9) & 1) << 5)); }
__device__ __forceinline__ void stage_rc(int b, int& R, int& C) { const int st = b / 1024, sb = b % 1024, swz = sb ^ (((sb >> 9) & 1) << 5); R = (st >> 1) * 16 + swz / 64; C = (st & 1) * 32 + (swz % 64) / 2; }
__device__ __forceinline__ int perm32(int rho) { const int n = rho >> 4, i = rho & 15; return 8 * (i >> 2) + 4 * n + (i & 3); }
struct Unit { int pm, pn, e; };

template <class Epi, class Sched>
__device__ __forceinline__ void gemm_phase(LAS unsigned char* lds, const int wid_in, const char* Abase, const int K  , const Sched& S, const Epi& E) {
    int wid = wid_in; asm volatile("" : "+s"(wid));
    unsigned z_ = 0u; asm volatile("" : "+s"(z_));
    const int lane = (int)__builtin_amdgcn_mbcnt_hi(~0u, __builtin_amdgcn_mbcnt_lo(~0u, z_)), tid = wid * 64 + lane;
    const int wr = wid >> 2, wc = wid & 3, fr = lane & 15, fq = lane >> 4;
    const int nt = K / 128;
    constexpr bool F8 = Sched::F8;
    constexpr bool GA = Sched::GATHER;
    unsigned voffA[2], voffB[2];
#pragma unroll
    for (int i = 0; i < 2; ++i) { int R, C; stage_rc(tid * 16 + i * 8192, R, C); const int Rb = Epi::PERM ? ((R & ~31) + perm32(R & 31)) : R; voffA[i] = (unsigned)(R * K + C * 2); voffB[i] = (unsigned)(Rb * K + C * 2); }
    const size_t kstep = (size_t)(BK * 2);
    const size_t hstep = (size_t)HALF * K;
    const unsigned ldsw = (unsigned)wid * 1024u;
    const int aoff = lds_byte(wr * 64 + fr, fq * 8), boff = lds_byte(wc * 32 + fr, fq * 8);
#define PG_SA(b, h) (((b) * 2 + (h)) * HTB)
#define PG_SB(b, h) ((4 + (b) * 2 + (h)) * HTB)
#define PG_STAGE(bufoff, gbase, voff) do { _Pragma("unroll") for (int _i = 0; _i < 2; ++_i) \
        __builtin_amdgcn_global_load_lds((const unsigned*)((const char*)(gbase) + (voff)[_i]), (LAS unsigned*)(lds + (bufoff) + ldsw + _i * 8192), 16, 0, 0); } while (0)
#define PG_STAGE_A(bufoff, ab, av, h, koff) do { if (GA) { const u32x2 o2_ = *(const LAS u32x2*)(aol + 2 * (h)); unsigned ov_[2] = {o2_.x, o2_.y}; PG_STAGE(bufoff, Abase + (koff), ov_); } else { PG_STAGE(bufoff, (ab) + (h) * hstep + (koff), voffA); } } while (0)
#define PG_LDA(dst, b, h) do { _Pragma("unroll") for (int m = 0; m < 4; ++m) _Pragma("unroll") for (int k = 0; k < 2; ++k) dst[m][k] = *(const LAS bf16x8*)(lds + PG_SA(b, h) + aoff + m * 2048 + k * 1024); } while (0)
#define PG_LDB(dst, b, h) do { _Pragma("unroll") for (int n = 0; n < 2; ++n) _Pragma("unroll") for (int k = 0; k < 2; ++k) dst[n][k] = *(const LAS bf16x8*)(lds + PG_SB(b, h) + boff + n * 2048 + k * 1024); } while (0)
#define PG_CAT8(lo, hi) __builtin_shufflevector(__builtin_bit_cast(v4i_t, lo), __builtin_bit_cast(v4i_t, hi), 0, 1, 2, 3, 4, 5, 6, 7)
#define PG_MMA(ai, bj, At, Bt) do { __builtin_amdgcn_s_setprio(1); _Pragma("unroll") for (int m = 0; m < 4; ++m) _Pragma("unroll") for (int n = 0; n < 2; ++n) { \
        if (F8) acc[ai][bj][m][n] = __builtin_amdgcn_mfma_scale_f32_16x16x128_f8f6f4(PG_CAT8(Bt[n][0], Bt[n][1]), PG_CAT8(At[m][0], At[m][1]), acc[ai][bj][m][n], 0, 0, 0, 122, 0, 127); \
        else { _Pragma("unroll") for (int k = 0; k < 2; ++k) acc[ai][bj][m][n] = __builtin_amdgcn_mfma_f32_16x16x32_bf16(Bt[n][k], At[m][k], acc[ai][bj][m][n], 0, 0, 0); } } __builtin_amdgcn_s_setprio(0); } while (0)
#define PG_WAIT_V(n) asm volatile("s_waitcnt vmcnt(" #n ")" ::: "memory")
#define PG_WAIT_L(n) asm volatile("s_waitcnt lgkmcnt(" #n ")" ::: "memory")
#define PG_BAR __builtin_amdgcn_s_barrier()
#define PG_SCHED __builtin_amdgcn_sched_barrier(0)
    Unit cur, nxt; int ui = 0;
    if (!S.next(0, cur)) return;
    LAS int* rtab = (LAS int*)(lds + STAGE_BYTES);
    LAS unsigned* aol = (LAS unsigned*)(lds + STAGE_BYTES + 2048) + tid * 4;
#define PG_AO_FROM_TABLE(tb) do { u32x4 o_; { int R_, C_; stage_rc(tid * 16, R_, C_); o_.x = (unsigned)(rtab[(tb) * 256 + R_] * K + C_ * 2); o_.z = (unsigned)(rtab[(tb) * 256 + 128 + R_] * K + C_ * 2); } \
        { int R_, C_; stage_rc(tid * 16 + 8192, R_, C_); o_.y = (unsigned)(rtab[(tb) * 256 + R_] * K + C_ * 2); o_.w = (unsigned)(rtab[(tb) * 256 + 128 + R_] * K + C_ * 2); } *(LAS u32x4*)aol = o_; } while (0)
    if (GA) { if (tid < 256) rtab[tid] = S.arow(cur, tid); __syncthreads(); PG_AO_FROM_TABLE(0); }
    const char* cA = GA ? Abase : Abase + S.aunit(cur, K);
    const char* cB = S.bptr(cur, K);
    f32x4 acc[2][2][4][2];
#pragma unroll
    for (int a = 0; a < 2; ++a)
#pragma unroll
        for (int b = 0; b < 2; ++b)
#pragma unroll
            for (int m = 0; m < 4; ++m)
#pragma unroll
                for (int n = 0; n < 2; ++n) acc[a][b][m][n] = (f32x4){0.f, 0.f, 0.f, 0.f};
    bf16x8 At[4][2], B0[2][2], B1[2][2];
    PG_STAGE(PG_SB(0, 0), cB, voffB); PG_STAGE(PG_SB(0, 1), cB + hstep, voffB); PG_STAGE_A(PG_SA(0, 0), cA, 0, 0, 0); PG_STAGE_A(PG_SA(0, 1), cA, 0, 1, 0);
    if (wr == 1) PG_BAR;
    PG_WAIT_V(2); PG_BAR;
    PG_STAGE(PG_SB(1, 0), cB + kstep, voffB); PG_STAGE_A(PG_SA(1, 0), cA, 0, 0, kstep); PG_STAGE(PG_SB(1, 1), cB + hstep + kstep, voffB);
    PG_WAIT_V(6); PG_BAR;
    for (;;) {
        const bool has_next = S.next(ui + 1, nxt);
        const char* nA = cA; const char* nB = cB;
        if (has_next) { if (GA) { if (wid < 4) __builtin_amdgcn_global_load_lds((const unsigned*)S.arowp(nxt, tid), (LAS unsigned*)(rtab + ((ui + 1) & 1) * 256 + wid * 64), 4, 0, 0); }
            else nA = Abase + S.aunit(nxt, K); nB = S.bptr(nxt, K); }
        for (int t = 0; t < nt; t += 2) {
            const bool last = (t == nt - 2);
            const size_t k1 = (size_t)(t + 1) * kstep, k2 = last ? 0 : (size_t)(t + 2) * kstep, k3 = k2 + kstep;
            const char* a2 = last ? nA : cA; const char* b2 = last ? nB : cB;
            PG_LDB(B0, 0, 0); PG_LDB(B1, 0, 1); PG_SCHED; PG_LDA(At, 0, 0); PG_STAGE_A(PG_SA(1, 1), cA, 0, 1, k1);
            if (GA && last && has_next) { PG_AO_FROM_TABLE((ui + 1) & 1); }
            PG_WAIT_V(8); PG_WAIT_L(0); PG_BAR; PG_MMA(0, 0, At, B0); PG_MMA(0, 1, At, B1); PG_BAR; PG_SCHED;
            PG_LDA(At, 0, 1); PG_STAGE(PG_SB(0, 0), b2 + k2, voffB); PG_STAGE(PG_SB(0, 1), b2 + hstep + k2, voffB); PG_STAGE_A(PG_SA(0, 0), a2, 0, 0, k2);
            PG_WAIT_V(8); PG_WAIT_L(0); PG_BAR; PG_MMA(1, 0, At, B0); PG_MMA(1, 1, At, B1); PG_BAR; PG_SCHED;
            PG_LDB(B0, 1, 0); PG_LDB(B1, 1, 1); PG_SCHED; PG_LDA(At, 1, 0); PG_STAGE_A(PG_SA(0, 1), a2, 0, 1, k2);
            PG_WAIT_V(8); PG_WAIT_L(0); PG_BAR; PG_MMA(0, 0, At, B0); PG_MMA(0, 1, At, B1); PG_BAR; PG_SCHED;
            PG_LDA(At, 1, 1); PG_STAGE(PG_SB(1, 0), b2 + k3, voffB); PG_STAGE(PG_SB(1, 1), b2 + hstep + k3, voffB); PG_STAGE_A(PG_SA(1, 0), a2, 0, 0, k3);
            PG_WAIT_V(8); PG_WAIT_L(0); PG_BAR; PG_MMA(1, 0, At, B0); PG_MMA(1, 1, At, B1); PG_BAR; PG_SCHED;
        }
        if (wr == 0) PG_BAR;
        E(acc, cur, wr, wc, fr, fq);
        if (!has_next) break;
#pragma unroll
        for (int a = 0; a < 2; ++a)
#pragma unroll
            for (int b = 0; b < 2; ++b)
#pragma unroll
                for (int m = 0; m < 4; ++m)
#pragma unroll
                    for (int n = 0; n < 2; ++n) acc[a][b][m][n] = (f32x4){0.f, 0.f, 0.f, 0.f};
        cur = nxt; cA = nA; cB = nB; ++ui;
        if (wr == 1) PG_BAR;
    }
    PG_WAIT_V(0);
    PG_BAR;
#undef PG_SA
#undef PG_SB
#undef PG_STAGE
#undef PG_STAGE_A
#undef PG_AO_FROM_TABLE
#undef PG_LDA
#undef PG_LDB
#undef PG_MMA
#undef PG_CAT8
#undef PG_WAIT_V
#undef PG_WAIT_L
#undef PG_BAR
#undef PG_SCHED
}

struct SchedDense {
    static constexpr bool GATHER = false, F8 = false;
    int nM, nN, nwg, G, c; const char* Bt;
    __device__ __forceinline__ bool next(int i, Unit& u) const {
        const long L = (long)i * G + c; if (L >= nwg) return false;
        int wgid = (int)L; { const int q = nwg / 8, r = nwg % 8, xcd = wgid % 8, off = wgid / 8; wgid = (xcd < r ? xcd * (q + 1) : r * (q + 1) + (xcd - r) * q) + off; }
        const int nig = 8 * nN, gid = wgid / nig, fm = gid * 8, gsz = (nM - fm) < 8 ? (nM - fm) : 8;
        u.pm = fm + ((wgid % nig) % gsz); u.pn = (wgid % nig) / gsz; u.e = 0; return true;
    }
    __device__ __forceinline__ int arow(const Unit&, int) const { return 0; }
    __device__ __forceinline__ const int* arowp(const Unit&, int) const { return nullptr; }
    __device__ __forceinline__ size_t aunit(const Unit& u, int K) const { return (size_t)u.pm * 256 * K; }
    __device__ __forceinline__ const char* bptr(const Unit& u, int K) const { return Bt + (size_t)u.pn * 256 * K; }
};
struct SchedMoE1 {
    static constexpr bool GATHER = true, F8 = true;
    int G, c; const int* ridx; const char* Bt;
    __device__ __forceinline__ bool next(int i, Unit& u) const {
        if (G % 8 == 0) {
            const int x = c & 7, q = (c >> 3) + (G >> 3) * i; if (q >= NEXP * 32) return false;
            u.e = q >> 5; const int r = q & 31; u.pm = r >> 1; u.pn = 2 * x + (r & 1); return true; }
        const int L = i * G + c; if (L >= NEXP * 16 * 16) return false;
        u.e = L >> 8; const int rem = L & 255; u.pm = rem & 15; u.pn = rem >> 4; return true;
    }
    __device__ __forceinline__ int arow(const Unit& u, int r) const { return ridx[u.e * EROWS + u.pm * 256 + r]; }
    __device__ __forceinline__ const int* arowp(const Unit& u, int r) const { return ridx + u.e * EROWS + u.pm * 256 + r; }
    __device__ __forceinline__ size_t aunit(const Unit&, int) const { return 0; }
    __device__ __forceinline__ const char* bptr(const Unit& u, int K) const { return Bt + ((size_t)u.e * 4096 + (size_t)u.pn * 256) * K; }
};
struct SchedMoE2 {
    static constexpr bool GATHER = true, F8 = true;
    int G, c; const int* idt; const char* Bt;
    __device__ __forceinline__ bool next(int i, Unit& u) const {
        if (G % 8 == 0) {
            const int x = c & 7, q = (c >> 3) + (G >> 3) * i; if (q >= 128) return false;
            u.e = 2 * x + (q >> 6); const int r = q & 63; u.pm = r >> 2; u.pn = r & 3; return true; }
        const int L = i * G + c; if (L >= NEXP * 16 * 4) return false;
        u.e = L >> 6; const int rem = L & 63; u.pm = rem & 15; u.pn = rem >> 4; return true;
    }
    __device__ __forceinline__ int arow(const Unit& u, int r) const { return u.e * EROWS + u.pm * 256 + r; }
    __device__ __forceinline__ const int* arowp(const Unit& u, int r) const { return idt + u.e * EROWS + u.pm * 256 + r; }
    __device__ __forceinline__ size_t aunit(const Unit&, int) const { return 0; }
    __device__ __forceinline__ const char* bptr(const Unit& u, int K) const { return Bt + ((size_t)u.e * 1024 + (size_t)u.pn * 256) * K; }
};

struct EpiProj {
    static constexpr bool PERM = true;
    bf16_t* O; int ldc; const float* lbf; const float* lbb;
    __device__ __forceinline__ void operator()(const f32x4 (&acc)[2][2][4][2], const Unit& u, int wr, int wc, int fr, int fq) const {
        const int row0 = u.pm * BM + wr * 64 + fr, col0 = u.pn * BM + wc * 32 + 8 * fq;
        const int mode = (u.pn == 3 || u.pn == 4) ? 1 : ((u.pn >= 5 && u.pn <= 8) ? 2 : 0);
#pragma unroll
        for (int bj = 0; bj < 2; ++bj) {
            float lb[8];
            if (mode == 2) { const float* lp = (u.pn <= 6 ? lbf + (u.pn - 5) * 256 : lbb + (u.pn - 7) * 256) + wc * 32 + 8 * fq + bj * HALF; const f32x4 a = *(const f32x4*)lp, b = *(const f32x4*)(lp + 4);
#pragma unroll
                for (int j = 0; j < 4; ++j) { lb[j] = a[j]; lb[4 + j] = b[j]; } }
#pragma unroll
            for (int ai = 0; ai < 2; ++ai)
#pragma unroll
                for (int m = 0; m < 4; ++m) { bf16_t* rowp = O + (size_t)(row0 + ai * HALF + m * 16) * ldc + col0; float v[8];
#pragma unroll
                    for (int j = 0; j < 4; ++j) { v[j] = acc[ai][bj][m][0][j]; v[4 + j] = acc[ai][bj][m][1][j]; }
                    if (mode == 1) {
#pragma unroll
                        for (int j = 0; j < 8; ++j) v[j] = silu_f(v[j]); }
                    else if (mode == 2) {
#pragma unroll
                        for (int j = 0; j < 8; ++j) v[j] = fgate_f(v[j], lb[j]); }
                    u32x4 w; w.x = cvt_pk_bf16(v[0], v[1]); w.y = cvt_pk_bf16(v[2], v[3]); w.z = cvt_pk_bf16(v[4], v[5]); w.w = cvt_pk_bf16(v[6], v[7]);
                    *(u32x4*)(rowp + bj * HALF) = w; } }
    }
};
struct EpiResid {
    static constexpr bool PERM = true;
    bf16_t* H; int ldc;
    __device__ __forceinline__ void operator()(const f32x4 (&acc)[2][2][4][2], const Unit& u, int wr, int wc, int fr, int fq) const {
        const int row0 = u.pm * BM + wr * 64 + fr, col0 = u.pn * BM + wc * 32 + 8 * fq;
#pragma unroll
        for (int ai = 0; ai < 2; ++ai)
#pragma unroll
            for (int m = 0; m < 4; ++m) { bf16_t* rowp = H + (size_t)(row0 + ai * HALF + m * 16) * ldc + col0;
#pragma unroll
                for (int bj = 0; bj < 2; ++bj) { u32x4* p = (u32x4*)(rowp + bj * HALF); const u32x4 w = *p; const f32x4 v0 = acc[ai][bj][m][0], v1 = acc[ai][bj][m][1];
                    u32x4 o; o.x = cvt_pk_bf16(bflo(w.x) + v0[0], bfhi(w.x) + v0[1]); o.y = cvt_pk_bf16(bflo(w.y) + v0[2], bfhi(w.y) + v0[3]); o.z = cvt_pk_bf16(bflo(w.z) + v1[0], bfhi(w.z) + v1[1]); o.w = cvt_pk_bf16(bflo(w.w) + v1[2], bfhi(w.w) + v1[3]);
                    *p = o; } }
    }
};
struct EpiGateUp {
    static constexpr bool PERM = true;
    unsigned char* ACT;
    __device__ __forceinline__ void operator()(const f32x4 (&acc)[2][2][4][2], const Unit& u, int wr, int wc, int fr, int fq) const {
        const int row0 = u.e * EROWS + u.pm * BM + wr * 64 + fr, col0 = u.pn * 128 + wc * 32 + 8 * fq;
#pragma unroll
        for (int ai = 0; ai < 2; ++ai)
#pragma unroll
            for (int m = 0; m < 4; ++m) { unsigned char* p = ACT + (size_t)(row0 + ai * HALF + m * 16) * FF + col0;
                float r[8];
#pragma unroll
                for (int n = 0; n < 2; ++n)
#pragma unroll
                    for (int j = 0; j < 4; ++j) r[n * 4 + j] = silu_f(acc[ai][0][m][n][j]) * acc[ai][1][m][n][j];
                u32x2 w; w.x = pk4_fp8(r[0], r[1], r[2], r[3]); w.y = pk4_fp8(r[4], r[5], r[6], r[7]);
                *(u32x2*)p = w; }
    }
};
struct EpiDown {
    static constexpr bool PERM = true;
    unsigned char* Y; const float* gate;
    __device__ __forceinline__ void operator()(const f32x4 (&acc)[2][2][4][2], const Unit& u, int wr, int wc, int fr, int fq) const {
        const int row0 = u.e * EROWS + u.pm * BM + wr * 64 + fr, col0 = u.pn * BM + wc * 32 + 8 * fq;
#pragma unroll
        for (int ai = 0; ai < 2; ++ai)
#pragma unroll
            for (int m = 0; m < 4; ++m) { const unsigned row = (unsigned)(row0 + ai * HALF + m * 16); const float g = 16.0f * *(const float*)((const char*)gate + row * 4u); const unsigned off = row * (unsigned)DM + (unsigned)col0;
#pragma unroll
                for (int bj = 0; bj < 2; ++bj) { const f32x4 v0 = acc[ai][bj][m][0] * g, v1 = acc[ai][bj][m][1] * g;
                    u32x2 w; w.x = pk4_fp8(v0[0], v0[1], v0[2], v0[3]); w.y = pk4_fp8(v1[0], v1[1], v1[2], v1[3]);
                    *(u32x2*)(Y + off + bj * HALF) = w; } }
    }
};
}

template <int NACC>
__device__ __forceinline__ void small_gemm16(const bf16_t* arow, const bf16_t* const (&brow)[NACC], const int K, f32x4 (&acc)[NACC], const int lane) {
    const bf16_t* ap = arow + 32 * (lane >> 4);
    const bf16_t* bp[NACC];
#pragma unroll
    for (int n = 0; n < NACC; ++n) { bp[n] = brow[n] + 32 * (lane >> 4); acc[n] = (f32x4){0.f, 0.f, 0.f, 0.f}; }
    bf16x8 a0[4], b0[NACC][4], a1[4], b1[NACC][4];
#define SG_LOAD(A_, B_, k0_) do { _Pragma("unroll") for (int s2 = 0; s2 < 4; ++s2) { A_[s2] = *(const bf16x8*)(ap + (k0_) + 8 * s2); \
        _Pragma("unroll") for (int n = 0; n < NACC; ++n) B_[n][s2] = *(const bf16x8*)(bp[n] + (k0_) + 8 * s2); } } while (0)
#define SG_MMA(A_, B_) do { _Pragma("unroll") for (int s2 = 0; s2 < 4; ++s2) _Pragma("unroll") for (int n = 0; n < NACC; ++n) acc[n] = __builtin_amdgcn_mfma_f32_16x16x32_bf16(B_[n][s2], A_[s2], acc[n], 0, 0, 0); } while (0)
    SG_LOAD(a0, b0, 0);
    for (int k0 = 0; k0 < K; k0 += 256) {
        const bool two = k0 + 128 < K;
        if (two) SG_LOAD(a1, b1, k0 + 128);
        SG_MMA(a0, b0);
        if (two) { if (k0 + 256 < K) SG_LOAD(a0, b0, k0 + 256); SG_MMA(a1, b1); }
    }
#undef SG_LOAD
#undef SG_MMA
}

__device__ __forceinline__ void small_gemm16_2r(const bf16_t* arow0, const bf16_t* arow1, const bf16_t* brow, const int K, f32x4 (&acc)[2], const int lane) {
    const bf16_t* ap0 = arow0 + 32 * (lane >> 4); const bf16_t* ap1 = arow1 + 32 * (lane >> 4); const bf16_t* bp = brow + 32 * (lane >> 4);
    acc[0] = (f32x4){0.f, 0.f, 0.f, 0.f}; acc[1] = (f32x4){0.f, 0.f, 0.f, 0.f};
    bf16x8 a0[2][4], b0[4], a1[2][4], b1[4];
#define SG_LOAD(A_, B_, k0_) do { _Pragma("unroll") for (int s2 = 0; s2 < 4; ++s2) { A_[0][s2] = *(const bf16x8*)(ap0 + (k0_) + 8 * s2); A_[1][s2] = *(const bf16x8*)(ap1 + (k0_) + 8 * s2); B_[s2] = *(const bf16x8*)(bp + (k0_) + 8 * s2); } } while (0)
#define SG_MMA(A_, B_) do { _Pragma("unroll") for (int s2 = 0; s2 < 4; ++s2) { acc[0] = __builtin_amdgcn_mfma_f32_16x16x32_bf16(B_[s2], A_[0][s2], acc[0], 0, 0, 0); acc[1] = __builtin_amdgcn_mfma_f32_16x16x32_bf16(B_[s2], A_[1][s2], acc[1], 0, 0, 0); } } while (0)
    SG_LOAD(a0, b0, 0);
    for (int k0 = 0; k0 < K; k0 += 256) {
        const bool two = k0 + 128 < K;
        if (two) SG_LOAD(a1, b1, k0 + 128);
        SG_MMA(a0, b0);
        if (two) { if (k0 + 256 < K) SG_LOAD(a0, b0, k0 + 256); SG_MMA(a1, b1); }
    }
#undef SG_LOAD
#undef SG_MMA
}

template <int NACC>
__device__ __forceinline__ void small_gemm16_f8(const unsigned char* arow, const unsigned char* const (&brow)[NACC], const int K, f32x4 (&acc)[NACC], const int lane) {
    typedef long long2_t __attribute__((ext_vector_type(2)));
    const unsigned char* ap = arow + 32 * (lane >> 4);
    const unsigned char* bp[NACC];
#pragma unroll
    for (int n = 0; n < NACC; ++n) { bp[n] = brow[n] + 32 * (lane >> 4); acc[n] = (f32x4){0.f, 0.f, 0.f, 0.f}; }
    long2_t a0[2], b0[NACC][2], a1[2], b1[NACC][2];
#define SG_LOAD(A_, B_, k0_) do { _Pragma("unroll") for (int s2 = 0; s2 < 2; ++s2) { A_[s2] = *(const long2_t*)(ap + (k0_) + 16 * s2); \
        _Pragma("unroll") for (int n = 0; n < NACC; ++n) B_[n][s2] = *(const long2_t*)(bp[n] + (k0_) + 16 * s2); } } while (0)
#define SG_MMA(A_, B_) do { _Pragma("unroll") for (int s2 = 0; s2 < 2; ++s2) _Pragma("unroll") for (int h = 0; h < 2; ++h) _Pragma("unroll") for (int n = 0; n < NACC; ++n) \
        acc[n] = __builtin_amdgcn_mfma_f32_16x16x32_fp8_fp8(B_[n][s2][h], A_[s2][h], acc[n], 0, 0, 0); } while (0)
    SG_LOAD(a0, b0, 0);
    for (int k0 = 0; k0 < K; k0 += 256) {
        const bool two = k0 + 128 < K;
        if (two) SG_LOAD(a1, b1, k0 + 128);
        SG_MMA(a0, b0);
        if (two) { if (k0 + 256 < K) SG_LOAD(a0, b0, k0 + 256); SG_MMA(a1, b1); }
    }
#undef SG_LOAD
#undef SG_MMA
}

template <int NROW, int NACC, int K, int PF>
__device__ __forceinline__ void small_gemm16_bt(const bf16_t* const (&arow)[NROW], const bf16_t* const (&brow)[NACC], f32x4 (&acc)[NROW][NACC], const int lane) {
    constexpr int NSW = K / 128, NPRE = PF < NSW ? PF : NSW;
    const int ko = 32 * (lane >> 4);
    bf16x8 A[PF][NROW][4], B[PF][NACC][4];
#pragma unroll
    for (int r = 0; r < NROW; ++r)
#pragma unroll
        for (int n = 0; n < NACC; ++n) acc[r][n] = (f32x4){0.f, 0.f, 0.f, 0.f};
#define SG_LOAD(buf_, s_) do { _Pragma("unroll") for (int s2 = 0; s2 < 4; ++s2) { \
        _Pragma("unroll") for (int r = 0; r < NROW; ++r) A[buf_][r][s2] = *(const bf16x8*)(arow[r] + ko + (s_) * 128 + 8 * s2); \
        _Pragma("unroll") for (int n = 0; n < NACC; ++n) B[buf_][n][s2] = *(const bf16x8*)(brow[n] + ko + (s_) * 128 + 8 * s2); } } while (0)
#pragma unroll
    for (int s = 0; s < NPRE; ++s) SG_LOAD(s, s);
#pragma unroll
    for (int s = 0; s < NSW; ++s) {
#pragma unroll
        for (int s2 = 0; s2 < 4; ++s2)
#pragma unroll
            for (int r = 0; r < NROW; ++r)
#pragma unroll
                for (int n = 0; n < NACC; ++n) acc[r][n] = __builtin_amdgcn_mfma_f32_16x16x32_bf16(B[s % PF][n][s2], A[s % PF][r][s2], acc[r][n], 0, 0, 0);
        if (s + PF < NSW) SG_LOAD(s % PF, s + PF);
    }
#undef SG_LOAD
}
template <int NACC, int K, int PF>
__device__ __forceinline__ void small_gemm16_f8t(const unsigned char* arow, const unsigned char* const (&brow)[NACC], f32x4 (&acc)[NACC], const int lane) {
    typedef long long2_t __attribute__((ext_vector_type(2)));
    constexpr int NSW = K / 128, NPRE = PF < NSW ? PF : NSW;
    const int ko = 32 * (lane >> 4);
    long2_t A[PF][2], B[PF][NACC][2];
#pragma unroll
    for (int n = 0; n < NACC; ++n) acc[n] = (f32x4){0.f, 0.f, 0.f, 0.f};
#define SG_LOAD(buf_, s_) do { _Pragma("unroll") for (int s2 = 0; s2 < 2; ++s2) { A[buf_][s2] = *(const long2_t*)(arow + ko + (s_) * 128 + 16 * s2); \
        _Pragma("unroll") for (int n = 0; n < NACC; ++n) B[buf_][n][s2] = *(const long2_t*)(brow[n] + ko + (s_) * 128 + 16 * s2); } } while (0)
#pragma unroll
    for (int s = 0; s < NPRE; ++s) SG_LOAD(s, s);
#pragma unroll
    for (int s = 0; s < NSW; ++s) {
#pragma unroll
        for (int s2 = 0; s2 < 2; ++s2)
#pragma unroll
            for (int h = 0; h < 2; ++h)
#pragma unroll
                for (int n = 0; n < NACC; ++n) acc[n] = __builtin_amdgcn_mfma_f32_16x16x32_fp8_fp8(B[s % PF][n][s2][h], A[s % PF][s2][h], acc[n], 0, 0, 0);
        if (s + PF < NSW) SG_LOAD(s % PF, s + PF);
    }
#undef SG_LOAD
}

struct Args { const float* in[21]; float* out; unsigned char* ws; int ph_lo, ph_hi; };
enum { I_X = 0, I_META, I_NORM1, I_WIN, I_QNW, I_KNW, I_ANW, I_HLB, I_HNW, I_CONVW, I_CONVB, I_DTB, I_ALOG, I_DSKIP, I_SNW, I_WOUT, I_NORM2, I_ROUTER, I_WGATE, I_WUP, I_WDOWN };

struct Ctx {
    const Args* a; unsigned char* ws; LAS char* smem; int tid, lane, wid, G, bid, wbuf;
#define CTX_PTR(name, type, off) __device__ __forceinline__ type* name() const { return (type*)(ws + (off)); }
    CTX_PTR(H, bf16_t, WS_H) CTX_PTR(U, bf16_t, WS_U) CTX_PTR(DT, float, WS_DT) CTX_PTR(AFFT, float, WS_AFFT) CTX_PTR(SEL, int, WS_SEL) CTX_PTR(RIDX, int, WS_RIDX) CTX_PTR(GATE, float, WS_GATE) CTX_PTR(IDT, int, WS_IDT)
    CTX_PTR(XBC, bf16_t, WS_XBC) CTX_PTR(ATT, bf16_t, WS_ATT) CTX_PTR(OF, bf16_t, WS_OF) CTX_PTR(OB, bf16_t, WS_OB) CTX_PTR(YF, bf16_t, WS_YF) CTX_PTR(YB, bf16_t, WS_YB)
    CTX_PTR(MIX, bf16_t, WS_MIX) CTX_PTR(PROJ, bf16_t, WS_PROJ) CTX_PTR(ACT, unsigned char, WS_ACT) CTX_PTR(U8, unsigned char, WS_U) CTX_PTR(Y, unsigned char, WS_Y)
    CTX_PTR(WIN, bf16_t, WS_WIN + (size_t)wbuf * WS_WSTRIDE) CTX_PTR(WOUT, bf16_t, WS_WOUT + (size_t)wbuf * WS_WSTRIDE) CTX_PTR(WGU, unsigned char, WS_WGU + (size_t)wbuf * WS_WSTRIDE) CTX_PTR(WD, unsigned char, WS_WD + (size_t)wbuf * WS_WSTRIDE) CTX_PTR(ROPE, float, WS_ROPE) CTX_PTR(LB, float, WS_LB)
#undef CTX_PTR
};

__device__ __forceinline__ int og(int v) { v = __builtin_amdgcn_readfirstlane(v); asm volatile("" : "+s"(v)); return v; }
__device__ __forceinline__ Ctx fresh(const Ctx& c0) {
    Ctx c = c0; int w_ = __builtin_amdgcn_readfirstlane(c0.wid), g_ = __builtin_amdgcn_readfirstlane(c0.G), b_ = __builtin_amdgcn_readfirstlane(c0.bid); unsigned z_ = 0u; asm volatile("" : "+s"(w_), "+s"(g_), "+s"(b_), "+s"(z_)); c.wid = w_; c.G = g_; c.bid = b_;
    c.lane = (int)__builtin_amdgcn_mbcnt_hi(~0u, __builtin_amdgcn_mbcnt_lo(~0u, z_)); c.tid = w_ * 64 + c.lane;
    const unsigned long long wv_ = (unsigned long long)c0.ws; unsigned wl_ = __builtin_amdgcn_readfirstlane((unsigned)wv_), wh_ = __builtin_amdgcn_readfirstlane((unsigned)(wv_ >> 32)); asm volatile("" : "+s"(wl_), "+s"(wh_));
    c.ws = (unsigned char*)(((unsigned long long)wh_ << 32) | wl_); return c;
}
__device__ __forceinline__ void phase_tables(const Ctx& c0) {
    const Ctx c = fresh(c0);
    const int gt = c.bid * 512 + c.tid, gs = c.G * 512;
    for (int idx = gt; idx < 4096 * 32; idx += gs) {
        const int tok = idx >> 5, i = idx & 31;
        const float pos = (float)((i < 16) ? (tok >> 6) : (tok & 63));
        const float inv = powf(10000.0f, -(float)(i & 15) / 16.0f);
        const float ang = pos * inv;
        c.ROPE()[idx] = cosf(ang); c.ROPE()[4096 * 32 + idx] = sinf(ang);
    }
    for (int idx = gt; idx < 2 * 512; idx += gs) {
        const int dir = idx >> 9, d = idx & 511;
        const float* lbp = c.a->in[I_HLB] + (size_t)dir * DEPTH * 512 + d;
        float v[DEPTH], mx = -INFINITY;
        for (int l = 0; l < DEPTH; ++l) { v[l] = lbp[l * 512]; mx = fmaxf(mx, v[l]); }
        float s = 0.f; for (int l = 0; l < DEPTH; ++l) { v[l] = expf(v[l] - mx); s += v[l]; }
        float cum = 0.f;
        for (int l = 0; l < DEPTH; ++l) { const float p = v[l] / s; cum += p; const float lb = fminf(fmaxf(cum - v[0] / s, 0.f), 1.f); c.LB()[(dir * DEPTH + l) * 512 + d] = lb; }
    }
    for (int idx = gt; idx < MOE_ROWS; idx += gs) c.IDT()[idx] = idx;
    for (int idx = gt; idx < NEXP * (EROWS - NB * CAP); idx += gs) { const int e = idx / (EROWS - NB * CAP), r = idx % (EROWS - NB * CAP); c.RIDX()[e * EROWS + NB * CAP + r] = 0; }
}

__device__ __forceinline__ void convert_tile(const Ctx& c, const float* src, int ld_src, int k0, int n0, bf16_t* dst, int ld_dst, int nrow0, LAS float* T) {
    const int tid = c.tid;
    __syncthreads();
#pragma unroll
    for (int i = 0; i < 2; ++i) { const int k = (tid >> 4) + 32 * i, n4 = (tid & 15) * 4; const f32x4 v = *(const f32x4*)(src + (size_t)(k0 + k) * ld_src + n0 + n4);
        T[k * 65 + n4 + 0] = v[0]; T[k * 65 + n4 + 1] = v[1]; T[k * 65 + n4 + 2] = v[2]; T[k * 65 + n4 + 3] = v[3]; }
    __syncthreads();
    { const int n = tid >> 3, k8 = (tid & 7) * 8; float r[8];
#pragma unroll
      for (int j = 0; j < 8; ++j) r[j] = T[(k8 + j) * 65 + n];
      u32x4 w; w.x = cvt_pk_bf16(r[0], r[1]); w.y = cvt_pk_bf16(r[2], r[3]); w.z = cvt_pk_bf16(r[4], r[5]); w.w = cvt_pk_bf16(r[6], r[7]);
      *(u32x4*)(dst + (size_t)(nrow0 + n) * ld_dst + k0 + k8) = w; }
}
__device__ __forceinline__ void convert_tile_f8(const Ctx& c, const float* src, int ld_src, int k0, int n0, unsigned char* dst, int ld_dst, int nrow0, LAS float* T) {
    const int tid = c.tid;
    __syncthreads();
#pragma unroll
    for (int i = 0; i < 2; ++i) { const int k = (tid >> 4) + 32 * i, n4 = (tid & 15) * 4; const f32x4 v = *(const f32x4*)(src + (size_t)(k0 + k) * ld_src + n0 + n4);
        T[k * 65 + n4 + 0] = v[0]; T[k * 65 + n4 + 1] = v[1]; T[k * 65 + n4 + 2] = v[2]; T[k * 65 + n4 + 3] = v[3]; }
    __syncthreads();
    { const int n = tid >> 3, k8 = (tid & 7) * 8; float r[8];
#pragma unroll
      for (int j = 0; j < 8; ++j) r[j] = 32.0f * T[(k8 + j) * 65 + n];
      u32x2 w; w.x = pk4_fp8(r[0], r[1], r[2], r[3]); w.y = pk4_fp8(r[4], r[5], r[6], r[7]);
      *(u32x2*)(dst + (size_t)(nrow0 + n) * ld_dst + k0 + k8) = w; }
}
struct CvtTile { const float* src; int ld_src, k0, n0; unsigned char* dst; int ld_dst, nrow0; bool f8; };
__device__ __forceinline__ CvtTile cvt_tile_desc(const Ctx& c, int layer, int t) {
    constexpr int T_IN = 16 * 72, T_OUT = 24 * 16, T_G = 16 * 16 * 32;
    CvtTile d;
    if (t < T_IN) { const int kt = t % 16, ntl = t / 16; d.src = c.a->in[I_WIN] + (size_t)layer * DM * INW; d.ld_src = INW; d.k0 = kt * 64; d.n0 = ntl * 64; d.dst = (unsigned char*)c.WIN(); d.ld_dst = DM; d.nrow0 = ntl * 64; d.f8 = false; }
    else if (t < T_IN + T_OUT) { const int u = t - T_IN, kt = u % 24, ntl = u / 24; d.src = c.a->in[I_WOUT] + (size_t)layer * MIXW * DM; d.ld_src = DM; d.k0 = kt * 64; d.n0 = ntl * 64; d.dst = (unsigned char*)c.WOUT(); d.ld_dst = MIXW; d.nrow0 = ntl * 64; d.f8 = false; }
    else if (t < T_IN + T_OUT + 2 * T_G) { int u = t - T_IN - T_OUT; const int which = u / T_G; u %= T_G; const int e = u / 512, r = u % 512, kt = r % 16, ntl = r / 16;
        const int f0 = ntl * 64, pn = f0 >> 7, j0 = f0 & 127;
        d.src = c.a->in[which ? I_WUP : I_WGATE] + ((size_t)layer * NEXP + e) * DM * FF; d.ld_src = FF; d.k0 = kt * 64; d.n0 = f0; d.dst = c.WGU() + (size_t)e * 4096 * DM; d.ld_dst = DM; d.nrow0 = pn * 256 + which * 128 + j0; d.f8 = true; }
    else { const int u = t - T_IN - T_OUT - 2 * T_G; const int e = u / 512, r = u % 512, kt = r % 32, ntl = r / 32;
        d.src = c.a->in[I_WDOWN] + ((size_t)layer * NEXP + e) * FF * DM; d.ld_src = DM; d.k0 = kt * 64; d.n0 = ntl * 64; d.dst = c.WD() + (size_t)e * DM * FF; d.ld_dst = FF; d.nrow0 = ntl * 64; d.f8 = true; }
    return d;
}
constexpr int CVT_TILES = 16 * 72 + 24 * 16 + 2 * 16 * 16 * 32 + 16 * 32 * 16, CVT_GROUPS = CVT_TILES / 4;
__device__ __forceinline__ void convert_pull(const Ctx& c0, int layer, LAS float* T) {
    const Ctx c = fresh(c0);
    unsigned* ctr = (unsigned*)(c.ws + WS_CTL) + 36864 + 64 * layer;
    volatile LAS unsigned* qw = (volatile LAS unsigned*)(c.smem + LDS_MISC + 96);
    const int tid = c.tid;
    for (;;) {
        __syncthreads();
        if (tid == 0) qw[0] = __hip_atomic_fetch_add(ctr, 1u, __ATOMIC_RELAXED, __HIP_MEMORY_SCOPE_AGENT);
        __syncthreads();
        const int gid = __builtin_amdgcn_readfirstlane((int)qw[0]);
        if (gid >= CVT_GROUPS) break;
        f32x4 v[4][2];
#pragma unroll
        for (int q = 0; q < 4; ++q) { const CvtTile d = cvt_tile_desc(c, layer, 4 * gid + q);
#pragma unroll
            for (int i = 0; i < 2; ++i) { const int k = (tid >> 4) + 32 * i, n4 = (tid & 15) * 4; v[q][i] = *(const f32x4*)(d.src + (size_t)(d.k0 + k) * d.ld_src + d.n0 + n4); } }
#pragma unroll
        for (int q = 0; q < 4; ++q) { LAS float* Tq = T + q * (64 * 65);
#pragma unroll
            for (int i = 0; i < 2; ++i) { const int k = (tid >> 4) + 32 * i, n4 = (tid & 15) * 4;
                Tq[k * 65 + n4 + 0] = v[q][i][0]; Tq[k * 65 + n4 + 1] = v[q][i][1]; Tq[k * 65 + n4 + 2] = v[q][i][2]; Tq[k * 65 + n4 + 3] = v[q][i][3]; } }
        __syncthreads();
#pragma unroll
        for (int q = 0; q < 4; ++q) { const CvtTile d = cvt_tile_desc(c, layer, 4 * gid + q); LAS float* Tq = T + q * (64 * 65);
            const int n = tid >> 3, k8 = (tid & 7) * 8; float r[8];
#pragma unroll
            for (int j = 0; j < 8; ++j) r[j] = Tq[(k8 + j) * 65 + n];
            if (d.f8) { u32x2 w; w.x = pk4_fp8(32.0f * r[0], 32.0f * r[1], 32.0f * r[2], 32.0f * r[3]); w.y = pk4_fp8(32.0f * r[4], 32.0f * r[5], 32.0f * r[6], 32.0f * r[7]);
                *(u32x2*)(d.dst + (size_t)(d.nrow0 + n) * d.ld_dst + d.k0 + k8) = w; }
            else { u32x4 w; w.x = cvt_pk_bf16(r[0], r[1]); w.y = cvt_pk_bf16(r[2], r[3]); w.z = cvt_pk_bf16(r[4], r[5]); w.w = cvt_pk_bf16(r[6], r[7]);
                *(u32x4*)((bf16_t*)d.dst + (size_t)(d.nrow0 + n) * d.ld_dst + d.k0 + k8) = w; } }
    }
}

template <bool ROUTER>
__device__ __forceinline__ void phase_norm(const Ctx& c0, int layer) {
    const Ctx c = fresh(c0);
    LAS float* W16 = (LAS float*)c.smem;
    if (ROUTER) { const float* src = c.a->in[I_ROUTER] + (size_t)layer * DM * NEXP; for (int i = c.tid; i < DM * 16; i += 512) W16[(i & 15) * DM + (i >> 4)] = src[i]; }
    else { const float* src = c.a->in[I_WIN] + (size_t)layer * DM * INW + C_DT; for (int i = c.tid; i < DM * 16; i += 512) W16[(i & 15) * DM + (i >> 4)] = src[(size_t)(i >> 4) * INW + (i & 15)]; }
    __syncthreads();
    const float* wn = c.a->in[ROUTER ? I_NORM2 : I_NORM1] + (size_t)layer * DM;
    const int lane = c.lane;
    f32x4 wv[4];
#pragma unroll
    for (int i = 0; i < 4; ++i) wv[i] = *(const f32x4*)(wn + 4 * lane + 256 * i);
    constexpr int NR = 4;
    static_assert(NR == 4, "the combine's hit masks are written out for 4 rows");
    for (int r0 = (c.bid * 8 + c.wid) * NR; r0 < ROWS; r0 += c.G * 8 * NR) {
        f32x4 v[NR][4];
#pragma unroll
        for (int q = 0; q < NR; ++q) { const int row = r0 + q;
            if (!ROUTER && layer == 0) { const float* src = row < ROWS_REAL ? c.a->in[I_X] + (size_t)row * DM : c.a->in[I_META] + (size_t)((row - ROWS_REAL) & 15) * DM;
#pragma unroll
                for (int i = 0; i < 4; ++i) v[q][i] = *(const f32x4*)(src + 4 * lane + 256 * i); }
            else {
#pragma unroll
                for (int i = 0; i < 4; ++i) { const u32x2 w = *(const u32x2*)(c.H() + (size_t)row * DM + 4 * lane + 256 * i); v[q][i] = (f32x4){bflo(w.x), bfhi(w.x), bflo(w.y), bfhi(w.y)}; } } }
        if (!ROUTER && layer > 0) {
            int sv[NR]; unsigned hm[NR];
#pragma unroll
            for (int q = 0; q < NR; ++q) sv[q] = lane < 16 ? c.SEL()[(r0 + q) * 16 + lane] : -1;
#pragma unroll
            for (int q = 0; q < NR; ++q) hm[q] = (unsigned)__builtin_amdgcn_ballot_w64(sv[q] >= 0);
            while ((hm[0] | hm[1] | hm[2] | hm[3]) != 0u) {
                int wd[NR][2][4]; bool has[NR][2];
#pragma unroll
                for (int q = 0; q < NR; ++q)
#pragma unroll
                    for (int j = 0; j < 2; ++j) { has[q][j] = hm[q] != 0u; const int e = has[q][j] ? __builtin_ctz(hm[q]) : 0; hm[q] &= hm[q] - 1u;
                        const int se = has[q][j] ? __builtin_amdgcn_readlane(sv[q], e) : 0;
                        const unsigned char* yp = c.Y() + (size_t)se * DM + 4 * lane;
#pragma unroll
                        for (int i = 0; i < 4; ++i) wd[q][j][i] = *(const int*)(yp + 256 * i); }
#pragma unroll
                for (int q = 0; q < NR; ++q)
#pragma unroll
                    for (int j = 0; j < 2; ++j) if (has[q][j]) {
#pragma unroll
                        for (int i = 0; i < 4; ++i) { const int w = wd[q][j][i]; const f32x2 lo = __builtin_amdgcn_cvt_pk_f32_fp8(w, false), hi_ = __builtin_amdgcn_cvt_pk_f32_fp8(w, true);
                            v[q][i][0] += lo[0] * 0.0625f; v[q][i][1] += lo[1] * 0.0625f; v[q][i][2] += hi_[0] * 0.0625f; v[q][i][3] += hi_[1] * 0.0625f; } }
            }
        }
        float rstd[NR];
#pragma unroll
        for (int q = 0; q < NR; ++q) {
            if (!ROUTER) {
#pragma unroll
                for (int i = 0; i < 4; ++i) { u32x2 w; w.x = cvt_pk_bf16(v[q][i][0], v[q][i][1]); w.y = cvt_pk_bf16(v[q][i][2], v[q][i][3]); *(u32x2*)(c.H() + (size_t)(r0 + q) * DM + 4 * lane + 256 * i) = w;
                    v[q][i] = (f32x4){bflo(w.x), bfhi(w.x), bflo(w.y), bfhi(w.y)}; } }
            float ss = 0.f;
#pragma unroll
            for (int i = 0; i < 4; ++i) ss += v[q][i][0] * v[q][i][0] + v[q][i][1] * v[q][i][1] + v[q][i][2] * v[q][i][2] + v[q][i][3] * v[q][i][3];
            rstd[q] = rsqrtf(wave_sum(ss, lane) * (1.0f / DM) + EPS); }
        float acc[NR][16];
#pragma unroll
        for (int q = 0; q < NR; ++q)
#pragma unroll
            for (int j = 0; j < 16; ++j) acc[q][j] = 0.f;
#pragma unroll
        for (int i = 0; i < 4; ++i) { f32x4 un[NR];
#pragma unroll
            for (int q = 0; q < NR; ++q) { un[q] = v[q][i] * rstd[q] * wv[i];
                if (ROUTER) *(unsigned*)(c.U8() + (size_t)(r0 + q) * DM + 4 * lane + 256 * i) = pk4_fp8(un[q][0], un[q][1], un[q][2], un[q][3]);
                else { u32x2 pk; pk.x = cvt_pk_bf16(un[q][0], un[q][1]); pk.y = cvt_pk_bf16(un[q][2], un[q][3]); *(u32x2*)(c.U() + (size_t)(r0 + q) * DM + 4 * lane + 256 * i) = pk; } }
#pragma unroll
            for (int j = 0; j < 16; ++j) { const f32x4 ww = *(const LAS f32x4*)(W16 + j * DM + 4 * lane + 256 * i);
#pragma unroll
                for (int q = 0; q < NR; ++q) acc[q][j] += un[q][0] * ww[0] + un[q][1] * ww[1] + un[q][2] * ww[2] + un[q][3] * ww[3]; } }
        float red[NR];
#pragma unroll
        for (int q = 0; q < NR; ++q) {
            float r8[8], r4[4], r2[2];
            { const bool up = (lane & 32) != 0;
#pragma unroll
              for (int j = 0; j < 8; ++j) { const float keep = up ? acc[q][8 + j] : acc[q][j], send = up ? acc[q][j] : acc[q][8 + j]; r8[j] = keep + shx(send, 32, lane); } }
            { const bool up = (lane & 16) != 0;
#pragma unroll
              for (int j = 0; j < 4; ++j) { const float keep = up ? r8[4 + j] : r8[j], send = up ? r8[j] : r8[4 + j]; r4[j] = keep + shx(send, 16, lane); } }
            { const bool up = (lane & 8) != 0;
#pragma unroll
              for (int j = 0; j < 2; ++j) { const float keep = up ? r4[2 + j] : r4[j], send = up ? r4[j] : r4[2 + j]; r2[j] = keep + shx(send, 8, lane); } }
            { const bool up = (lane & 4) != 0; const float keep = up ? r2[1] : r2[0], send = up ? r2[0] : r2[1]; float x = keep + shx(send, 4, lane); x += shx(x, 2, lane); x += shx(x, 1, lane); red[q] = x; }
        }
        const int oidx = ((lane >> 5) & 1) * 8 + ((lane >> 4) & 1) * 4 + ((lane >> 3) & 1) * 2 + ((lane >> 2) & 1);
        if (!ROUTER) {
#pragma unroll
            for (int q = 0; q < NR; ++q) if ((lane & 3) == 0) c.DT()[(r0 + q) * 16 + oidx] = red[q]; }
        else {
            float pr[NR];
#pragma unroll
            for (int q = 0; q < NR; ++q) {
                float mx = red[q];
#pragma unroll
                for (int o = 4; o < 64; o <<= 1) mx = fmaxf(mx, shx(mx, o, lane));
                const float ex = __expf(red[q] - mx); float s_ = ex;
#pragma unroll
                for (int o = 4; o < 64; o <<= 1) s_ += shx(s_, o, lane);
                pr[q] = ex / s_; }
            int b, t; if (r0 < ROWS_REAL) { b = r0 >> 12; t = (r0 & 4095) + NMETA; } else { b = (r0 - ROWS_REAL) >> 4; t = (r0 - ROWS_REAL) & 15; }
            static_assert(NR == 4, "vector AFFT store");
            if ((lane & 3) == 0) *(f32x4*)(c.AFFT() + (size_t)(b * 16 + oidx) * LTOK + t) = (f32x4){pr[0], pr[1], pr[2], pr[3]};
        }
    }
}

__device__ __forceinline__ void phase_router(const Ctx& c0, int layer) {
    const Ctx c = fresh(c0);
    const int lane = c.lane, r = lane & 15, q = lane >> 4;
    LAS u32x4* BH = (LAS u32x4*)c.smem;
    LAS u32x4* BL = BH + 2048;
    LAS float* WN = (LAS float*)(c.smem + 65536);
    {
        const float* rw = c.a->in[I_ROUTER] + (size_t)layer * DM * NEXP; const float* wn = c.a->in[I_NORM2] + (size_t)layer * DM;
        for (int idx = c.tid; idx < 2048; idx += 512) { const int st = idx >> 6, L = idx & 63; const int col0 = 128 * (st >> 2) + 32 * (L >> 4) + 8 * (st & 3), e = L & 15;
            float w[8];
#pragma unroll
            for (int i = 0; i < 8; ++i) w[i] = wn[col0 + i] * rw[(size_t)(col0 + i) * NEXP + e];
            u32x4 h, l;
            h.x = cvt_pk_bf16(w[0], w[1]); h.y = cvt_pk_bf16(w[2], w[3]); h.z = cvt_pk_bf16(w[4], w[5]); h.w = cvt_pk_bf16(w[6], w[7]);
            l.x = cvt_pk_bf16(w[0] - bflo(h.x), w[1] - bfhi(h.x)); l.y = cvt_pk_bf16(w[2] - bflo(h.y), w[3] - bfhi(h.y)); l.z = cvt_pk_bf16(w[4] - bflo(h.z), w[5] - bfhi(h.z)); l.w = cvt_pk_bf16(w[6] - bflo(h.w), w[7] - bfhi(h.w));
            BH[idx] = h; BL[idx] = l; }
        for (int i = c.tid; i < DM; i += 512) WN[i] = wn[i];
    }
    __syncthreads();
    for (int g = c.bid * 8 + c.wid; g < ROWS / 16; g += c.G * 8) {
        const int row = 16 * g + r;
        const bf16_t* hp = c.H() + (size_t)row * DM + 32 * q;
        u32x4 raw[8][4];
#pragma unroll
        for (int sw = 0; sw < 8; ++sw)
#pragma unroll
            for (int j = 0; j < 4; ++j) raw[sw][j] = *(const u32x4*)(hp + 128 * sw + 8 * j);
        float ss = (float)(c.bid >> 30);
#pragma unroll
        for (int sw = 0; sw < 8; ++sw)
#pragma unroll
            for (int j = 0; j < 4; ++j) { const u32x4 w = raw[sw][j];
                ss += bflo(w.x) * bflo(w.x) + bfhi(w.x) * bfhi(w.x) + bflo(w.y) * bflo(w.y) + bfhi(w.y) * bfhi(w.y) + bflo(w.z) * bflo(w.z) + bfhi(w.z) * bfhi(w.z) + bflo(w.w) * bflo(w.w) + bfhi(w.w) * bfhi(w.w); }
        ss += shx(ss, 16, lane); ss += shx(ss, 32, lane);
        const float rstd = rsqrtf(ss * (1.0f / DM) + EPS);
        const float zz = (float)(c.bid >> 30);
        f32x4 acc = (f32x4){zz, zz, zz, zz};
#pragma unroll
        for (int sw = 0; sw < 8; ++sw)
#pragma unroll
            for (int j = 0; j < 4; ++j) { const int st = sw * 4 + j; const bf16x8 a = __builtin_bit_cast(bf16x8, raw[sw][j]);
                const bf16x8 bh = __builtin_bit_cast(bf16x8, BH[st * 64 + lane]), bl = __builtin_bit_cast(bf16x8, BL[st * 64 + lane]);
                acc = __builtin_amdgcn_mfma_f32_16x16x32_bf16(bh, a, acc, 0, 0, 0); acc = __builtin_amdgcn_mfma_f32_16x16x32_bf16(bl, a, acc, 0, 0, 0);
                if (j == 3) __builtin_amdgcn_sched_barrier(0); }
        float lg[4], ex[4];
#pragma unroll
        for (int i = 0; i < 4; ++i) lg[i] = acc[i] * rstd;
        float mx = fmaxf(fmaxf(lg[0], lg[1]), fmaxf(lg[2], lg[3])); mx = fmaxf(mx, shx(mx, 16, lane)); mx = fmaxf(mx, shx(mx, 32, lane));
        float sm = 0.f;
#pragma unroll
        for (int i = 0; i < 4; ++i) { ex[i] = __expf(lg[i] - mx); sm += ex[i]; }
        sm += shx(sm, 16, lane); sm += shx(sm, 32, lane);
        { int b, t; if (row < ROWS_REAL) { b = row >> 12; t = (row & 4095) + NMETA; } else { b = (row - ROWS_REAL) >> 4; t = (row - ROWS_REAL) & 15; }
#pragma unroll
          for (int i = 0; i < 4; ++i) c.AFFT()[(size_t)(b * 16 + 4 * q + i) * LTOK + t] = ex[i] / sm; }
        unsigned char* up = c.U8() + (size_t)row * DM + 32 * q;
#pragma unroll
        for (int sw = 0; sw < 8; ++sw) { unsigned o[8];
#pragma unroll
            for (int j = 0; j < 4; ++j) { u32x4 w = raw[sw][j]; asm volatile("" : "+v"(w));   const f32x4 w0 = *(const LAS f32x4*)(WN + 128 * sw + 32 * q + 8 * j), w1 = *(const LAS f32x4*)(WN + 128 * sw + 32 * q + 8 * j + 4);
                o[2 * j] = pk4_fp8(bflo(w.x) * rstd * w0[0], bfhi(w.x) * rstd * w0[1], bflo(w.y) * rstd * w0[2], bfhi(w.y) * rstd * w0[3]);
                o[2 * j + 1] = pk4_fp8(bflo(w.z) * rstd * w1[0], bfhi(w.z) * rstd * w1[1], bflo(w.w) * rstd * w1[2], bfhi(w.w) * rstd * w1[3]); }
            *(u32x4*)(up + 128 * sw) = (u32x4){o[0], o[1], o[2], o[3]}; *(u32x4*)(up + 128 * sw + 16) = (u32x4){o[4], o[5], o[6], o[7]}; __builtin_amdgcn_sched_barrier(0); }
    }
}

__device__ __forceinline__ void phase_prep(const Ctx& c0, int layer) {
    const Ctx c = fresh(c0);
    const int lane = c.lane;
    {
        const float* qw = c.a->in[I_QNW] + layer * 64; const float* kw = c.a->in[I_KNW] + layer * 64;
        const int d0 = 8 * (lane & 7);
        float qn[8], kn[8];
#pragma unroll
        for (int j = 0; j < 8; ++j) { qn[j] = qw[d0 + j]; kn[j] = kw[d0 + j]; }
        for (int rb = (c.bid * 8 + c.wid) * 4; rb < ROWS; rb += c.G * 32) {
            u32x4 wq[4], wk[4]; f32x4 cs[4][2], sn[4][2]; bool rot[4];
#pragma unroll
            for (int j = 0; j < 4; ++j) { const int row = rb + j; bf16_t* prow = c.PROJ() + (size_t)row * PROJW;
                wq[j] = *(const u32x4*)(prow + C_AQ + 8 * lane); wk[j] = lane < 16 ? *(const u32x4*)(prow + C_AK + 8 * lane) : (u32x4){0u, 0u, 0u, 0u};
                rot[j] = row < ROWS_REAL; const int tok = rot[j] ? (row & 4095) : 0;
                const float* cp = c.ROPE() + (size_t)tok * 32 + (d0 & 31); const float* sp = cp + 4096 * 32;
                cs[j][0] = *(const f32x4*)cp; cs[j][1] = *(const f32x4*)(cp + 4); sn[j][0] = *(const f32x4*)sp; sn[j][1] = *(const f32x4*)(sp + 4); }
#pragma unroll
            for (int j = 0; j < 4; ++j) { bf16_t* prow = c.PROJ() + (size_t)(rb + j) * PROJW;
#pragma unroll
                for (int pass = 0; pass < 2; ++pass) { const u32x4 w = pass ? wk[j] : wq[j];
                    float x[8] = {bflo(w.x), bfhi(w.x), bflo(w.y), bfhi(w.y), bflo(w.z), bfhi(w.z), bflo(w.w), bfhi(w.w)};
                    float ss = 0.f;
#pragma unroll
                    for (int q = 0; q < 8; ++q) ss += x[q] * x[q];
                    ss += shx(ss, 1, lane); ss += shx(ss, 2, lane); ss += shx(ss, 4, lane);
                    const float rstd = rsqrtf(ss * (1.0f / 64.0f) + EPS) ;
                    float xn[8], xp[8], o[8];
#pragma unroll
                    for (int q = 0; q < 8; ++q) xn[q] = x[q] * rstd * (pass ? kn[q] : qn[q]);
#pragma unroll
                    for (int q = 0; q < 8; ++q) xp[q] = shx(xn[q], 4, lane);
#pragma unroll
                    for (int q = 0; q < 8; ++q) { const float cc = rot[j] ? cs[j][q >> 2][q & 3] : 1.0f, s_ = rot[j] ? sn[j][q >> 2][q & 3] : 0.0f;
                        o[q] = (d0 < 32) ? (xn[q] * cc - xp[q] * s_) : (xp[q] * s_ + xn[q] * cc); }
                    const float sc = pass ? 1.0f : QSCALE;
                    u32x4 wo; wo.x = cvt_pk_bf16(o[0] * sc, o[1] * sc); wo.y = cvt_pk_bf16(o[2] * sc, o[3] * sc); wo.z = cvt_pk_bf16(o[4] * sc, o[5] * sc); wo.w = cvt_pk_bf16(o[6] * sc, o[7] * sc);
                    if (pass == 0) *(u32x4*)(prow + C_AQ + 8 * lane) = wo; else if (lane < 16) *(u32x4*)(prow + C_AK + 8 * lane) = wo; } }
        }
    }
    {
        const float* cw = c.a->in[I_CONVW] + (size_t)layer * 768 * 7; const float* cb = c.a->in[I_CONVB] + (size_t)layer * 768;
        auto conv_pass = [&](const u32x2 (&win)[22], int b, int t0, int ch) {
            f32x4 wv[7]; const f32x4 bs = *(const f32x4*)(cb + ch);
#pragma unroll
            for (int q = 0; q < 7; ++q) wv[q] = *(const f32x4*)(cw + ch * 7 + 4 * q);
#pragma unroll
            for (int r = 0; r < 16; ++r) { float a0 = bs[0], a1 = bs[1], a2 = bs[2], a3 = bs[3];
#pragma unroll
                for (int tp = 0; tp < 7; ++tp) { const u32x2 x = win[r + tp];
                    a0 += wv[(0 * 7 + tp) >> 2][(0 * 7 + tp) & 3] * bflo(x.x); a1 += wv[(1 * 7 + tp) >> 2][(1 * 7 + tp) & 3] * bfhi(x.x); a2 += wv[(2 * 7 + tp) >> 2][(2 * 7 + tp) & 3] * bflo(x.y); a3 += wv[(3 * 7 + tp) >> 2][(3 * 7 + tp) & 3] * bfhi(x.y); }
                u32x2 o; o.x = cvt_pk_bf16(silu_f(a0), silu_f(a1)); o.y = cvt_pk_bf16(silu_f(a2), silu_f(a3));
                *(u32x2*)(c.XBC() + (size_t)row_of(b, t0 + r) * 768 + ch) = o; } };
        for (int task = c.bid * 8 + c.wid; task < NB * 256; task += c.G * 8) {
            const int b = task >> 8, t0 = NMETA + 16 * (task & 255);
            u32x2 win[3][22];
#pragma unroll
            for (int i = 0; i < 3; ++i)
#pragma unroll
                for (int r = 0; r < 22; ++r) { const int tt = t0 - 3 + r;
                    win[i][r] = (tt < LTOK) ? *(const u32x2*)(c.PROJ() + (size_t)row_of(b, tt) * PROJW + C_XBC + 4 * lane + 256 * i) : (u32x2){0u, 0u}; }
#pragma unroll
            for (int i = 0; i < 3; ++i) conv_pass(win[i], b, t0, 4 * lane + 256 * i);
        }
        for (int task = c.G * 8 - 1 - (c.bid * 8 + c.wid); task < NB * 3; task += c.G * 8) {
            const int b = task / 3, i = task % 3;
            u32x2 win[22];
#pragma unroll
            for (int r = 0; r < 22; ++r) { const int tt = r - 3;
                win[r] = (tt >= 0) ? *(const u32x2*)(c.PROJ() + (size_t)row_of(b, tt) * PROJW + C_XBC + 4 * lane + 256 * i) : (u32x2){0u, 0u}; }
            conv_pass(win, b, 0, 4 * lane + 256 * i);
        }
    }
}

namespace att {
using bf16=unsigned short;
using bf16x8=__attribute__((ext_vector_type(8)))short;
using s16x4=__attribute__((ext_vector_type(4)))short;
using f32x16=__attribute__((ext_vector_type(16)))float;
using u32x4=__attribute__((ext_vector_type(4)))unsigned;
constexpr int NW=8,QBLK=32,KVBLK=64,NT=65;
__device__ __forceinline__ int crow(int r,int hi){return (r&3)+8*(r>>2)+4*hi;}
#define SBAR() __builtin_amdgcn_sched_barrier(0)
__device__ __forceinline__ void tmask(f32x16&p0,f32x16&p1){
  const float NEG=-INFINITY;
  #pragma unroll
  for(int r=0;r<16;++r){ if(r>=8)p0[r]=NEG; p1[r]=NEG; }
}

constexpr int NSLOT=3, SLOTB=8192;
constexpr int LDS_K=0, LDS_V=NSLOT*SLOTB, LDS_WS=2*NSLOT*SLOTB, LDS_OST=LDS_WS+NW*64*4, LDS_BYTES=LDS_OST+NW*4096;
constexpr float C2=0.125f*1.4426950408889634f;
__device__ __forceinline__ void glds16(const void*sbase,unsigned voff,unsigned lds_dst){unsigned keep;
  asm volatile("s_mov_b32 %0, m0\n\ts_mov_b32 m0, %3\n\ts_nop 0\n\tglobal_load_lds_dwordx4 %1, %2\n\ts_mov_b32 m0, %0":"=&s"(keep):"v"(voff),"s"(sbase),"s"(lds_dst):"memory");}
__device__ __forceinline__ float max3f(float a,float b,float c){float r;asm("v_max3_f32 %0, %1, %2, %3":"=v"(r):"v"(a),"v"(b),"v"(c));return r;}
__device__ __forceinline__ float max2f(float a,float b){float r;asm("v_max_f32_e32 %0, %1, %2":"=v"(r):"v"(a),"v"(b));return r;}
__device__ __forceinline__ float fadd_s(float a,float b){float r;asm("v_add_f32_e32 %0, %1, %2":"=v"(r):"v"(a),"v"(b));return r;}
__device__ __forceinline__ float fsub_s(float a,float b){float r;asm("v_sub_f32_e32 %0, %1, %2":"=v"(r):"v"(a),"v"(b));return r;}
typedef float f32x2_t __attribute__((ext_vector_type(2))); typedef __bf16 bf16x2_t __attribute__((ext_vector_type(2)));
__device__ __forceinline__ unsigned cvtpk_s(float lo,float hi){f32x2_t v={lo,hi};bf16x2_t b=__builtin_convertvector(v,bf16x2_t);return __builtin_bit_cast(unsigned,b);}
#define WAIT_BAR(N) asm volatile("s_waitcnt vmcnt(" #N ") lgkmcnt(0)\n\ts_barrier":::"memory")

__device__ __forceinline__ void qkt(f32x16&p0,f32x16&p1,const char*Kslot,const bf16x8*qr,const f32x16&negm,int r32,int hi){
  const char*kb=Kslot+hi*1024+r32*16;
  #pragma unroll
  for(int d0=0;d0<4;++d0){
    const bf16x8 b0=*reinterpret_cast<const bf16x8*>(kb+d0*2048);
    const bf16x8 b1=*reinterpret_cast<const bf16x8*>(kb+d0*2048+512);
    if(d0==0){p0=__builtin_amdgcn_mfma_f32_32x32x16_bf16(b0,qr[0],negm,0,0,0);p1=__builtin_amdgcn_mfma_f32_32x32x16_bf16(b1,qr[0],negm,0,0,0);}
    else{p0=__builtin_amdgcn_mfma_f32_32x32x16_bf16(b0,qr[d0],p0,0,0,0);p1=__builtin_amdgcn_mfma_f32_32x32x16_bf16(b1,qr[d0],p1,0,0,0);}}
}
typedef __attribute__((address_space(3))) const char* lds_cptr;
typedef short v4i16_t __attribute__((ext_vector_type(4)));
__device__ __forceinline__ void kload8(bf16x8*kf,lds_cptr kp){
  kf[0]=*(const __attribute__((address_space(3))) bf16x8*)(kp);      kf[1]=*(const __attribute__((address_space(3))) bf16x8*)(kp+512);
  kf[2]=*(const __attribute__((address_space(3))) bf16x8*)(kp+2048); kf[3]=*(const __attribute__((address_space(3))) bf16x8*)(kp+2560);
  kf[4]=*(const __attribute__((address_space(3))) bf16x8*)(kp+4096); kf[5]=*(const __attribute__((address_space(3))) bf16x8*)(kp+4608);
  kf[6]=*(const __attribute__((address_space(3))) bf16x8*)(kp+6144); kf[7]=*(const __attribute__((address_space(3))) bf16x8*)(kp+6656);
}
__device__ __forceinline__ void kload2(bf16x8*kf,lds_cptr kp,int j){ kf[2*j]=*(const __attribute__((address_space(3))) bf16x8*)(kp+j*2048); kf[2*j+1]=*(const __attribute__((address_space(3))) bf16x8*)(kp+j*2048+512); }
__device__ __forceinline__ s16x4 vtr(lds_cptr p){ return __builtin_bit_cast(s16x4,__builtin_amdgcn_ds_read_tr16_b64_v4i16((__attribute__((address_space(3))) v4i16_t*)p)); }
__device__ __forceinline__ float rowmax(const f32x16&p0,const f32x16&p1){
  float a=max3f(p0[0],p0[1],p1[0]),b=max3f(p0[2],p0[3],p1[1]);a=max3f(a,p1[2],p1[3]);
  #pragma unroll
  for(int r=4;r<16;r+=4){a=max3f(a,p0[r],p0[r+1]);b=max3f(b,p0[r+2],p0[r+3]);a=max3f(a,p1[r],p1[r+1]);b=max3f(b,p1[r+2],p1[r+3]);}
  const float m=max2f(a,b);
  auto rr=__builtin_amdgcn_permlane32_swap(__float_as_uint(m),__float_as_uint(m),false,false);
  return max2f(__uint_as_float(rr[0]),__uint_as_float(rr[1]));
}
__device__ __forceinline__ void pv(f32x16*o,int vb,bf16x8 pa0,bf16x8 pa1,bf16x8 pa2,bf16x8 pa3){
  #pragma unroll
  for(int d0=0;d0<2;++d0){s16x4 lo[4],hi[4];
    #pragma unroll
    for(int ks=0;ks<4;++ks){
      asm volatile("ds_read_b64_tr_b16 %0,%1 offset:%c2":"=&v"(lo[ks]):"v"(vb),"i"(d0*4096+ks*1024):"memory");
      asm volatile("ds_read_b64_tr_b16 %0,%1 offset:%c2":"=&v"(hi[ks]):"v"(vb),"i"(d0*4096+ks*1024+512):"memory");}
    asm volatile("s_waitcnt lgkmcnt(0)":::"memory");SBAR();
    #define PK(k) (bf16x8){lo[k][0],lo[k][1],lo[k][2],lo[k][3],hi[k][0],hi[k][1],hi[k][2],hi[k][3]}
    o[d0]=__builtin_amdgcn_mfma_f32_32x32x16_bf16(pa0,PK(0),o[d0],0,0,0);
    o[d0]=__builtin_amdgcn_mfma_f32_32x32x16_bf16(pa1,PK(1),o[d0],0,0,0);
    o[d0]=__builtin_amdgcn_mfma_f32_32x32x16_bf16(pa2,PK(2),o[d0],0,0,0);
    o[d0]=__builtin_amdgcn_mfma_f32_32x32x16_bf16(pa3,PK(3),o[d0],0,0,0);
    #undef PK
  }
}

#ifndef ATTN_STORE16
#define ATTN_STORE16(p,v) (*(u32x4*)(p)=(v))
#endif
template<int THRL> __device__ __forceinline__ void attn_unit(int b,int g,int qb,const bf16*P,bf16*O,char*shm,int wid,int lane){
  constexpr int DM=PROJW;
  const int r32=lane&31,hi=lane>>5;
  const bool meta=(qb==64);
  const int head=4*g+(wid>>1);
  const long qrow0=meta?(long)(ROWS_REAL+b*NMETA):(long)b*SEQ+qb*64+(wid&1)*32;
  const long rowbase=(long)b*SEQ; const long metaoff=((long)(ROWS_REAL+b*NMETA)-rowbase)*DM;
  const bf16*Qw=P+qrow0*DM+C_AQ+head*64;
  const bf16*Kh=P+rowbase*DM+C_AK+g*64,*Vh=P+rowbase*DM+C_AV+g*64;
  const unsigned lds0=(unsigned)(uintptr_t)shm;
  float*wsf=(float*)(shm+LDS_WS)+wid*64;
  const unsigned ksrc=(unsigned)(lane*DM+wid*8)*2u;
  const unsigned vsrc=(unsigned)((16*(wid&3)+(lane>>2))*DM+(wid>>2)*32+(lane&3)*8)*2u;
  const unsigned kdst=lds0+LDS_K+wid*1024, vdst=lds0+LDS_V+wid*1024;
  #define TOFF(t) (((t)<NT-1)?(long)(t)*KVBLK*DM:metaoff)
  #define DMA_K(t,slot) glds16(Kh+TOFF(t),ksrc,(unsigned)__builtin_amdgcn_readfirstlane(kdst+(slot)))
  #define DMA_V(t,slot) glds16(Vh+TOFF(t),vsrc,(unsigned)__builtin_amdgcn_readfirstlane(vdst+(slot)))
  const int vb0=(int)(lds0+LDS_V)+((lane>>4)&1)*32+(lane&3)*8+(4*hi+((lane&15)>>2))*64;
  const char*Kbase=shm+LDS_K; bf16x8 kf[8];
  const lds_cptr shm3=(lds_cptr)shm; const lds_cptr kp0=shm3+LDS_K+hi*1024+r32*16; const lds_cptr vp0=shm3+LDS_V+((lane>>4)&1)*32+(lane&3)*8+(4*hi+((lane&15)>>2))*64;
  DMA_K(0,0);DMA_V(0,0);DMA_K(1,SLOTB);
  bf16x8 qr[4];
  #pragma unroll
  for(int d0=0;d0<4;++d0)qr[d0]=*reinterpret_cast<const bf16x8*>(&Qw[(long)(meta?(r32&15):r32)*DM+d0*16+hi*8]);
  float mhat=0.f,l_reg=0.f;f32x16 o[2];f32x16 negm; { const float zz=(float)(qb>>30);
    _Pragma("unroll") for(int r=0;r<16;++r){o[0][r]=zz;o[1][r]=zz;negm[r]=zz;} } asm volatile("":"+v"(negm));
  #define CMASK(P0,P1,t) do{}while(0)
  bool resc=false;
  #define START(P0,P1) do{ const float rm=rowmax(P0,P1); resc=false; \
    { const float dl=rm; mhat=fadd_s(mhat,dl); \
      _Pragma("unroll") for(int r=0;r<16;++r){P0[r]=fsub_s(P0[r],dl);P1[r]=fsub_s(P1[r],dl);} \
      _Pragma("unroll") for(int r=0;r<16;++r)negm[r]=-mhat; asm volatile("":"+v"(negm)); } \
    _Pragma("unroll") for(int r=0;r<16;++r)P0[r]=__builtin_amdgcn_exp2f(P0[r]); }while(0)
  #define RESC() do{ if(resc){ asm volatile("s_waitcnt lgkmcnt(0)":::"memory"); \
      _Pragma("unroll") for(int d_=0;d_<2;++d_) _Pragma("unroll") for(int r=0;r<16;++r)o[d_][r]*=wsf[crow(r,hi)]; } }while(0)
  f32x16 pA0,pA1,pB0,pB1;
  int sl_prev=0,sl_cur=0,sl_next=SLOTB;
  #define ROT() do{sl_prev=sl_cur;sl_cur=sl_next;sl_next=(sl_next==(NSLOT-1)*SLOTB)?0:sl_next+SLOTB;}while(0)
  DMA_K(2,2*SLOTB);
  WAIT_BAR(3);
  qkt(pA0,pA1,Kbase,qr,negm,r32,hi);asm volatile("s_nop 15\n\ts_nop 7":"+v"(pA0),"+v"(pA1));CMASK(pA0,pA1,0);
  START(pA0,pA1);
  _Pragma("unroll") for(int r=0;r<16;++r)pA1[r]=__builtin_amdgcn_exp2f(pA1[r]);
  WAIT_BAR(0);
  DMA_K(3,0);DMA_V(1,SLOTB);
  ROT();
  kload8(kf,kp0+sl_cur);
  WAIT_BAR(2);
  s16x4 vlo[8],vhi[8]; u32x4 pw0,pw1,pw2,pw3;
  #define PKW(P,B) cvtpk_s(P[B],P[B+1])
  #define PAF(k) __builtin_bit_cast(bf16x8,pw##k)
  #define VFR(i) (bf16x8){vlo[i][0],vlo[i][1],vlo[i][2],vlo[i][3],vhi[i][0],vhi[i][1],vhi[i][2],vhi[i][3]}
  #define PIN(x) asm volatile("":"+v"(x))
  #define MX3(a,b,c) __builtin_fmaxf(__builtin_fmaxf((a),(b)),(c))
  #define GAPA(MF,A0,A1,A2,A3,W0,W1,PW) do{ MF; sacc+=A0; sacc+=A1; sacc+=A2; sacc+=A3; PIN(sacc); W0; W1; PIN(PW); SBAR(); }while(0)
  #define EX(v) __builtin_amdgcn_exp2f(v)
  #define GAPB(MF,X,B) do{ MF; X[B]=EX(X[B]); X[B+1]=EX(X[B+1]); X[B+2]=EX(X[B+2]); X[B+3]=EX(X[B+3]); PIN(X); SBAR(); }while(0)
  #define VRD(i) do{ vlo[i]=vtr(vp_+(((i)>>2)*4096+((i)&3)*1024)); vhi[i]=vtr(vp_+(((i)>>2)*4096+((i)&3)*1024+512)); }while(0)
  #define KRD(G,j) do{ if(G){ kload2(kf,kp0+sl_next,j); SBAR(); } }while(0)
  #define STEP(C0,C1,P0,P1,t,GK,GV,GL) do{ SBAR(); \
    const lds_cptr vp_=vp0+sl_prev; \
    VRD(0); SBAR(); float sacc=(P0[0]+P0[1]); \
    GAPA(C0=__builtin_amdgcn_mfma_f32_32x32x16_bf16(kf[0],qr[0],negm,0,0,0), P0[2],P0[3],P0[4],P0[5],     pw0[0]=PKW(P0,0), pw0[1]=PKW(P0,2), pw0); \
    VRD(4); SBAR(); GAPA(C1=__builtin_amdgcn_mfma_f32_32x32x16_bf16(kf[1],qr[0],negm,0,0,0), P0[6],P0[7],P0[8],P0[9],     pw0[2]=PKW(P0,4), pw0[3]=PKW(P0,6), pw0); \
    VRD(1); SBAR(); GAPA(C0=__builtin_amdgcn_mfma_f32_32x32x16_bf16(kf[2],qr[1],C0,0,0,0),   P0[10],P0[11],P0[12],P0[13], pw1[0]=PKW(P0,8), pw1[1]=PKW(P0,10), pw1); \
    VRD(5); SBAR(); GAPA(C1=__builtin_amdgcn_mfma_f32_32x32x16_bf16(kf[3],qr[1],C1,0,0,0),   P0[14],P0[15],P1[0],P1[1],   pw1[2]=PKW(P0,12),pw1[3]=PKW(P0,14), pw1); \
    VRD(2); SBAR(); GAPA(C0=__builtin_amdgcn_mfma_f32_32x32x16_bf16(kf[4],qr[2],C0,0,0,0),   P1[2],P1[3],P1[4],P1[5],     pw2[0]=PKW(P1,0), pw2[1]=PKW(P1,2), pw2); \
    VRD(6); SBAR(); GAPA(C1=__builtin_amdgcn_mfma_f32_32x32x16_bf16(kf[5],qr[2],C1,0,0,0),   P1[6],P1[7],P1[8],P1[9],     pw2[2]=PKW(P1,4), pw2[3]=PKW(P1,6), pw2); \
    VRD(3); SBAR(); GAPA(C0=__builtin_amdgcn_mfma_f32_32x32x16_bf16(kf[6],qr[3],C0,0,0,0),   P1[10],P1[11],P1[12],P1[13], pw3[0]=PKW(P1,8), pw3[1]=PKW(P1,10), pw3); \
    VRD(7); SBAR(); GAPA(C1=__builtin_amdgcn_mfma_f32_32x32x16_bf16(kf[7],qr[3],C1,0,0,0),   P1[14],P1[15],0.f,0.f,       pw3[2]=PKW(P1,12),pw3[3]=PKW(P1,14), pw3); \
    l_reg+=sacc; \
    if(GK){DMA_K((t)+3,sl_cur);} if(GV){DMA_V((t)+1,sl_next);} \
    CMASK(C0,C1,t); \
    { float a=MX3(C0[0],C0[1],C1[0]),b=MX3(C0[2],C0[3],C1[1]); a=MX3(a,C1[2],C1[3]); \
      _Pragma("unroll") for(int r=4;r<16;r+=4){a=MX3(a,C0[r],C0[r+1]);b=MX3(b,C0[r+2],C0[r+3]);a=MX3(a,C1[r],C1[r+1]);b=MX3(b,C1[r+2],C1[r+3]);} \
      float rm=__builtin_fmaxf(a,b); { auto rr=__builtin_amdgcn_permlane32_swap(__float_as_uint(rm),__float_as_uint(rm),false,false); rm=__builtin_fmaxf(__uint_as_float(rr[0]),__uint_as_float(rr[1])); } \
      resc=false; \
      if(__builtin_expect(__any(rm>(float)THRL),0)){ const float dl=__builtin_fmaxf(rm,0.f); mhat+=dl; \
        _Pragma("unroll") for(int r=0;r<16;++r){C0[r]-=dl;C1[r]-=dl;} \
        _Pragma("unroll") for(int r=0;r<16;++r)negm[r]=-mhat; asm volatile("":"+v"(negm)); \
        const float f=__builtin_amdgcn_exp2f(-dl); l_reg*=f; if(hi==0)wsf[r32]=f; resc=true; } } \
    SBAR(); \
    GAPB(o[0]=__builtin_amdgcn_mfma_f32_32x32x16_bf16(PAF(0),VFR(0),o[0],0,0,0), C0,0); \
    GAPB(o[1]=__builtin_amdgcn_mfma_f32_32x32x16_bf16(PAF(0),VFR(4),o[1],0,0,0), C0,4); \
    KRD(GL,0); GAPB(o[0]=__builtin_amdgcn_mfma_f32_32x32x16_bf16(PAF(1),VFR(1),o[0],0,0,0), C0,8); \
    KRD(GL,1); GAPB(o[1]=__builtin_amdgcn_mfma_f32_32x32x16_bf16(PAF(1),VFR(5),o[1],0,0,0), C0,12); \
    KRD(GL,2); GAPB(o[0]=__builtin_amdgcn_mfma_f32_32x32x16_bf16(PAF(2),VFR(2),o[0],0,0,0), C1,0); \
    KRD(GL,3); GAPB(o[1]=__builtin_amdgcn_mfma_f32_32x32x16_bf16(PAF(2),VFR(6),o[1],0,0,0), C1,4); \
    GAPB(o[0]=__builtin_amdgcn_mfma_f32_32x32x16_bf16(PAF(3),VFR(3),o[0],0,0,0), C1,8); \
    GAPB(o[1]=__builtin_amdgcn_mfma_f32_32x32x16_bf16(PAF(3),VFR(7),o[1],0,0,0), C1,12); \
    }while(0)
  int t=1;
  for(;t+5<NT;t+=2){
    STEP(pB0,pB1,pA0,pA1,t,true,true,true);     WAIT_BAR(2); RESC(); ROT();
    STEP(pA0,pA1,pB0,pB1,t+1,true,true,true);   WAIT_BAR(2); RESC(); ROT();
  }
  #undef CMASK
  #define CMASK(P0,P1,t) do{ if((t)==NT-1)tmask(P0,P1); }while(0)
  #define ENDW(tt) do{ if((tt)+3<NT){WAIT_BAR(2);} else if((tt)+2<NT){WAIT_BAR(1);} else {WAIT_BAR(0);} }while(0)
  for(;t+2<NT;t+=2){
    STEP(pB0,pB1,pA0,pA1,t,(t+3<NT),(t+1<NT),(t+1<NT));       ENDW(t);   RESC(); ROT();
    STEP(pA0,pA1,pB0,pB1,t+1,(t+4<NT),(t+2<NT),(t+2<NT));     ENDW(t+1); RESC(); ROT();
  }
  STEP(pB0,pB1,pA0,pA1,NT-2,false,true,true); ENDW(NT-2); RESC(); ROT();
  STEP(pA0,pA1,pB0,pB1,NT-1,false,false,false); RESC();
  { float sacc=pA0[0]+pA0[1]; _Pragma("unroll") for(int r=2;r<16;++r)sacc+=pA0[r]; _Pragma("unroll") for(int r=0;r<16;++r)sacc+=pA1[r]; l_reg+=sacc;
    pw0=(u32x4){PKW(pA0,0),PKW(pA0,2),PKW(pA0,4),PKW(pA0,6)};pw1=(u32x4){PKW(pA0,8),PKW(pA0,10),PKW(pA0,12),PKW(pA0,14)};pw2=(u32x4){PKW(pA1,0),PKW(pA1,2),PKW(pA1,4),PKW(pA1,6)};pw3=(u32x4){PKW(pA1,8),PKW(pA1,10),PKW(pA1,12),PKW(pA1,14)};
    SBAR(); pv(o,vb0+sl_cur,PAF(0),PAF(1),PAF(2),PAF(3)); }
  #undef PKW
  #undef PAF
  #undef VFR
  #undef PIN
  #undef MX3
  #undef GAPA
  #undef GAPB
  #undef EX
  #undef VRD
  #undef KRD
  #undef STEP
  #undef ENDW
  {auto rr=__builtin_amdgcn_permlane32_swap(__float_as_uint(l_reg),__float_as_uint(l_reg),false,false);l_reg=__uint_as_float(rr[0])+__uint_as_float(rr[1]);}
  if(hi==0)wsf[32+r32]=l_reg;asm volatile("s_waitcnt lgkmcnt(0)":::"memory");
  float rli[16];
  #pragma unroll
  for(int r=0;r<16;++r)rli[r]=__builtin_amdgcn_rcpf(wsf[32+crow(r,hi)]);
  bf16*Ow=O+qrow0*512+head*64;
  { bf16*stg=(bf16*)(shm+LDS_OST)+wid*2048;
    #pragma unroll
    for(int r=0;r<16;++r){const int orow=crow(r,hi);
      #pragma unroll
      for(int d0=0;d0<2;++d0)stg[orow*64+d0*32+r32]=f2bf(o[d0][r]*rli[r]);}
    asm volatile("s_waitcnt lgkmcnt(0)":::"memory");
    #pragma unroll
    for(int i=0;i<4;++i){const int row=i*8+(lane>>3),ch=lane&7; const u32x4 v=*(const u32x4*)(stg+row*64+ch*8); if(!meta||((wid&1)==0&&row<NMETA)) ATTN_STORE16(Ow+(long)row*512+ch*8,v);} }
  asm volatile("s_waitcnt lgkmcnt(0)\n\ts_barrier":::"memory");
  #undef DMA_K
  #undef TOFF
  #undef DMA_V
  #undef CMASK
  #undef START
  #undef RESC
  #undef ROT
}
#undef SBAR
#undef WAIT_BAR
}

__device__ __forceinline__ void chunk_rows(int b, int ch, int& base, int& n) { if (ch == 0) { base = ROWS_REAL + b * NMETA; n = NMETA; } else { base = b * SEQ + (ch - 1) * 64; n = 64; } }

typedef float f32x16 __attribute__((ext_vector_type(16)));
__device__ __forceinline__ int crow16(int r, int hi) { return (r & 3) + 8 * (r >> 2) + 4 * hi; }
__device__ __forceinline__ void hgrn_chunk_item(const Ctx& c, int layer, int b, int h, int dir) {
    constexpr int PQ = 136, PJ = 72;
    LAS char* sm = c.smem;
    LAS bf16_t* QT = (LAS bf16_t*)(sm);
    LAS bf16_t* QH = (LAS bf16_t*)(sm + 17408);
    LAS bf16_t* R0 = (LAS bf16_t*)(sm + 26112);
    LAS bf16_t* R1 = (LAS bf16_t*)(sm + 34816);
    LAS bf16_t* OT = R1;
    LAS bf16_t* KT = (LAS bf16_t*)(sm + 52224);
    LAS bf16_t* VT = (LAS bf16_t*)(sm + 70656);
    LAS bf16_t* PT = (LAS bf16_t*)(sm + 89088);
    LAS bf16_t* SL = (LAS bf16_t*)(sm + 98304);
    LAS float* DV = (LAS float*)(sm + 133120);
    LAS float* CX = (LAS float*)(sm + 133632);
    const int tid = c.tid, lane = c.lane, wid = c.wid, r32 = lane & 31, hi = lane >> 5;
    const int d = tid & 127, rq = tid >> 7;
    const float lb = c.LB()[(dir * DEPTH + layer) * 512 + h * 128 + d];
    bf16_t* OUT = dir ? c.OB() : c.OF();
    const bf16_t* PR = c.PROJ();
    const int fcol = dir ? C_HB : C_HF;
    __syncthreads();
    { const unsigned zu = (unsigned)(c.bid >> 30); const u32x4 z4 = (u32x4){zu, zu, zu, zu};
      for (int i = tid; i < 34816 / 16; i += 512) ((LAS u32x4*)SL)[i] = z4;
      for (int i = tid; i < 9216 / 16; i += 512) ((LAS u32x4*)PT)[i] = z4; }
    f32x16 Sacc[2];
    const float zz = (float)(c.bid >> 30);
#pragma unroll
    for (int r = 0; r < 16; ++r) { Sacc[0][r] = zz; Sacc[1][r] = zz; }
    LAS bf16_t* RQ = (LAS bf16_t*)(sm); LAS bf16_t* RF = (LAS bf16_t*)(sm + 16384); LAS bf16_t* RV = (LAS bf16_t*)(sm + 52224);
    u32x4 pfq[2], pff[2], pfv[2];
    const unsigned zu_ = (unsigned)(c.bid >> 30);
#define HG_LOAD(ci_) do { const int ch_ = dir ? 64 - (ci_) : (ci_); int base_, n_; chunk_rows(b, ch_, base_, n_); \
        _Pragma("unroll") for (int k = 0; k < 2; ++k) { const int p_ = tid + 512 * k, i_ = p_ >> 4, c16_ = p_ & 15; const int r_ = dir ? n_ - 1 - i_ : i_; \
            if (i_ < n_) { const bf16_t* pp_ = PR + (size_t)(base_ + r_) * PROJW + h * 128 + 8 * c16_; pfq[k] = *(const u32x4*)(pp_ + C_HQ); pff[k] = *(const u32x4*)(pp_ + fcol); pfv[k] = *(const u32x4*)(pp_ + C_HI); } \
            else { pfq[k] = (u32x4){zu_, zu_, zu_, zu_}; pff[k] = (u32x4){0x3f803f80u + zu_, 0x3f803f80u + zu_, 0x3f803f80u + zu_, 0x3f803f80u + zu_}; pfv[k] = (u32x4){zu_, zu_, zu_, zu_}; } } } while (0)
    HG_LOAD(0);
    for (int ci = 0; ci < 65; ++ci) {
        const int ch = dir ? 64 - ci : ci; int base, n; chunk_rows(b, ch, base, n);
#pragma unroll
        for (int k = 0; k < 2; ++k) { const int p_ = tid + 512 * k, i_ = p_ >> 4, c16_ = p_ & 15;
            *(LAS u32x4*)(RQ + i_ * 128 + 8 * c16_) = pfq[k]; *(LAS u32x4*)(RF + i_ * 128 + 8 * c16_) = pff[k]; *(LAS u32x4*)(RV + i_ * 128 + 8 * c16_) = pfv[k]; }
        if (ci + 1 < 65) HG_LOAD(ci + 1);
        lds_barrier();
        unsigned short xq[16], xf[16], xv[16];
#pragma unroll
        for (int m = 0; m < 16; ++m) { xq[m] = RQ[(16 * rq + m) * 128 + d]; xf[m] = RF[(16 * rq + m) * 128 + d]; xv[m] = RV[(16 * rq + m) * 128 + d]; }
        float cl[16], kk[16], qq[16];
        { float run = 0.f;
#pragma unroll
          for (int m = 0; m < 16; ++m) { const float f = bf2f(xf[m]);
              run += fmaxf(__logf(f), -200.0f); cl[m] = run; kk[m] = 1.0f - f; qq[m] = bf2f(xq[m]); }
          CX[rq * 128 + d] = run; }
        lds_barrier();
        { const float c0 = CX[d], c1 = CX[128 + d], c2 = CX[256 + d], c3 = CX[384 + d];
          const float tot0 = c0 + c1, tot1 = c2 + c3;
          const float off = (rq == 1) ? c0 : (rq == 3 ? c2 : 0.f);
          const int I = rq >> 1;
          const float e0 = __expf(tot0), e1 = __expf(tot1);
          if (rq == 0) DV[d] = e0 * e1;
          unsigned kp[8], vp[8];
#pragma unroll
          for (int m = 0; m < 16; ++m) { const int i = 16 * rq + m; const float cb = off + cl[m];
              const float E = __expf(fmaxf(cb, -80.f)), rE = __builtin_amdgcn_rcpf(E), krE = kk[m] * rE;
              QT[i * PQ + d] = f2bf(qq[m] * E);
              float khat;
              if (I == 0) { R0[i * PQ + d] = f2bf(krE); R1[i * PQ + d] = f2bf(krE * e0); khat = krE * e0 * e1; }
              else { R1[i * PQ + d] = f2bf(krE); QH[(i - 32) * PQ + d] = f2bf(qq[m] * E * e0); khat = krE * e1; }
              if (m & 1) { kp[m >> 1] |= ((unsigned)f2bf(khat)) << 16; vp[m >> 1] |= ((unsigned)xv[m]) << 16; } else { kp[m >> 1] = f2bf(khat); vp[m >> 1] = xv[m]; } }
          *(LAS u32x4*)(KT + d * PJ + 16 * rq) = (u32x4){kp[0], kp[1], kp[2], kp[3]}; *(LAS u32x4*)(KT + d * PJ + 16 * rq + 8) = (u32x4){kp[4], kp[5], kp[6], kp[7]};
          *(LAS u32x4*)(VT + d * PJ + 16 * rq) = (u32x4){vp[0], vp[1], vp[2], vp[3]}; *(LAS u32x4*)(VT + d * PJ + 16 * rq + 8) = (u32x4){vp[4], vp[5], vp[6], vp[7]}; }
        lds_barrier();
        if (wid < 3) {
            const LAS bf16_t* Rb = (wid == 0) ? R0 : (wid == 1 ? R1 : R1 + 32 * PQ);
            const int i0 = wid == 0 ? 0 : 32, j0 = wid == 2 ? 32 : 0;
            f32x16 acc;
#pragma unroll
            for (int r = 0; r < 16; ++r) acc[r] = zz;
#pragma unroll
            for (int d0 = 0; d0 < 8; ++d0) { const bf16x8 a = *(const LAS bf16x8*)(Rb + r32 * PQ + 16 * d0 + 8 * hi); const bf16x8 bq = *(const LAS bf16x8*)(QT + (i0 + r32) * PQ + 16 * d0 + 8 * hi);
                acc = __builtin_amdgcn_mfma_f32_32x32x16_bf16(a, bq, acc, 0, 0, 0); }
#pragma unroll
            for (int q4 = 0; q4 < 4; ++q4) { float v[4];
#pragma unroll
                for (int t = 0; t < 4; ++t) { const int jrel = 8 * q4 + 4 * hi + t; v[t] = (wid == 1 || jrel <= r32) ? acc[4 * q4 + t] : 0.f; }
                u32x2 w; w.x = cvt_pk_bf16(v[0], v[1]); w.y = cvt_pk_bf16(v[2], v[3]);
                *(LAS u32x2*)(PT + (i0 + r32) * PJ + j0 + 8 * q4 + 4 * hi) = w; }
        }
        { const int dq = wid & 3, eh = wid >> 2;
#pragma unroll
          for (int q4 = 0; q4 < 4; ++q4) { const f32x4 dv = *(const LAS f32x4*)(DV + 32 * dq + 8 * q4 + 4 * hi);
#pragma unroll
              for (int t = 0; t < 4; ++t) { Sacc[0][4 * q4 + t] *= dv[t]; Sacc[1][4 * q4 + t] *= dv[t]; } }
#pragma unroll
          for (int js = 0; js < 4; ++js) { const bf16x8 a = *(const LAS bf16x8*)(KT + (32 * dq + r32) * PJ + 16 * js + 8 * hi);
#pragma unroll
              for (int eb = 0; eb < 2; ++eb) { const bf16x8 bv = *(const LAS bf16x8*)(VT + (64 * eh + 32 * eb + r32) * PJ + 16 * js + 8 * hi);
                  Sacc[eb] = __builtin_amdgcn_mfma_f32_32x32x16_bf16(a, bv, Sacc[eb], 0, 0, 0); } } }
        lds_barrier();
        { const int ih = wid & 1, eq = wid >> 1, i0 = 32 * ih, e0 = 32 * eq;
          f32x16 acc;
#pragma unroll
          for (int r = 0; r < 16; ++r) acc[r] = zz;
#pragma unroll
          for (int js = 0; js < 4; ++js) if (js < 2 || ih) { const bf16x8 a = *(const LAS bf16x8*)(PT + (i0 + r32) * PJ + 16 * js + 8 * hi); const bf16x8 bv = *(const LAS bf16x8*)(VT + (e0 + r32) * PJ + 16 * js + 8 * hi);
              acc = __builtin_amdgcn_mfma_f32_32x32x16_bf16(a, bv, acc, 0, 0, 0); }
          const LAS bf16_t* qh = ih ? QH : QT;
#pragma unroll
          for (int ds = 0; ds < 8; ++ds) { const bf16x8 a = *(const LAS bf16x8*)(qh + r32 * PQ + 16 * ds + 8 * hi); const bf16x8 bs = *(const LAS bf16x8*)(SL + (e0 + r32) * PQ + 16 * ds + 8 * hi);
              acc = __builtin_amdgcn_mfma_f32_32x32x16_bf16(a, bs, acc, 0, 0, 0); }
#pragma unroll
          for (int r = 0; r < 16; ++r) OT[(i0 + crow16(r, hi)) * PQ + e0 + r32] = f2bf(acc[r]); }
        lds_barrier();
        { const int dq = wid & 3, eh = wid >> 2;
#pragma unroll
          for (int eb = 0; eb < 2; ++eb)
#pragma unroll
              for (int q4 = 0; q4 < 4; ++q4) { u32x2 w; w.x = cvt_pk_bf16(Sacc[eb][4 * q4], Sacc[eb][4 * q4 + 1]); w.y = cvt_pk_bf16(Sacc[eb][4 * q4 + 2], Sacc[eb][4 * q4 + 3]);
                  *(LAS u32x2*)(SL + (64 * eh + 32 * eb + r32) * PQ + 32 * dq + 8 * q4 + 4 * hi) = w; } }
#pragma unroll
        for (int k = 0; k < 2; ++k) { const int idx = tid + 512 * k, i = idx >> 4, c16 = idx & 15; const int r = dir ? n - 1 - i : i;
            if (i < n) *(u32x4*)(OUT + (size_t)(base + r) * 512 + h * 128 + c16 * 8) = *(const LAS u32x4*)(OT + i * PQ + c16 * 8); }
    }
#undef HG_LOAD
    __syncthreads();
}

__device__ __forceinline__ bf16x8 pack8(float a0, float a1, float a2, float a3, float a4, float a5, float a6, float a7) {
    u32x4 w; w.x = cvt_pk_bf16(a0, a1); w.y = cvt_pk_bf16(a2, a3); w.z = cvt_pk_bf16(a4, a5); w.w = cvt_pk_bf16(a6, a7); return __builtin_bit_cast(bf16x8, w);
}
__device__ __forceinline__ bf16x8 ld8perm(const LAS bf16_t* p) {
    const u32x2 a = *(const LAS u32x2*)p, b = *(const LAS u32x2*)(p + 8); u32x4 w; w.x = a.x; w.y = a.y; w.z = b.x; w.w = b.y; return __builtin_bit_cast(bf16x8, w);
}
__device__ __forceinline__ void ssd_chunk_item(const Ctx& c, int layer, int b, int g, int dir) {
    constexpr int PJ = 72, PO = 264;
    LAS char* sm = c.smem;
    LAS bf16_t* TB = (LAS bf16_t*)(sm);
    LAS bf16_t* TC = (LAS bf16_t*)(sm + 9216);
    LAS bf16_t* TBT = (LAS bf16_t*)(sm + 18432);
    LAS bf16_t* TX = (LAS bf16_t*)(sm + 27648);
    LAS bf16_t* OT = (LAS bf16_t*)(sm + 64512);
    LAS float* CUM = (LAS float*)(sm + 98304);
    LAS float* DTV = CUM + 256;
    LAS float* WV = CUM + 512;
    LAS float* ECV = CUM + 768;
    LAS float* DVv = CUM + 1024;
    const int tid = c.tid, lane = c.lane, wid = c.wid, r32 = lane & 31, hi = lane >> 5;
    const int hh = wid >> 1, ph = wid & 1;
    bf16_t* OUT = dir ? c.YB() : c.YF();
    const bf16_t* XB = c.XBC();
    const float* DTP = c.DT();
    const int xcp = tid & 127, xq4 = tid >> 7;
    const int prow = tid >> 3, ppc = tid & 7;
    const int sh = (tid >> 6) & 3, si = tid & 63;
    const float dtb = c.a->in[I_DTB][(layer * 2 + dir) * 8 + 4 * g + sh];
    const float Ah = -__expf(c.a->in[I_ALOG][(layer * 2 + dir) * 8 + 4 * g + sh]);
    __syncthreads();
    f32x16 Sacc[2];
    const float zz = (float)(c.bid >> 30);
#pragma unroll
    for (int r = 0; r < 16; ++r) { Sacc[0][r] = zz; Sacc[1][r] = zz; }
    LAS bf16_t* RX = (LAS bf16_t*)(sm + 106496);
    u32x4 pfx[4], pb, pc; float dtr;
    const unsigned zu_ = (unsigned)(c.bid >> 30);
#define SSD_LOAD(ci_) do { const int ch_ = dir ? 64 - (ci_) : (ci_); int base_, n_; chunk_rows(b, ch_, base_, n_); const u32x4 z = (u32x4){zu_, zu_, zu_, zu_}; \
        _Pragma("unroll") for (int k = 0; k < 4; ++k) { const int p_ = tid + 512 * k, i = p_ >> 5, c_ = p_ & 31, r = dir ? n_ - 1 - i : i; pfx[k] = (i < n_) ? *(const u32x4*)(XB + (size_t)(base_ + r) * 768 + 256 * g + 8 * c_) : z; } \
        { const int i = prow, r = dir ? n_ - 1 - i : i; \
          pb = (i < n_) ? *(const u32x4*)(XB + (size_t)(base_ + r) * 768 + 512 + 64 * g + 8 * ppc) : z; pc = (i < n_) ? *(const u32x4*)(XB + (size_t)(base_ + r) * 768 + 640 + 64 * g + 8 * ppc) : z; } \
        { const int i = si, r = dir ? n_ - 1 - i : i; dtr = (tid < 256 && i < n_) ? DTP[(size_t)(base_ + r) * 16 + dir * 8 + 4 * g + sh] : -1e30f; } } while (0)
    SSD_LOAD(0);
    for (int ci = 0; ci < 65; ++ci) {
        const int ch = dir ? 64 - ci : ci; int base, n; chunk_rows(b, ch, base, n);
#pragma unroll
        for (int k = 0; k < 4; ++k) { const int p_ = tid + 512 * k; *(LAS u32x4*)(RX + (p_ >> 5) * 256 + 8 * (p_ & 31)) = pfx[k]; }
        *(LAS u32x4*)(TB + prow * PJ + 8 * ppc) = pb; *(LAS u32x4*)(TC + prow * PJ + 8 * ppc) = pc;
        const float dtc = dtr;
        if (ci + 1 < 65) SSD_LOAD(ci + 1);
        lds_barrier();
        { unsigned xr[16];
#pragma unroll
          for (int m = 0; m < 16; ++m) xr[m] = *(const LAS unsigned*)(RX + (16 * xq4 + m) * 256 + 2 * xcp);
          unsigned lo[8], hi2[8];
#pragma unroll
          for (int q = 0; q < 8; ++q) { lo[q] = (xr[2 * q] & 0xffffu) | (xr[2 * q + 1] << 16); hi2[q] = (xr[2 * q] >> 16) | (xr[2 * q + 1] & 0xffff0000u); }
          LAS bf16_t* x0 = TX + (2 * xcp) * PJ + 16 * xq4;
          *(LAS u32x4*)(x0) = (u32x4){lo[0], lo[1], lo[2], lo[3]}; *(LAS u32x4*)(x0 + 8) = (u32x4){lo[4], lo[5], lo[6], lo[7]};
          *(LAS u32x4*)(x0 + PJ) = (u32x4){hi2[0], hi2[1], hi2[2], hi2[3]}; *(LAS u32x4*)(x0 + PJ + 8) = (u32x4){hi2[4], hi2[5], hi2[6], hi2[7]}; }
        if (tid >= 256) { const int bn = tid & 63, brq = (tid >> 6) & 3; unsigned short bv[16];
#pragma unroll
            for (int m = 0; m < 16; ++m) bv[m] = TB[(16 * brq + m) * PJ + bn];
            u32x4 w0, w1; w0.x = bv[0] | ((unsigned)bv[1] << 16); w0.y = bv[2] | ((unsigned)bv[3] << 16); w0.z = bv[4] | ((unsigned)bv[5] << 16); w0.w = bv[6] | ((unsigned)bv[7] << 16);
            w1.x = bv[8] | ((unsigned)bv[9] << 16); w1.y = bv[10] | ((unsigned)bv[11] << 16); w1.z = bv[12] | ((unsigned)bv[13] << 16); w1.w = bv[14] | ((unsigned)bv[15] << 16);
            *(LAS u32x4*)(TBT + bn * PJ + 16 * brq) = w0; *(LAS u32x4*)(TBT + bn * PJ + 16 * brq + 8) = w1; }
        if (tid < 256) {
            const float xd = dtc + dtb;
            const float dt = (dtc < -1e29f) ? 0.f : (xd > 20.f ? xd : log1pf(__expf(xd)));
            float cum = dt * Ah;
#pragma unroll
            for (int o = 1; o < 64; o <<= 1) { const float t = shup_f(cum, o, lane); if (lane >= o) cum += t; }
            const float tot = shl_f(cum, 63);
            CUM[sh * 64 + si] = cum; DTV[sh * 64 + si] = dt; WV[sh * 64 + si] = dt * __expf(tot - cum); ECV[sh * 64 + si] = __expf(cum);
            if (si == 0) DVv[sh] = __expf(tot);
        }
        lds_barrier();
        {
            const LAS float* cumh = CUM + hh * 64; const LAS float* dth = DTV + hh * 64; const LAS float* wh = WV + hh * 64; const LAS float* ech = ECV + hh * 64;
            bf16x8 sf[2][2];
#pragma unroll
            for (int nb = 0; nb < 2; ++nb)
#pragma unroll
                for (int s2 = 0; s2 < 2; ++s2) sf[nb][s2] = pack8(Sacc[nb][8 * s2], Sacc[nb][8 * s2 + 1], Sacc[nb][8 * s2 + 2], Sacc[nb][8 * s2 + 3], Sacc[nb][8 * s2 + 4], Sacc[nb][8 * s2 + 5], Sacc[nb][8 * s2 + 6], Sacc[nb][8 * s2 + 7]);
            const LAS bf16_t* xT = TX + (hh * 64 + 32 * ph + r32) * PJ;
#pragma unroll
            for (int ib = 0; ib < 2; ++ib) {
                f32x16 acc;
#pragma unroll
                for (int r = 0; r < 16; ++r) acc[r] = zz;
#pragma unroll
                for (int nb = 0; nb < 2; ++nb)
#pragma unroll
                    for (int s2 = 0; s2 < 2; ++s2) { const bf16x8 cb_ = ld8perm(TC + (32 * ib + r32) * PJ + 32 * nb + 16 * s2 + 4 * hi);
                        acc = __builtin_amdgcn_mfma_f32_32x32x16_bf16(sf[nb][s2], cb_, acc, 0, 0, 0); }
                { const float eci = ech[32 * ib + r32];
#pragma unroll
                  for (int r = 0; r < 16; ++r) acc[r] *= eci; }
                const float ci_ = cumh[32 * ib + r32];
#pragma unroll
                for (int jb = 0; jb <= ib; ++jb) {
                    f32x16 gacc;
#pragma unroll
                    for (int r = 0; r < 16; ++r) gacc[r] = zz;
#pragma unroll
                    for (int ns = 0; ns < 4; ++ns) { const bf16x8 a = *(const LAS bf16x8*)(TB + (32 * jb + r32) * PJ + 16 * ns + 8 * hi); const bf16x8 bq = *(const LAS bf16x8*)(TC + (32 * ib + r32) * PJ + 16 * ns + 8 * hi);
                        gacc = __builtin_amdgcn_mfma_f32_32x32x16_bf16(a, bq, gacc, 0, 0, 0); }
#pragma unroll
                    for (int q4 = 0; q4 < 4; ++q4) { const f32x4 cj = *(const LAS f32x4*)(cumh + 32 * jb + 8 * q4 + 4 * hi); const f32x4 dj = *(const LAS f32x4*)(dth + 32 * jb + 8 * q4 + 4 * hi);
#pragma unroll
                        for (int t = 0; t < 4; ++t) { const int jrel = 8 * q4 + 4 * hi + t; const bool keep = (jb < ib) || (jrel <= r32);
                            gacc[4 * q4 + t] = keep ? gacc[4 * q4 + t] * dj[t] * __expf(fminf(ci_ - cj[t], 0.f)) : 0.f; } }
#pragma unroll
                    for (int s2 = 0; s2 < 2; ++s2) { const bf16x8 pfr = pack8(gacc[8 * s2], gacc[8 * s2 + 1], gacc[8 * s2 + 2], gacc[8 * s2 + 3], gacc[8 * s2 + 4], gacc[8 * s2 + 5], gacc[8 * s2 + 6], gacc[8 * s2 + 7]);
                        const bf16x8 xb = ld8perm(xT + 32 * jb + 16 * s2 + 4 * hi);
                        acc = __builtin_amdgcn_mfma_f32_32x32x16_bf16(xb, pfr, acc, 0, 0, 0); }
                }
#pragma unroll
                for (int q4 = 0; q4 < 4; ++q4) { u32x2 w; w.x = cvt_pk_bf16(acc[4 * q4], acc[4 * q4 + 1]); w.y = cvt_pk_bf16(acc[4 * q4 + 2], acc[4 * q4 + 3]);
                    *(LAS u32x2*)(OT + (32 * ib + r32) * PO + hh * 64 + 32 * ph + 8 * q4 + 4 * hi) = w; }
            }
            const float Dh = DVv[hh];
#pragma unroll
            for (int r = 0; r < 16; ++r) { Sacc[0][r] *= Dh; Sacc[1][r] *= Dh; }
#pragma unroll
            for (int js = 0; js < 4; ++js) { const u32x4 xw = *(const LAS u32x4*)(xT + 16 * js + 8 * hi); const f32x4 w0 = *(const LAS f32x4*)(wh + 16 * js + 8 * hi), w1 = *(const LAS f32x4*)(wh + 16 * js + 8 * hi + 4);
                const bf16x8 xb = pack8(bflo(xw.x) * w0[0], bfhi(xw.x) * w0[1], bflo(xw.y) * w0[2], bfhi(xw.y) * w0[3], bflo(xw.z) * w1[0], bfhi(xw.z) * w1[1], bflo(xw.w) * w1[2], bfhi(xw.w) * w1[3]);
#pragma unroll
                for (int nb = 0; nb < 2; ++nb) { const bf16x8 a = *(const LAS bf16x8*)(TBT + (32 * nb + r32) * PJ + 16 * js + 8 * hi);
                    Sacc[nb] = __builtin_amdgcn_mfma_f32_32x32x16_bf16(a, xb, Sacc[nb], 0, 0, 0); } }
        }
        lds_barrier();
#pragma unroll
        for (int k = 0; k < 4; ++k) { const int idx = tid + 512 * k, i = idx >> 5, c16 = idx & 31; const int r = dir ? n - 1 - i : i;
            if (i < n) *(u32x4*)(OUT + (size_t)(base + r) * 512 + 256 * g + c16 * 8) = *(const LAS u32x4*)(OT + i * PO + c16 * 8); }
    }
#undef SSD_LOAD
    __syncthreads();
}

__device__ __forceinline__ void phase_mixers(const Ctx& c0, int layer, const int sites = 15, const int qsel = 0) {
    constexpr int N_H = 64, N_S = 32, N_A = NB * 2 * 65;
#ifndef MIX_SITES
#define MIX_SITES 15
#endif
    if ((MIX_SITES & 1) && (sites & 1)) { const Ctx c = fresh(c0); for (int it = c.bid; it < N_H; it += c.G) hgrn_chunk_item(c, layer, it >> 3, (it >> 1) & 3, it & 1); }
    if ((MIX_SITES & 2) && (sites & 2)) { const Ctx c = fresh(c0); for (int it = (c.bid + c.G - N_H % c.G) % c.G; it < N_S; it += c.G) ssd_chunk_item(c, layer, it >> 2, (it >> 1) & 1, it & 1); }
    if ((MIX_SITES & 4) && (sites & 4)) { const Ctx c = fresh(c0);
        unsigned* qctr = (unsigned*)(c.ws + WS_CTL) + 32768 + 64 * layer + 1024 * qsel;
        volatile LAS unsigned* qw = (volatile LAS unsigned*)(c.smem + LDS_MISC + 64);
        for (;;) {
            if (c.tid == 0) qw[0] = __hip_atomic_fetch_add(qctr, 1u, __ATOMIC_RELAXED, __HIP_MEMORY_SCOPE_AGENT);
            __syncthreads();
            const int u = __builtin_amdgcn_readfirstlane((int)qw[0]);
            __syncthreads();
            if (u >= N_A) break;
            const int b = u / 130, rem = u % 130; att::attn_unit<8>(b, rem / 65, rem % 65, c.PROJ(), c.ATT(), (char*)c.smem, c.wid, c.lane); } }
    if ((MIX_SITES & 8) && (sites & 8) && layer + 1 < DEPTH) { Ctx cn = c0; cn.wbuf = c0.wbuf ^ 1; convert_pull(cn, layer + 1, (LAS float*)(c0.smem + 65536)); }
}

__device__ __forceinline__ void phase_mix(const Ctx& c0, int layer) {
    const Ctx c = fresh(c0);
    const int lane = c.lane;
    const float* anw = c.a->in[I_ANW] + layer * 512; const float* hnw = c.a->in[I_HNW] + layer * 512; const float* snw = c.a->in[I_SNW] + layer * 512;
    const float dsk = c.a->in[I_DSKIP][layer * 8 + (lane >> 3)];
    auto ld8 = [](const bf16_t* p, float (&x)[8]) { const u32x4 w = *(const u32x4*)p; x[0] = bflo(w.x); x[1] = bfhi(w.x); x[2] = bflo(w.y); x[3] = bfhi(w.y); x[4] = bflo(w.z); x[5] = bfhi(w.z); x[6] = bflo(w.w); x[7] = bfhi(w.w); };
    auto st8 = [](bf16_t* p, const float (&x)[8]) { u32x4 w; w.x = cvt_pk_bf16(x[0], x[1]); w.y = cvt_pk_bf16(x[2], x[3]); w.z = cvt_pk_bf16(x[4], x[5]); w.w = cvt_pk_bf16(x[6], x[7]); *(u32x4*)p = w; };
    for (int row = c.bid * 8 + c.wid; row < ROWS; row += c.G * 8) {
        const bf16_t* prow = c.PROJ() + (size_t)row * PROJW;
        bf16_t* mrow = c.MIX() + (size_t)row * MIXW;
        float x[8], y[8], z[8];
        { ld8(c.ATT() + (size_t)row * 512 + 8 * lane, x); float ss = 0.f;
#pragma unroll
          for (int j = 0; j < 8; ++j) ss += x[j] * x[j];
          ss = wave_sum(ss, lane); const float rstd = rsqrtf(ss * (1.0f / 512.0f) + EPS);
#pragma unroll
          for (int j = 0; j < 8; ++j) x[j] = x[j] * rstd * anw[8 * lane + j];
          st8(mrow + 8 * lane, x); }
        { ld8(c.OF() + (size_t)row * 512 + 8 * lane, x); ld8(c.OB() + (size_t)row * 512 + 8 * lane, y); ld8(prow + C_HG + 8 * lane, z); float ss = 0.f;
#pragma unroll
          for (int j = 0; j < 8; ++j) { x[j] += y[j]; ss += x[j] * x[j]; }
          ss += shx(ss, 1, lane); ss += shx(ss, 2, lane); ss += shx(ss, 4, lane); ss += shx(ss, 8, lane);
          const float rstd = rsqrtf(ss * (1.0f / 128.0f) + EPS);
#pragma unroll
          for (int j = 0; j < 8; ++j) x[j] = x[j] * rstd * hnw[8 * lane + j] * silu_f(z[j]);
          st8(mrow + 512 + 8 * lane, x); }
        { ld8(c.YF() + (size_t)row * 512 + 8 * lane, x); ld8(c.YB() + (size_t)row * 512 + 8 * lane, y); ld8(prow + C_SZ + 8 * lane, z); float xs[8]; ld8(c.XBC() + (size_t)row * 768 + 8 * lane, xs); float ss = 0.f;
#pragma unroll
          for (int j = 0; j < 8; ++j) { x[j] = (x[j] + y[j] + dsk * xs[j]) * silu_f(z[j]); ss += x[j] * x[j]; }
          ss = wave_sum(ss, lane); const float rstd = rsqrtf(ss * (1.0f / 512.0f) + EPS);
#pragma unroll
          for (int j = 0; j < 8; ++j) x[j] = x[j] * rstd * snw[8 * lane + j];
          st8(mrow + 1024 + 8 * lane, x); }
    }
}

__device__ __forceinline__ void phase_topk(const Ctx& c0) {
    const Ctx c = fresh(c0);
    LAS unsigned* HIST = (LAS unsigned*)c.smem;
    LAS unsigned* WOFF = HIST + 1024;
    LAS unsigned* RES = HIST + 1040;
    const int tid = c.tid, lane = c.lane, wid = c.wid;
    for (int it = c.bid; it < NB * NEXP; it += c.G) {
        const int b = it >> 4, e = it & 15;
        unsigned key[9];
#pragma unroll
        for (int k = 0; k < 9; ++k) { const int i = 9 * tid + k; key[k] = i < LTOK ? min(__float_as_uint(c.AFFT()[(size_t)it * LTOK + i]), 0x3fffffffu) : 0u; }
        unsigned prefix = 0u, need = CAP;
#pragma unroll
        for (int pass = 0; pass < 3; ++pass) {
            const int sh = 20 - 10 * pass;
            __syncthreads();
            HIST[tid] = 0u; HIST[tid + 512] = 0u;
            __syncthreads();
#pragma unroll
            for (int k = 0; k < 9; ++k) { const int i = 9 * tid + k; const bool cand = (i < LTOK) && (pass == 0 || (key[k] >> (sh + 10)) == prefix);
                if (cand) __hip_atomic_fetch_add(&HIST[(key[k] >> sh) & 1023u], 1u, __ATOMIC_RELAXED, __HIP_MEMORY_SCOPE_WORKGROUP); }
            __syncthreads();
            const unsigned h1 = HIST[1023 - 2 * tid], h0 = HIST[1022 - 2 * tid];
            const unsigned pair = h1 + h0; unsigned inc = pair;
#pragma unroll
            for (int o = 1; o < 64; o <<= 1) { const unsigned t = shup_u(inc, o, lane); if (lane >= o) inc += t; }
            if (lane == 63) WOFF[wid] = inc;
            __syncthreads();
            unsigned woff = 0u;
#pragma unroll
            for (int w = 0; w < 8; ++w) { const unsigned v = WOFF[w]; if (w < wid) woff += v; }
            const unsigned above1 = woff + inc - pair, suf1 = above1 + h1, suf0 = suf1 + h0;
            if (suf1 >= need && above1 < need) { RES[0] = (unsigned)(1023 - 2 * tid); RES[1] = need - above1; }
            if (suf0 >= need && suf1 < need) { RES[0] = (unsigned)(1022 - 2 * tid); RES[1] = need - suf1; }
            __syncthreads();
            prefix = (prefix << 10) | RES[0]; need = RES[1];
        }
        const unsigned T = prefix;
        unsigned ngt = 0u, neq = 0u;
#pragma unroll
        for (int k = 0; k < 9; ++k) { const int i = 9 * tid + k; if (i < LTOK) { ngt += key[k] > T; neq += key[k] == T; } }
        unsigned pk = ngt | (neq << 16), inc = pk;
#pragma unroll
        for (int o = 1; o < 64; o <<= 1) { const unsigned t = shup_u(inc, o, lane); if (lane >= o) inc += t; }
        __syncthreads();
        if (lane == 63) WOFF[wid] = inc;
        __syncthreads();
        unsigned woff = 0u, tot = 0u;
#pragma unroll
        for (int w = 0; w < 8; ++w) { const unsigned v = WOFF[w]; if (w < wid) woff += v; tot += v; }
        const unsigned ex = woff + inc - pk;
        unsigned gt_off = ex & 0xffffu, eq_off = ex >> 16; const unsigned gt_tot = tot & 0xffffu;
#pragma unroll
        for (int k = 0; k < 9; ++k) { const int i = 9 * tid + k;
            if (i < LTOK) { const int row = row_of(b, i); int slot = -1;
                if (key[k] > T) slot = (int)gt_off++;
                else if (key[k] == T) { if (eq_off < need) slot = (int)(gt_tot + eq_off); ++eq_off; }
                if (slot >= 0) { const int mrow = e * EROWS + b * CAP + slot; c.RIDX()[mrow] = row; c.GATE()[mrow] = __uint_as_float(key[k]); c.SEL()[row * 16 + e] = mrow; }
                else c.SEL()[row * 16 + e] = -1; } }
    }
}

__device__ __forceinline__ void phase_final(const Ctx& c0) {
    const Ctx c = fresh(c0);
    const int lane = c.lane;
    constexpr int NR = 4;
    for (int r0 = (c.bid * 8 + c.wid) * NR; r0 < ROWS_REAL; r0 += c.G * 8 * NR) {
        f32x4 v[NR][4]; int sv[NR]; unsigned hm[NR];
#pragma unroll
        for (int q = 0; q < NR; ++q) { sv[q] = lane < 16 ? c.SEL()[(r0 + q) * 16 + lane] : -1;
#pragma unroll
            for (int i = 0; i < 4; ++i) { const u32x2 w = *(const u32x2*)(c.H() + (size_t)(r0 + q) * DM + 4 * lane + 256 * i); v[q][i] = (f32x4){bflo(w.x), bfhi(w.x), bflo(w.y), bfhi(w.y)}; } }
#pragma unroll
        for (int q = 0; q < NR; ++q) hm[q] = (unsigned)__builtin_amdgcn_ballot_w64(sv[q] >= 0);
        while ((hm[0] | hm[1] | hm[2] | hm[3]) != 0u) {
            int wd[NR][2][4]; bool has[NR][2];
#pragma unroll
            for (int q = 0; q < NR; ++q)
#pragma unroll
                for (int j = 0; j < 2; ++j) { has[q][j] = hm[q] != 0u; const int e = has[q][j] ? __builtin_ctz(hm[q]) : 0; hm[q] &= hm[q] - 1u;
                    const int se = has[q][j] ? __builtin_amdgcn_readlane(sv[q], e) : 0;
                    const unsigned char* yp = c.Y() + (size_t)se * DM + 4 * lane;
#pragma unroll
                    for (int i = 0; i < 4; ++i) wd[q][j][i] = *(const int*)(yp + 256 * i); }
#pragma unroll
            for (int q = 0; q < NR; ++q)
#pragma unroll
                for (int j = 0; j < 2; ++j) if (has[q][j]) {
#pragma unroll
                    for (int i = 0; i < 4; ++i) { const int w = wd[q][j][i]; const f32x2 lo = __builtin_amdgcn_cvt_pk_f32_fp8(w, false), hi_ = __builtin_amdgcn_cvt_pk_f32_fp8(w, true);
                        v[q][i][0] += lo[0] * 0.0625f; v[q][i][1] += lo[1] * 0.0625f; v[q][i][2] += hi_[0] * 0.0625f; v[q][i][3] += hi_[1] * 0.0625f; } }
        }
#pragma unroll
        for (int q = 0; q < NR; ++q)
#pragma unroll
            for (int i = 0; i < 4; ++i) *(f32x4*)(c.a->out + (size_t)(r0 + q) * DM + 4 * lane + 256 * i) = v[q][i];
    }
}

struct SmallDeal { int xcd, nx, wslot, nw; };
__device__ __forceinline__ SmallDeal small_deal(const Ctx& c) { SmallDeal d; d.nx = 1; d.xcd = 0; d.wslot = c.bid; d.nw = c.G; return d; }
__device__ __forceinline__ void small_inproj(const Ctx& c0, int layer) {
    const Ctx c = fresh(c0); const int lane = c.lane, r = lane & 15, cq = lane >> 4; const SmallDeal d = small_deal(c); const int per = 288 / d.nx;
    for (int u = d.wslot * 8 + c.wid; u < 4 * per; u += d.nw * 8) { const int rp = u / per, n0 = 16 * (d.xcd * per + u % per); const int row0 = ROWS_REAL + 32 * rp + r;
        const bf16_t* const ar[2] = {c.U() + (size_t)row0 * DM, c.U() + (size_t)(row0 + 16) * DM}; const bf16_t* const br[1] = {c.WIN() + (size_t)(n0 + r) * DM};
        f32x4 acc2[2][1]; small_gemm16_bt<2, 1, DM, 4>(ar, br, acc2, lane);
        const int mode = (n0 >= C_HQ && n0 < C_HF) ? 1 : ((n0 >= C_HF && n0 < C_HI) ? 2 : 0);
        const int col = n0 + 4 * cq;
#pragma unroll
        for (int q = 0; q < 2; ++q) { float v[4] = {acc2[q][0][0], acc2[q][0][1], acc2[q][0][2], acc2[q][0][3]};
            if (mode == 1) {
#pragma unroll
                for (int j = 0; j < 4; ++j) v[j] = silu_f(v[j]); }
            else if (mode == 2) { const float* lp = c.LB() + ((col >= C_HB ? 1 : 0) * DEPTH + layer) * 512 + (col >= C_HB ? col - C_HB : col - C_HF);
#pragma unroll
                for (int j = 0; j < 4; ++j) v[j] = fgate_f(v[j], lp[j]); }
            u32x2 w; w.x = cvt_pk_bf16(v[0], v[1]); w.y = cvt_pk_bf16(v[2], v[3]); *(u32x2*)(c.PROJ() + (size_t)(row0 + 16 * q) * PROJW + col) = w; } }
}
__device__ __forceinline__ void small_outproj(const Ctx& c0) {
    const Ctx c = fresh(c0); const int lane = c.lane, r = lane & 15, cq = lane >> 4, gq = c.wid >> 2, kq = c.wid & 3; const SmallDeal d = small_deal(c); const int per = 64 / d.nx;
    LAS f32x4* RED = (LAS f32x4*)c.smem;
    for (int u0 = d.wslot * 2; u0 < 8 * per; u0 += d.nw * 2) { const int u = u0 + gq; const int rg = u / per, n0 = 16 * (d.xcd * per + u % per); const int row = ROWS_REAL + 16 * rg + r;
        const bf16_t* const ar[1] = {c.MIX() + (size_t)row * MIXW + kq * (MIXW / 4)}; const bf16_t* const br[1] = {c.WOUT() + (size_t)(n0 + r) * MIXW + kq * (MIXW / 4)};
        f32x4 acc1[1][1]; small_gemm16_bt<1, 1, MIXW / 4, 3>(ar, br, acc1, lane);
        __syncthreads();
        RED[c.wid * 64 + lane] = acc1[0][0];
        __syncthreads();
        if (kq == 0) { const f32x4 sum = RED[(4 * gq) * 64 + lane] + RED[(4 * gq + 1) * 64 + lane] + RED[(4 * gq + 2) * 64 + lane] + RED[(4 * gq + 3) * 64 + lane];
            u32x2* p = (u32x2*)(c.H() + (size_t)row * DM + n0 + 4 * cq); const u32x2 w = *p; u32x2 o; o.x = cvt_pk_bf16(bflo(w.x) + sum[0], bfhi(w.x) + sum[1]); o.y = cvt_pk_bf16(bflo(w.y) + sum[2], bfhi(w.y) + sum[3]); *p = o; } }
}
__device__ __forceinline__ void small_gateup(const Ctx& c0) {
    const Ctx c = fresh(c0); const int lane = c.lane, r = lane & 15, cq = lane >> 4; const SmallDeal d = small_deal(c); const int per = 128 / d.nx;
    for (int u = d.wslot * 8 + c.wid; u < NEXP * per; u += d.nw * 8) { const int e = u / per, fb = d.xcd * per + u % per, ff0 = 16 * fb, pn = ff0 >> 7, j0 = ff0 & 127; const int mrow = e * EROWS + 4096 + r;
        const unsigned char* wb = c.WGU() + ((size_t)e * 4096 + pn * 256 + j0 + r) * DM;
        const unsigned char* const br[2] = {wb, wb + (size_t)128 * DM};
        f32x4 acc[2]; small_gemm16_f8t<2, DM, 4>(c.U8() + (size_t)c.RIDX()[mrow] * DM, br, acc, lane);
        const float sc = 1.0f / 32.0f; float v[4];
#pragma unroll
        for (int j = 0; j < 4; ++j) v[j] = silu_f(acc[0][j] * sc) * (acc[1][j] * sc);
        *(unsigned*)(c.ACT() + (size_t)mrow * FF + ff0 + 4 * cq) = pk4_fp8(v[0], v[1], v[2], v[3]); }
}
__device__ __forceinline__ void small_down(const Ctx& c0) {
    const Ctx c = fresh(c0); const int lane = c.lane, r = lane & 15, cq = lane >> 4, gq = c.wid >> 1, kq = c.wid & 1; const SmallDeal d = small_deal(c); const int eper = NEXP / d.nx;
    LAS f32x4* RED = (LAS f32x4*)c.smem;
    for (int u0 = d.wslot * 4; u0 < eper * 64; u0 += d.nw * 4) { const int u = u0 + gq; const int e = d.xcd * eper + (u >> 6), n0 = 16 * (u & 63); const int mrow = e * EROWS + 4096 + r;
        const unsigned char* const br[1] = {c.WD() + ((size_t)e * DM + n0 + r) * FF + kq * (FF / 2)};
        f32x4 acc[1]; small_gemm16_f8t<1, FF / 2, 8>(c.ACT() + (size_t)mrow * FF + kq * (FF / 2), br, acc, lane);
        __syncthreads();
        RED[c.wid * 64 + lane] = acc[0];
        __syncthreads();
        if (kq == 0) { const f32x4 sum = RED[(2 * gq) * 64 + lane] + RED[(2 * gq + 1) * 64 + lane];
            const float g = c.GATE()[mrow] * (1.0f / 32.0f);
            *(unsigned*)(c.Y() + (size_t)mrow * DM + n0 + 4 * cq) = pk4_fp8(16.0f * sum[0] * g, 16.0f * sum[1] * g, 16.0f * sum[2] * g, 16.0f * sum[3] * g); } }
}

constexpr int NPH_LAYER = 10, NPH = 1 + DEPTH * NPH_LAYER + 1;
__global__ void __launch_bounds__(512, 2) mega(Args args) {
    extern __shared__ __attribute__((aligned(16))) unsigned char lds[];
    Ctx c;
    c.wbuf = 0;
    c.a = &args; c.ws = args.ws; c.smem = (LAS char*)lds; c.tid = threadIdx.x; c.lane = c.tid & 63; c.wid = __builtin_amdgcn_readfirstlane(c.tid >> 6); c.G = gridDim.x; c.bid = blockIdx.x;
    unsigned char* ws = args.ws;
    LAS unsigned char* l3 = (LAS unsigned char*)lds;
    volatile LAS unsigned* MISC = (volatile LAS unsigned*)(l3 + LDS_MISC);
    if (c.tid < 4) MISC[c.tid] = 0u;
    __syncthreads();
    const int lo = args.ph_lo, hi = args.ph_hi;
    XcdBarrier bar; bar.bar = (unsigned*)(ws + WS_CTL) + 4096; bar.x = 0; bar.st = MISC;
    if (hi - lo > 1) bar = xcd_barrier_post((unsigned*)(ws + WS_CTL) + 4096, MISC);
#define IN(k) (lo <= (k) && (k) < hi)
#define SEAM(k) do { if (IN(k) && IN((k) + 1)) xcd_barrier(bar, c.wid); } while (0)
    if ((PH_MASK & 1) && IN(0)) { phase_tables(c); }
    SEAM(0);
    for (int layer_ = 0; layer_ < DEPTH; ++layer_) {
        int layer = layer_; asm volatile("" : "+s"(layer)); c.wbuf = layer & 1;
        const int p0 = 1 + layer_ * NPH_LAYER;
        if ((PH_MASK & (2 << 0)) && IN(p0 + 0)) { DLY(10, phase_norm<false>(c, layer)); convert_pull(c, layer, (LAS float*)(c.smem + 65536)); }
        SEAM(p0 + 0);
        if ((PH_MASK & (2 << 1)) && IN(p0 + 1)) { pg::SchedDense S{ROWS_REAL / 256, PROJW / 256, (ROWS_REAL / 256) * (PROJW / 256), og(c.G), og(c.bid), (const char*)c.WIN()}; pg::EpiProj E{c.PROJ(), PROJW, c.LB() + (0 * DEPTH + layer) * 512, c.LB() + (1 * DEPTH + layer) * 512};
            REP(1) pg::gemm_phase(l3, c.wid, (const char*)c.U(), DM * 2, S, E); for (int sr_ = 0; sr_ < SMALL_REP; ++sr_) small_inproj(c, layer); }
        SEAM(p0 + 1);
        if ((PH_MASK & (2 << 2)) && IN(p0 + 2)) { DLY(2, phase_prep(c, layer)); }
        SEAM(p0 + 2);
        if ((PH_MASK & (2 << 3)) && IN(p0 + 3)) { const int nrep_ = (PROBE_PH >= 13 && PROBE_PH <= 15) ? 2 : 1; for (int rep_ = 0; rep_ < nrep_; ++rep_) { __syncthreads(); phase_mixers(c, layer, og(rep_ == 0 ? 15 : (PROBE_PH == 13 ? 4 : (PROBE_PH == 14 ? 1 : 2))), og(rep_)); } }
        SEAM(p0 + 3);
        if ((PH_MASK & (2 << 4)) && IN(p0 + 4)) { REP(4) phase_mix(c, layer); }
        SEAM(p0 + 4);
        if ((PH_MASK & (2 << 5)) && IN(p0 + 5)) { pg::SchedDense S{ROWS_REAL / 256, DM / 256, (ROWS_REAL / 256) * (DM / 256), og(c.G), og(c.bid), (const char*)c.WOUT()}; pg::EpiResid E{c.H(), DM};
            DLY(5, pg::gemm_phase(l3, c.wid, (const char*)c.MIX(), MIXW * 2, S, E)); small_outproj(c); }
        SEAM(p0 + 5);
        if ((PH_MASK & (2 << 6)) && IN(p0 + 6)) { REP(6) { __syncthreads(); phase_router(c, layer); } }
        SEAM(p0 + 6);
        if ((PH_MASK & (2 << 7)) && IN(p0 + 7)) { REP(7) phase_topk(c); }
        SEAM(p0 + 7);
        if ((PH_MASK & (2 << 8)) && IN(p0 + 8)) { pg::SchedMoE1 S{og(c.G), og(c.bid), c.RIDX(), (const char*)c.WGU()}; pg::EpiGateUp E{c.ACT()};
            REP(8) pg::gemm_phase(l3, c.wid, (const char*)c.U8(), DM, S, E); for (int sr_ = 0; sr_ < SMALL_REP; ++sr_) small_gateup(c); }
        SEAM(p0 + 8);
        if ((PH_MASK & (2 << 9)) && IN(p0 + 9)) { pg::SchedMoE2 S{og(c.G), og(c.bid), c.IDT(), (const char*)c.WD()}; pg::EpiDown E{c.Y(), c.GATE()};
            REP(9) pg::gemm_phase(l3, c.wid, (const char*)c.ACT(), FF, S, E); for (int sr_ = 0; sr_ < SMALL_REP; ++sr_) small_down(c); }
        SEAM(p0 + 9);
    }
    if ((PH_MASK & (2 << 10)) && IN(NPH - 1)) { DLY(11, phase_final(c)); }
#undef IN
#undef SEAM
}

extern "C" void kernel_launch(void* const* d_in, const int* in_sizes, int n_in, void* d_out, int out_size, void* d_ws, size_t ws_size, hipStream_t stream) {
    static int grid = 0;
    if (grid == 0) {
        if (n_in != 21 || out_size != ROWS_REAL * DM || ws_size < WS_END) { fprintf(stderr, "kernel_launch: unexpected problem (n_in %d, out %d, ws %zu)\n", n_in, out_size, ws_size); grid = -1; return; }
        int dev = 0, cus = 0, per_cu = 0;
        if (hipGetDevice(&dev) != hipSuccess || hipDeviceGetAttribute(&cus, hipDeviceAttributeMultiprocessorCount, dev) != hipSuccess) { grid = -1; return; }
        if (hipFuncSetAttribute((const void*)mega, hipFuncAttributeMaxDynamicSharedMemorySize, LDS_BYTES) != hipSuccess) { fprintf(stderr, "kernel_launch: hipFuncSetAttribute failed\n"); grid = -1; return; }
        if (hipOccupancyMaxActiveBlocksPerMultiprocessor(&per_cu, (const void*)mega, 512, LDS_BYTES) != hipSuccess || per_cu < 1) fprintf(stderr, "kernel_launch: occupancy query says %d\n", per_cu);
        (void)hipGetLastError();
        grid = cus;
    }
    if (grid < 0) return;
    (void)hipMemsetAsync((char*)d_ws + WS_CTL, 0, CTL_BYTES, stream);
    Args a{};
    for (int i = 0; i < 21; ++i) a.in[i] = (const float*)d_in[i];
    a.out = (float*)d_out; a.ws = (unsigned char*)d_ws;
#if LAUNCH_PER_PHASE
    for (int ph = 0; ph < NPH; ++ph) { a.ph_lo = ph; a.ph_hi = ph + 1; hipLaunchKernelGGL(mega, dim3(grid), dim3(512), LDS_BYTES, stream, a); }
#else
    a.ph_lo = 0; a.ph_hi = NPH; hipLaunchKernelGGL(mega, dim3(grid), dim3(512), LDS_BYTES, stream, a);
#endif
}
```
